# Optimizing an MI355X kernel written in HIP

```python
import jax, jax.numpy as jnp
from jax import lax
import numpy as np

D_MODEL = 1024
BATCH = 4
SEQ = 8192
DEPTH = 4

HEAD_DIM = 64
N_SB_HEADS = 4
N_MOBA_HEADS = 4
N_MLA_HEADS = 4
N_NSA_HEADS = 4
N_MEM_HEADS = 4
MEM_LEN = 256
BRANCH_W = 4 * HEAD_DIM
N_BRANCHES = 5
Q_BLOCK = 128
MOBA_BLOCK = 256
MOBA_TOPK = 3
MLA_Q_RANK = 256
MLA_KV_RANK = 128
MLA_NOPE = 64
MLA_ROPE = 32
MLA_V = 64
ROPE_THETA = 10000.0
NSA_CMP_LEN = 32
NSA_CMP_STRIDE = 16
NSA_SEL_LEN = 64
NSA_TOPN = 16
NSA_WINDOW = 512
NSA_PHI_HIDDEN = 128
N_GROUPS = 4
EXPERTS_PER_GROUP = 4
N_EXPERTS = N_GROUPS * EXPERTS_PER_GROUP
D_EXPERT = 256
TOPK_IN_GROUP = 2
DEEPNORM_ALPHA = (2.0 * DEPTH) ** 0.25
DEEPNORM_BETA = (8.0 * DEPTH) ** -0.25
LN_EPS = 1e-5
RMS_EPS = 1e-6
NEG = -1e30
BIG = 1e30

IN_SIZES = (3 * N_SB_HEADS * HEAD_DIM,
            3 * N_MOBA_HEADS * HEAD_DIM,
            MLA_Q_RANK,
            MLA_KV_RANK,
            MLA_ROPE,
            N_NSA_HEADS * HEAD_DIM,
            6 * HEAD_DIM,
            3 * N_NSA_HEADS,
            N_MEM_HEADS * HEAD_DIM)
IN_TOTAL = sum(IN_SIZES)
IN_SPLITS = tuple(int(c) for c in np.cumsum(IN_SIZES)[:-1])

kernel_name = 'hybrid_gated_sparse_mixers_hmoe'


def layer_norm(x, g, b):
    xf = x.astype(jnp.float32)
    mu = jnp.mean(xf, axis=-1, keepdims=True)
    var = jnp.mean(jnp.square(xf - mu), axis=-1, keepdims=True)
    return ((xf - mu) * lax.rsqrt(var + LN_EPS) * g + b).astype(x.dtype)


def rms_norm(x, g):
    xf = x.astype(jnp.float32)
    return (xf * lax.rsqrt(jnp.mean(jnp.square(xf), axis=-1, keepdims=True) + RMS_EPS) * g).astype(x.dtype)


def heads(x, n):
    b, s, _ = x.shape
    return x.reshape(b, s, n, -1).transpose(0, 2, 1, 3)


def merge_heads(o):
    b, n, s, d = o.shape
    return o.transpose(0, 2, 1, 3).reshape(b, s, n * d)


def alibi_slopes(n):
    return jnp.power(2.0, -8.0 * jnp.arange(1, n + 1, dtype=jnp.float32) / n)


def rope(x, pos):
    half = x.shape[-1] // 2
    freqs = jnp.power(ROPE_THETA, -jnp.arange(half, dtype=jnp.float32) / half)
    ang = pos.astype(jnp.float32)[:, None] * freqs
    cos, sin = jnp.cos(ang), jnp.sin(ang)
    xf = x.astype(jnp.float32)
    x1, x2 = xf[..., :half], xf[..., half:]
    return jnp.concatenate([x1 * cos - x2 * sin, x1 * sin + x2 * cos], axis=-1).astype(x.dtype)


def sweep_query_blocks(block_fn, seq_len):
    out = lax.map(block_fn, jnp.arange(seq_len // Q_BLOCK))
    nb, b, h, q, dv = out.shape
    return out.transpose(1, 2, 0, 3, 4).reshape(b, h, nb * q, dv)


def stick_breaking_attention(q, k, v):
    s_len, d = q.shape[2], q.shape[3]
    scale = d ** -0.5
    kpos = jnp.arange(s_len)

    def block(i):
        q0 = i * Q_BLOCK
        qb = lax.dynamic_slice_in_dim(q, q0, Q_BLOCK, axis=2)
        qpos = q0 + jnp.arange(Q_BLOCK)
        z = jnp.einsum('bhqd,bhkd->bhqk', qb, k).astype(jnp.float32) * scale
        past = kpos[None, :] < qpos[:, None]
        log_keep = jnp.where(past, jax.nn.log_sigmoid(-z), 0.0)
        later = lax.cumsum(log_keep, axis=3, reverse=True) - log_keep
        a = jnp.where(past, jnp.exp(jax.nn.log_sigmoid(z) + later), 0.0)
        return jnp.einsum('bhqk,bhkd->bhqd', a.astype(v.dtype), v)

    return sweep_query_blocks(block, s_len)


def moba_attention(q, k, v, slopes):
    b, h, s_len, d = q.shape
    scale = d ** -0.5
    nblk = s_len // MOBA_BLOCK
    kb = k.reshape(b, h, nblk, MOBA_BLOCK, d)
    vb = v.reshape(b, h, nblk, MOBA_BLOCK, d)
    k_mean = jnp.mean(kb.astype(jnp.float32), axis=3).astype(k.dtype)
    topk = min(MOBA_TOPK, nblk - 1)
    blk_ids = jnp.arange(nblk)
    in_blk = jnp.arange(MOBA_BLOCK)
    bi = jnp.arange(b)[:, None, None, None]
    hi = jnp.arange(h)[None, :, None, None]

    def block(i):
        q0 = i * Q_BLOCK
        qb = lax.dynamic_slice_in_dim(q, q0, Q_BLOCK, axis=2)
        qpos = q0 + jnp.arange(Q_BLOCK)
        own = q0 // MOBA_BLOCK
        k_own = lax.dynamic_index_in_dim(kb, own, axis=2, keepdims=False)
        v_own = lax.dynamic_index_in_dim(vb, own, axis=2, keepdims=False)
        own_pos = own * MOBA_BLOCK + in_blk
        dist_own = (qpos[:, None] - own_pos[None, :]).astype(jnp.float32)
        s_own = jnp.einsum('bhqd,bhkd->bhqk', qb, k_own).astype(jnp.float32) * scale - slopes[:, None, None] * dist_own
        s_own = jnp.where(own_pos[None, :] <= qpos[:, None], s_own, NEG)
        if topk == 0:
            p = jax.nn.softmax(s_own, axis=-1).astype(v.dtype)
            return jnp.einsum('bhqk,bhkd->bhqd', p, v_own)
        gscore = jnp.einsum('bhqd,bhnd->bhqn', qb, k_mean).astype(jnp.float32)
        gscore = jnp.where(blk_ids[None, None, None, :] < own, gscore, NEG)
        gval, gidx = lax.top_k(gscore, topk)
        sel_ok = gval > 0.5 * NEG
        k_sel = kb[bi, hi, gidx]
        v_sel = vb[bi, hi, gidx]
        sel_pos = gidx[..., None] * MOBA_BLOCK + in_blk
        dist_sel = (qpos[:, None, None] - sel_pos).astype(jnp.float32)
        s_sel = jnp.einsum('bhqd,bhqnkd->bhqnk', qb, k_sel).astype(jnp.float32) * scale - slopes[:, None, None, None] * dist_sel
        s_sel = jnp.where(sel_ok[..., None], s_sel, NEG).reshape(b, h, Q_BLOCK, topk * MOBA_BLOCK)
        p = jax.nn.softmax(jnp.concatenate([s_sel, s_own], axis=-1), axis=-1).astype(v.dtype)
        p_sel = p[..., :topk * MOBA_BLOCK].reshape(b, h, Q_BLOCK, topk, MOBA_BLOCK)
        p_own = p[..., topk * MOBA_BLOCK:]
        return (jnp.einsum('bhqnk,bhqnkd->bhqd', p_sel, v_sel)
                + jnp.einsum('bhqk,bhkd->bhqd', p_own, v_own))

    return sweep_query_blocks(block, s_len)


def dense_causal_attention(q, k, v):
    s_len, dq = q.shape[2], q.shape[3]
    scale = dq ** -0.5
    kpos = jnp.arange(s_len)

    def block(i):
        q0 = i * Q_BLOCK
        qb = lax.dynamic_slice_in_dim(q, q0, Q_BLOCK, axis=2)
        qpos = q0 + jnp.arange(Q_BLOCK)
        s = jnp.einsum('bhqd,bhkd->bhqk', qb, k).astype(jnp.float32) * scale
        s = jnp.where(kpos[None, :] <= qpos[:, None], s, NEG)
        p = jax.nn.softmax(s, axis=-1).astype(v.dtype)
        return jnp.einsum('bhqk,bhkd->bhqd', p, v)

    return sweep_query_blocks(block, s_len)


def mla_attention(c_q, c_kv, k_rope_in, g_cq, g_ckv, w_uq, w_ukv):
    b, s_len, _ = c_q.shape
    pos = jnp.arange(s_len)
    q = heads(rms_norm(c_q, g_cq) @ w_uq, N_MLA_HEADS)
    q = jnp.concatenate([q[..., :MLA_NOPE], rope(q[..., MLA_NOPE:], pos)], axis=-1)
    kv = heads(rms_norm(c_kv, g_ckv) @ w_ukv, N_MLA_HEADS)
    k_r = jnp.broadcast_to(rope(k_rope_in, pos)[:, None], (b, N_MLA_HEADS, s_len, MLA_ROPE))
    k = jnp.concatenate([kv[..., :MLA_NOPE], k_r], axis=-1)
    v = kv[..., MLA_NOPE:]
    return merge_heads(dense_causal_attention(q, k, v))


def nsa_compress(x, pe, w1, w2):
    b, s_len, d = x.shape
    n_chunks = s_len // NSA_CMP_STRIDE
    ratio = NSA_CMP_LEN // NSA_CMP_STRIDE
    chunks = x.reshape(b, n_chunks, NSA_CMP_STRIDE, d)
    blocks = jnp.concatenate([chunks[:, r:n_chunks - ratio + 1 + r] for r in range(ratio)], axis=2)
    flat = (blocks + pe).reshape(b, n_chunks - ratio + 1, NSA_CMP_LEN * d)
    return jax.nn.gelu(flat @ w1) @ w2


def nsa_attention(q, kv, gate_logits, pe, w_k1, w_k2, w_v1, w_v2, slopes):
    b, h, s_len, d = q.shape
    scale = d ** -0.5
    k_cmp, v_cmp, k_slc, v_slc, k_win, v_win = jnp.split(kv, 6, axis=-1)
    gates = jax.nn.sigmoid(gate_logits).reshape(b, s_len, h, 3).transpose(0, 2, 1, 3)
    k_c = nsa_compress(k_cmp, pe, w_k1, w_k2)
    v_c = nsa_compress(v_cmp, pe, w_v1, w_v2)
    n_cmp = k_c.shape[1]
    cmp_start = jnp.arange(n_cmp) * NSA_CMP_STRIDE
    cmp_end = cmp_start + NSA_CMP_LEN - 1
    n_sel = s_len // NSA_SEL_LEN
    sel_ids = jnp.arange(n_sel)
    sel_start = sel_ids * NSA_SEL_LEN
    overlap = ((cmp_start[:, None] < sel_start[None, :] + NSA_SEL_LEN)
               & (cmp_start[:, None] + NSA_CMP_LEN > sel_start[None, :])).astype(jnp.float32)
    topn = min(NSA_TOPN, n_sel)
    ks_b = k_slc.reshape(b, n_sel, NSA_SEL_LEN, d)
    vs_b = v_slc.reshape(b, n_sel, NSA_SEL_LEN, d)
    pad = jnp.zeros((b, NSA_WINDOW, d), k_win.dtype)
    kw_pad = jnp.concatenate([pad, k_win], axis=1)
    vw_pad = jnp.concatenate([pad, v_win], axis=1)
    bi = jnp.arange(b)[:, None, None]
    in_sel = jnp.arange(NSA_SEL_LEN)

    def block(i):
        q0 = i * Q_BLOCK
        qb = lax.dynamic_slice_in_dim(q, q0, Q_BLOCK, axis=2)
        gb = lax.dynamic_slice_in_dim(gates, q0, Q_BLOCK, axis=2)
        qpos = q0 + jnp.arange(Q_BLOCK)
        dist_c = (qpos[:, None] - cmp_end[None, :]).astype(jnp.float32)
        m_c = cmp_end[None, :] <= qpos[:, None]
        s_c = jnp.einsum('bhqd,bnd->bhqn', qb, k_c).astype(jnp.float32) * scale - slopes[:, None, None] * dist_c
        p_c = jnp.where(m_c, jax.nn.softmax(jnp.where(m_c, s_c, NEG), axis=-1), 0.0)
        o_c = jnp.einsum('bhqn,bnd->bhqd', p_c.astype(v_c.dtype), v_c)
        imp = jnp.einsum('bhqn,ns->bqs', p_c, overlap)
        cur = qpos // NSA_SEL_LEN
        forced = (sel_ids[None, :] == 0) | (sel_ids[None, :] == cur[:, None])
        past = sel_ids[None, :] < cur[:, None]
        score = jnp.where(forced, BIG, jnp.where(past, imp, NEG))
        val, idx = lax.top_k(score, topn)
        ok = val > 0.5 * NEG
        k_s = ks_b[bi, idx]
        v_s = vs_b[bi, idx]
        pos_s = idx[..., None] * NSA_SEL_LEN + in_sel
        dist_s = (qpos[:, None, None] - pos_s).astype(jnp.float32)[:, None]
        m_s = (ok[..., None] & (pos_s <= qpos[:, None, None]))[:, None]
        s_s = jnp.einsum('bhqd,bqnkd->bhqnk', qb, k_s).astype(jnp.float32) * scale - slopes[:, None, None, None] * dist_s
        s_s = jnp.where(m_s, s_s, NEG).reshape(b, h, Q_BLOCK, topn * NSA_SEL_LEN)
        p_s = jax.nn.softmax(s_s, axis=-1).astype(v_s.dtype).reshape(b, h, Q_BLOCK, topn, NSA_SEL_LEN)
        o_s = jnp.einsum('bhqnk,bqnkd->bhqd', p_s, v_s)
        k_w = lax.dynamic_slice_in_dim(kw_pad, q0, Q_BLOCK + NSA_WINDOW, axis=1)
        v_w = lax.dynamic_slice_in_dim(vw_pad, q0, Q_BLOCK + NSA_WINDOW, axis=1)
        pos_w = q0 - NSA_WINDOW + jnp.arange(Q_BLOCK + NSA_WINDOW)
        dist_w = qpos[:, None] - pos_w[None, :]
        m_w = (dist_w >= 0) & (dist_w < NSA_WINDOW) & (pos_w[None, :] >= 0)
        s_w = jnp.einsum('bhqd,bkd->bhqk', qb, k_w).astype(jnp.float32) * scale - slopes[:, None, None] * dist_w.astype(jnp.float32)
        p_w = jax.nn.softmax(jnp.where(m_w, s_w, NEG), axis=-1).astype(v_w.dtype)
        o_w = jnp.einsum('bhqk,bkd->bhqd', p_w, v_w)
        return gb[..., 0:1] * o_c + gb[..., 1:2] * o_s + gb[..., 2:3] * o_w

    return merge_heads(sweep_query_blocks(block, s_len))


def memory_cross_attention(q_mem, mem, w_mem_kv):
    q = heads(q_mem, N_MEM_HEADS)
    k, v = jnp.split(mem @ w_mem_kv, 2, axis=-1)
    k, v = heads(k, N_MEM_HEADS), heads(v, N_MEM_HEADS)
    s = jnp.einsum('bhqd,bhkd->bhqk', q, k).astype(jnp.float32) * (HEAD_DIM ** -0.5)
    p = jax.nn.softmax(s, axis=-1).astype(v.dtype)
    return merge_heads(jnp.einsum('bhqk,bhkd->bhqd', p, v))


def hybrid_mixer(x, mem, w_in, g_cq, g_ckv, w_uq, w_ukv, nsa_pe, w_phi_k1, w_phi_k2, w_phi_v1, w_phi_v2,
                 w_mem_kv, w_br, w_gate, b_gate, w_out):
    h = x @ w_in
    h_sb, h_moba, c_q, c_kv, k_rope_in, q_nsa, kv_nsa, g_nsa, q_mem = jnp.split(h, IN_SPLITS, axis=-1)
    q, k, v = jnp.split(h_sb, 3, axis=-1)
    o_sb = merge_heads(stick_breaking_attention(heads(q, N_SB_HEADS), heads(k, N_SB_HEADS), heads(v, N_SB_HEADS)))
    q, k, v = jnp.split(h_moba, 3, axis=-1)
    o_moba = merge_heads(moba_attention(heads(q, N_MOBA_HEADS), heads(k, N_MOBA_HEADS), heads(v, N_MOBA_HEADS),
                                        alibi_slopes(N_MOBA_HEADS)))
    o_mla = mla_attention(c_q, c_kv, k_rope_in, g_cq, g_ckv, w_uq, w_ukv)
    o_nsa = nsa_attention(heads(q_nsa, N_NSA_HEADS), kv_nsa, g_nsa, nsa_pe, w_phi_k1, w_phi_k2, w_phi_v1, w_phi_v2,
                          alibi_slopes(N_NSA_HEADS))
    o_mem = memory_cross_attention(q_mem, mem, w_mem_kv)
    merged = jnp.zeros_like(x)
    for i, o in enumerate((o_sb, o_moba, o_mla, o_nsa, o_mem)):
        gate = jax.nn.sigmoid(x @ w_gate[i] + b_gate[i])
        merged = merged + gate * (o @ w_br[i])
    return merged @ w_out


def hierarchical_moe(x, w_rg, b_rg, w_re, b_re, w_up, w_down):
    b, s_len, d = x.shape
    xt = x.reshape(b * s_len, d)
    glog = (xt @ w_rg + b_rg).astype(jnp.float32)
    pg = jax.nn.softmax(glog, axis=-1)
    g_sel = jnp.argmax(glog, axis=-1)
    g_oh = jax.nn.one_hot(g_sel, N_GROUPS, dtype=jnp.float32)
    pg_sel = jnp.sum(pg * g_oh, axis=-1)
    elog_all = (jnp.einsum('td,gde->tge', xt, w_re) + b_re).astype(jnp.float32)
    elog = jnp.einsum('tge,tg->te', elog_all, g_oh)
    pe = jax.nn.softmax(elog, axis=-1)
    val, idx = lax.top_k(pe, TOPK_IN_GROUP)
    weight = pg_sel[:, None] * val / jnp.sum(val, axis=-1, keepdims=True)
    expert_id = g_sel[:, None] * EXPERTS_PER_GROUP + idx
    gate_dense = jnp.sum(jax.nn.one_hot(expert_id, N_EXPERTS, dtype=jnp.float32) * weight[..., None], axis=1).astype(x.dtype)
    y = jnp.zeros_like(xt)
    for e in range(N_EXPERTS):
        a, u = jnp.split(xt @ w_up[e], 2, axis=-1)
        y = y + gate_dense[:, e:e + 1] * ((jax.nn.silu(a) * u) @ w_down[e])
    return y.reshape(b, s_len, d)


def setup_inputs(seed: int = 0) -> dict:
    key = jax.random.key(seed)
    ks = jax.random.split(key, 27)
    L = DEPTH

    def nrm(k, shape, scale):
        return jax.random.normal(k, shape, jnp.float32) * scale

    def gain(k, shape):
        return 1.0 + 0.02 * jax.random.normal(k, shape, jnp.float32)

    return {
        'x': nrm(ks[0], (BATCH, SEQ, D_MODEL), 1.0),
        'mem': nrm(ks[1], (BATCH, MEM_LEN, D_MODEL), 1.0),
        'w_in': nrm(ks[2], (L, D_MODEL, IN_TOTAL), D_MODEL ** -0.5),
        'g_cq': gain(ks[3], (L, MLA_Q_RANK)),
        'g_ckv': gain(ks[4], (L, MLA_KV_RANK)),
        'w_uq': nrm(ks[5], (L, MLA_Q_RANK, N_MLA_HEADS * (MLA_NOPE + MLA_ROPE)), MLA_Q_RANK ** -0.5),
        'w_ukv': nrm(ks[6], (L, MLA_KV_RANK, N_MLA_HEADS * (MLA_NOPE + MLA_V)), MLA_KV_RANK ** -0.5),
        'nsa_pe': nrm(ks[7], (L, NSA_CMP_LEN, HEAD_DIM), 0.1),
        'w_phi_k1': nrm(ks[8], (L, NSA_CMP_LEN * HEAD_DIM, NSA_PHI_HIDDEN), (NSA_CMP_LEN * HEAD_DIM) ** -0.5),
        'w_phi_k2': nrm(ks[9], (L, NSA_PHI_HIDDEN, HEAD_DIM), NSA_PHI_HIDDEN ** -0.5),
        'w_phi_v1': nrm(ks[10], (L, NSA_CMP_LEN * HEAD_DIM, NSA_PHI_HIDDEN), (NSA_CMP_LEN * HEAD_DIM) ** -0.5),
        'w_phi_v2': nrm(ks[11], (L, NSA_PHI_HIDDEN, HEAD_DIM), NSA_PHI_HIDDEN ** -0.5),
        'w_mem_kv': nrm(ks[12], (L, D_MODEL, 2 * N_MEM_HEADS * HEAD_DIM), D_MODEL ** -0.5),
        'w_br': nrm(ks[13], (L, N_BRANCHES, BRANCH_W, D_MODEL), DEEPNORM_BETA * BRANCH_W ** -0.5),
        'w_gate': nrm(ks[14], (L, N_BRANCHES, D_MODEL, D_MODEL), D_MODEL ** -0.5),
        'b_gate': nrm(ks[15], (L, N_BRANCHES, D_MODEL), 0.02),
        'w_out': nrm(ks[16], (L, D_MODEL, D_MODEL), DEEPNORM_BETA * D_MODEL ** -0.5),
        'ln1_g': gain(ks[17], (L, D_MODEL)),
        'ln1_b': nrm(ks[18], (L, D_MODEL), 0.02),
        'w_rg': nrm(ks[19], (L, D_MODEL, N_GROUPS), D_MODEL ** -0.5),
        'b_rg': nrm(ks[20], (L, N_GROUPS), 0.01),
        'w_re': nrm(ks[21], (L, N_GROUPS, D_MODEL, EXPERTS_PER_GROUP), D_MODEL ** -0.5),
        'b_re': nrm(ks[22], (L, N_GROUPS, EXPERTS_PER_GROUP), 0.01),
        'w_up': nrm(ks[23], (L, N_EXPERTS, D_MODEL, 2 * D_EXPERT), D_MODEL ** -0.5),
        'w_down': nrm(ks[24], (L, N_EXPERTS, D_EXPERT, D_MODEL), DEEPNORM_BETA * D_EXPERT ** -0.5),
        'ln2_g': gain(ks[25], (L, D_MODEL)),
        'ln2_b': nrm(ks[26], (L, D_MODEL), 0.02),
    }


def reference(x, mem, w_in, g_cq, g_ckv, w_uq, w_ukv, nsa_pe, w_phi_k1, w_phi_k2, w_phi_v1, w_phi_v2,
              w_mem_kv, w_br, w_gate, b_gate, w_out, ln1_g, ln1_b, w_rg, b_rg, w_re, b_re, w_up, w_down,
              ln2_g, ln2_b):
    s_len = x.shape[1]
    s_pad = -(-s_len // MOBA_BLOCK) * MOBA_BLOCK
    h = jnp.pad(x, ((0, 0), (0, s_pad - s_len), (0, 0)))
    for l in range(DEPTH):
        y = hybrid_mixer(h, mem, w_in[l], g_cq[l], g_ckv[l], w_uq[l], w_ukv[l], nsa_pe[l],
                         w_phi_k1[l], w_phi_k2[l], w_phi_v1[l], w_phi_v2[l], w_mem_kv[l],
                         w_br[l], w_gate[l], b_gate[l], w_out[l])
        h = layer_norm(DEEPNORM_ALPHA * h + y, ln1_g[l], ln1_b[l])
        y = hierarchical_moe(h, w_rg[l], b_rg[l], w_re[l], b_re[l], w_up[l], w_down[l])
        h = layer_norm(DEEPNORM_ALPHA * h + y, ln2_g[l], ln2_b[l])
    return h[:, :s_len]
```

```cpp
#include <hip/hip_runtime.h>
#include <stdint.h>

#ifndef N_LAUNCH_MODE
#define N_LAUNCH_MODE 0
#endif

typedef unsigned short bf16_t;
typedef short bf16x8 __attribute__((ext_vector_type(8)));
typedef short s16x4 __attribute__((ext_vector_type(4)));
typedef short v4i16_t __attribute__((ext_vector_type(4)));
typedef float f32x16 __attribute__((ext_vector_type(16)));
typedef float f32x4 __attribute__((ext_vector_type(4)));
typedef float f32x2 __attribute__((ext_vector_type(2)));
typedef unsigned u32x4 __attribute__((ext_vector_type(4)));
typedef unsigned u32x2 __attribute__((ext_vector_type(2)));
typedef __bf16 bf16x2_t __attribute__((ext_vector_type(2)));
#define LAS __attribute__((address_space(3)))
#define DI __device__ __forceinline__

constexpr int NB = 4, S = 8192, DM = 1024, NL = 4, T = NB * S;
constexpr int PW = 2944;
constexpr int C_SBQ = 0, C_SBK = 256, C_SBV = 512, C_MBQ = 768, C_MBK = 1024, C_MBV = 1280, C_CQ = 1536, C_CKV = 1792, C_KR = 1920,
              C_NQ = 1952, C_NKV = 2208, C_QM = 2592, C_GN = 2848;
constexpr int OBW = 1280;
constexpr int QMW = 384, MKW = 640;
constexpr float LOG2E = 1.4426950408889634f, LN2 = 0.6931471805599453f;
constexpr float ALPHA = 1.681792830507429f;
constexpr int NTHR = 256;
constexpr int LDS_BYTES = 49152;

constexpr size_t W_IN = 0, W_UQ = W_IN + (size_t)PW * 1024, W_UKV = W_UQ + 384 * 256, W_PHI1 = W_UKV + 512 * 128, W_PHI2 = W_PHI1 + 2 * 128 * 2048,
                 W_MEM = W_PHI2 + 2 * 128 * 128, W_BR = W_MEM + 512 * 1024, W_G = W_BR + 5 * 1024 * 256, W_OUT = W_G + 5 * 1024 * 1024,
                 W_UP = W_OUT + 1024 * 1024, W_DN = W_UP + 16 * 512 * 1024, W_END = W_DN + 16 * 1024 * 256;

constexpr size_t MiB = 1u << 20;
constexpr size_t WS_CTL = 0;
constexpr size_t WS_HB = 1 * MiB;
constexpr size_t WS_P = WS_HB + 64 * MiB;
constexpr size_t WS_MG = WS_P;
constexpr size_t WS_ACT = WS_P + 64 * MiB;
constexpr size_t WS_OB = WS_P + 184 * MiB;
constexpr size_t WS_QM = WS_OB + 80 * MiB;
constexpr size_t WS_MK = WS_QM + 24 * MiB;
constexpr size_t WS_W = WS_MK + 40 * MiB;
constexpr size_t WS_MEMB = WS_W + 47 * MiB;
constexpr size_t WS_MEMKV = WS_MEMB + 2 * MiB;
constexpr size_t WS_HC = WS_MEMKV + 1 * MiB;
constexpr size_t WS_KC = WS_HC + 1 * MiB;
constexpr size_t WS_KMEAN = WS_KC + 1 * MiB;
constexpr size_t WS_CPART = WS_KMEAN + 1 * MiB;
constexpr size_t WS_LTOK = WS_CPART + 1 * MiB;
constexpr size_t WS_LW = WS_LTOK + 3 * MiB;
constexpr size_t WS_STASH = WS_LW + 6 * MiB;
constexpr size_t WS_END = WS_STASH + 16 * MiB;
static_assert(WS_END <= 480 * MiB, "workspace map");
static_assert(W_END * 2 <= 47 * MiB, "weights");
constexpr int CW_Q = 64;
constexpr int CW_CNT = 256;
constexpr int CW_BAR = 1024;

struct Params { const float* in[27]; float* out; unsigned char* ws; };

DI unsigned cvtpk(float lo, float hi) { f32x2 v = {lo, hi}; bf16x2_t b = __builtin_convertvector(v, bf16x2_t); return __builtin_bit_cast(unsigned, b); }
DI float bf2f(unsigned short x) { return __builtin_bit_cast(float, (unsigned)x << 16); }
DI float bflo(unsigned u) { return __builtin_bit_cast(float, u << 16); }
DI float bfhi(unsigned u) { return __builtin_bit_cast(float, u & 0xffff0000u); }
DI f32x16 mfma(bf16x8 a, bf16x8 b, f32x16 c) { return __builtin_amdgcn_mfma_f32_32x32x16_bf16(a, b, c, 0, 0, 0); }
DI float ex2(float x) { return __builtin_amdgcn_exp2f(x); }
DI float lg2(float x) { return __builtin_amdgcn_logf(x); }
DI float wave_sum(float v) {
#pragma unroll
    for (int o = 32; o >= 1; o >>= 1) v += __shfl_xor(v, o);
    return v;
}
DI s16x4 vtr(const bf16_t* p) { return __builtin_bit_cast(s16x4, __builtin_amdgcn_ds_read_tr16_b64_v4i16((LAS v4i16_t*)(LAS char*)(p))); }
DI int opaque_tid() { int t = threadIdx.x; asm volatile("" : "+v"(t)); return t; }
DI f32x16 zero16() { f32x16 z;
#pragma unroll
    for (int i = 0; i < 16; ++i) z[i] = 0.f; return z; }

constexpr int GP = 72;
DI void gemm_kloop(f32x16 (&acc)[2][2], const bf16_t* a0, const bf16_t* a1, const bf16_t* a2, const bf16_t* a3, size_t a_kstride,
                   const bf16_t* bbase, size_t ldb, int nk, char* lds) {
    const int tid = opaque_tid(), lane = tid & 63, w = tid >> 6, r = lane & 31, h = lane >> 5, wr = w >> 1, wc = w & 1;
    bf16_t* As = (bf16_t*)lds; bf16_t* Bs = (bf16_t*)(lds + 128 * GP * 2);
    const int srow = tid >> 3, scol = (tid & 7) * 8;
    const bf16_t* b0 = bbase + (size_t)(srow) * ldb + scol;
    const bf16_t* b1 = bbase + (size_t)(srow + 32) * ldb + scol;
    const bf16_t* b2 = bbase + (size_t)(srow + 64) * ldb + scol;
    const bf16_t* b3 = bbase + (size_t)(srow + 96) * ldb + scol;
    uint4 ra0 = *(const uint4*)a0, ra1 = *(const uint4*)a1, ra2 = *(const uint4*)a2, ra3 = *(const uint4*)a3;
    uint4 rb0 = *(const uint4*)b0, rb1 = *(const uint4*)b1, rb2 = *(const uint4*)b2, rb3 = *(const uint4*)b3;
    for (int kt = 0; kt < nk; ++kt) {
        __syncthreads();
        *(uint4*)(As + (srow) * GP + scol) = ra0; *(uint4*)(As + (srow + 32) * GP + scol) = ra1;
        *(uint4*)(As + (srow + 64) * GP + scol) = ra2; *(uint4*)(As + (srow + 96) * GP + scol) = ra3;
        *(uint4*)(Bs + (srow) * GP + scol) = rb0; *(uint4*)(Bs + (srow + 32) * GP + scol) = rb1;
        *(uint4*)(Bs + (srow + 64) * GP + scol) = rb2; *(uint4*)(Bs + (srow + 96) * GP + scol) = rb3;
        __syncthreads();
        if (kt + 1 < nk) {
            const size_t ao = (size_t)(kt + 1) * a_kstride; const size_t bo = (size_t)(kt + 1) * 64;
            ra0 = *(const uint4*)(a0 + ao); ra1 = *(const uint4*)(a1 + ao); ra2 = *(const uint4*)(a2 + ao); ra3 = *(const uint4*)(a3 + ao);
            rb0 = *(const uint4*)(b0 + bo); rb1 = *(const uint4*)(b1 + bo); rb2 = *(const uint4*)(b2 + bo); rb3 = *(const uint4*)(b3 + bo);
        }
#pragma unroll
        for (int ks = 0; ks < 4; ++ks) {
            const bf16x8 fa0 = *(const bf16x8*)(As + (64 * wr + r) * GP + 16 * ks + 8 * h);
            const bf16x8 fa1 = *(const bf16x8*)(As + (64 * wr + 32 + r) * GP + 16 * ks + 8 * h);
            const bf16x8 fb0 = *(const bf16x8*)(Bs + (64 * wc + r) * GP + 16 * ks + 8 * h);
            const bf16x8 fb1 = *(const bf16x8*)(Bs + (64 * wc + 32 + r) * GP + 16 * ks + 8 * h);
            acc[0][0] = mfma(fb0, fa0, acc[0][0]); acc[0][1] = mfma(fb1, fa0, acc[0][1]);
            acc[1][0] = mfma(fb0, fa1, acc[1][0]); acc[1][1] = mfma(fb1, fa1, acc[1][1]);
        }
    }
}
DI void zero_acc(f32x16 (&acc)[2][2]) { acc[0][0] = zero16(); acc[0][1] = zero16(); acc[1][0] = zero16(); acc[1][1] = zero16(); }

constexpr int VP = 72;
template <int DQK> struct KVRegs { u32x4 k[DQK / 32]; u32x4 v[2]; };
template <int DQK> DI void kv_load(KVRegs<DQK>& R, const bf16_t* kbase, size_t kpitch, const bf16_t* vbase, size_t vpitch, int t, int keymax) {
    const int tid = threadIdx.x; int key = 64 * t + (tid >> 2); key = key > keymax ? keymax : key;
    const bf16_t* kp = kbase + (size_t)key * kpitch + (tid & 3) * (DQK / 4);
#pragma unroll
    for (int i = 0; i < DQK / 32; ++i) R.k[i] = *(const u32x4*)(kp + 8 * i);
    const bf16_t* vp = vbase + (size_t)key * vpitch + (tid & 3) * 16;
    R.v[0] = *(const u32x4*)vp; R.v[1] = *(const u32x4*)(vp + 8);
}
template <int DQK> DI void kv_store(const KVRegs<DQK>& R, char* lds) {
    constexpr int KP = DQK + 8; const int tid = threadIdx.x;
    bf16_t* Ks = (bf16_t*)lds; bf16_t* Vs = (bf16_t*)(lds + 64 * KP * 2);
    bf16_t* kp = Ks + (tid >> 2) * KP + (tid & 3) * (DQK / 4);
#pragma unroll
    for (int i = 0; i < DQK / 32; ++i) *(u32x4*)(kp + 8 * i) = R.k[i];
    bf16_t* vp = Vs + (tid >> 2) * VP + (tid & 3) * 16;
    *(u32x4*)vp = R.v[0]; *(u32x4*)(vp + 8) = R.v[1];
}
template <int DQK> DI void qk_tile(f32x16 (&s)[2], const bf16x8 (&qf)[DQK / 16], const char* lds) {
    constexpr int KP = DQK + 8; const int lane = threadIdx.x & 63, r = lane & 31, h = lane >> 5;
    const bf16_t* Ks = (const bf16_t*)lds;
#pragma unroll
    for (int kh = 0; kh < 2; ++kh) {
        s[kh] = zero16();
#pragma unroll
        for (int ks = 0; ks < DQK / 16; ++ks) {
            const bf16x8 kf = *(const bf16x8*)(Ks + (32 * kh + r) * KP + 16 * ks + 8 * h);
            s[kh] = mfma(kf, qf[ks], s[kh]);
        }
    }
}
template <int DQK> DI void pv_tile(f32x16 (&o)[2], const f32x16 (&p)[2], const char* lds) {
    constexpr int KP = DQK + 8; const int lane = threadIdx.x & 63, h = lane >> 5;
    const bf16_t* Vs = (const bf16_t*)(lds + 64 * KP * 2);
    const int q4 = (lane & 15) >> 2, p4 = lane & 3, blk = (lane >> 4) & 1;
    const bf16_t* vb = Vs + (4 * h + q4) * VP + 16 * blk + 4 * p4;
#pragma unroll
    for (int kh = 0; kh < 2; ++kh)
#pragma unroll
        for (int st = 0; st < 2; ++st) {
            u32x4 pk;
            pk[0] = cvtpk(p[kh][8 * st + 0], p[kh][8 * st + 1]); pk[1] = cvtpk(p[kh][8 * st + 2], p[kh][8 * st + 3]);
            pk[2] = cvtpk(p[kh][8 * st + 4], p[kh][8 * st + 5]); pk[3] = cvtpk(p[kh][8 * st + 6], p[kh][8 * st + 7]);
            const bf16x8 pf = __builtin_bit_cast(bf16x8, pk);
#pragma unroll
            for (int db = 0; db < 2; ++db) {
                const bf16_t* vp = vb + (32 * kh + 16 * st) * VP + 32 * db;
                const s16x4 lo = vtr(vp), hi = vtr(vp + 8 * VP);
                const bf16x8 vf = __builtin_shufflevector(lo, hi, 0, 1, 2, 3, 4, 5, 6, 7);
                o[db] = mfma(vf, pf, o[db]);
            }
        }
}
template <int DQK, class Pol> DI void flash_tile(const bf16x8 (&qf)[DQK / 16], const char* lds, int t, const Pol& pol, float& m, float& l, f32x16 (&o)[2]) {
    const int lane = threadIdx.x & 63, h = lane >> 5;
    f32x16 s[2];
    qk_tile<DQK>(s, qf, lds);
    float mx = -1e30f;
#pragma unroll
    for (int kh = 0; kh < 2; ++kh)
#pragma unroll
        for (int i = 0; i < 16; ++i) {
            const float v = pol.score(s[kh][i], 32 * kh + 8 * (i >> 2) + (i & 3));
            s[kh][i] = v; mx = fmaxf(mx, v);
        }
    mx = fmaxf(mx, __shfl_xor(mx, 32));
    const float mn = fmaxf(m, mx);
    const float alpha = ex2(m - mn);
    m = mn;
    float rs = 0.f;
#pragma unroll
    for (int kh = 0; kh < 2; ++kh)
#pragma unroll
        for (int i = 0; i < 16; ++i) { const float p = ex2(s[kh][i] - mn); s[kh][i] = p; rs += p; }
    l = l * alpha + rs;
#pragma unroll
    for (int i = 0; i < 16; ++i) { o[0][i] *= alpha; o[1][i] *= alpha; }
    pv_tile<DQK>(o, s, lds);
}
template <int DQK, class Pol, class Need>
DI void flash_pass(const bf16x8 (&qf)[DQK / 16], const bf16_t* kbase, size_t kpitch, const bf16_t* vbase, size_t vpitch, int keymax,
                   int t_lo, int t_hi, Need need, int wave_tmax, Pol& pol, float& m, float& l, f32x16 (&o)[2], char* lds) {
    KVRegs<DQK> R;
    int t = t_lo; while (t < t_hi && !need(t)) ++t;
    if (t < t_hi) kv_load<DQK>(R, kbase, kpitch, vbase, vpitch, t, keymax);
    while (t < t_hi) {
        int tn = t + 1; while (tn < t_hi && !need(tn)) ++tn;
        __syncthreads();
        kv_store<DQK>(R, lds);
        __syncthreads();
        if (tn < t_hi) kv_load<DQK>(R, kbase, kpitch, vbase, vpitch, tn, keymax);
        if (t <= wave_tmax) { pol.prep(t); flash_tile<DQK, Pol>(qf, lds, t, pol, m, l, o); }
        t = tn;
    }
}
struct NeedAll { DI bool operator()(int) const { return true; } };
struct NeedBits128 { unsigned long long lo, hi; DI bool operator()(int t) const { const unsigned long long w = t < 64 ? lo : hi; return (w >> (t & 63)) & 1ull; } };
struct NeedBlk4 { unsigned u; DI bool operator()(int t) const { return (u >> (t >> 2)) & 1u; } };

struct PolCausal { int qpos; float sc2; int lim; DI void prep(int t) { lim = qpos - 64 * t - 4 * (int)((threadIdx.x & 63) >> 5); }
    DI float score(float d, int koff) const { return koff <= lim ? d * sc2 : -1e30f; } };
struct PolMem { float sc2; DI void prep(int) {} DI float score(float d, int) const { return d * sc2; } };
struct PolMoba { int qpos; float sc2, sl2; unsigned mask; int lim; float base;
    DI void prep(int t) { const int kb = 64 * t + 4 * (int)((threadIdx.x & 63) >> 5); lim = ((mask >> (t >> 2)) & 1u) ? qpos - kb : -1; base = sl2 * (float)(kb - qpos); }
    DI float score(float d, int koff) const { return koff <= lim ? fmaf(d, sc2, fmaf(sl2, (float)koff, base)) : -1e30f; } };
struct PolCmp { int qpos; float sc2, sl2; int lim; float base;
    DI void prep(int t) { const int kb = 64 * t + 4 * (int)((threadIdx.x & 63) >> 5); const int klim = (qpos - 31) >> 4; const int l1 = klim - kb, l2 = 510 - kb; lim = l1 < l2 ? l1 : l2; base = sl2 * (float)(16 * kb + 31 - qpos); }
    DI float score(float d, int koff) const { return koff <= lim ? fmaf(d, sc2, fmaf(16.f * sl2, (float)koff, base)) : -1e30f; } };
struct PolSel { int qpos; float sc2, sl2; unsigned long long mlo, mhi; int lim; float base;
    DI void prep(int t) { const int kb = 64 * t + 4 * (int)((threadIdx.x & 63) >> 5); const unsigned long long w = t < 64 ? mlo : mhi; lim = ((w >> (t & 63)) & 1ull) ? qpos - kb : -1; base = sl2 * (float)(kb - qpos); }
    DI float score(float d, int koff) const { return koff <= lim ? fmaf(d, sc2, fmaf(sl2, (float)koff, base)) : -1e30f; } };
struct PolWin { int qpos; float sc2, sl2; int lim; float base;
    DI void prep(int t) { const int kb = 64 * t + 4 * (int)((threadIdx.x & 63) >> 5); lim = qpos - kb; base = sl2 * (float)(kb - qpos); }
    DI float score(float d, int koff) const { return (koff <= lim && koff > lim - 512) ? fmaf(d, sc2, fmaf(sl2, (float)koff, base)) : -1e30f; } };

DI void write_o(bf16_t* orow, const f32x16 (&o)[2]) {
    const int h = (threadIdx.x & 63) >> 5;
#pragma unroll
    for (int db = 0; db < 2; ++db)
#pragma unroll
        for (int g = 0; g < 4; ++g) {
            u32x2 wv; wv[0] = cvtpk(o[db][4 * g], o[db][4 * g + 1]); wv[1] = cvtpk(o[db][4 * g + 2], o[db][4 * g + 3]);
            *(u32x2*)(orow + 32 * db + 8 * g + 4 * h) = wv;
        }
}
DI void load_q64(bf16x8 (&qf)[4], const bf16_t* qrow) { const int h = (threadIdx.x & 63) >> 5;
#pragma unroll
    for (int ks = 0; ks < 4; ++ks) qf[ks] = *(const bf16x8*)(qrow + 16 * ks + 8 * h); }

struct Ctx {
    const Params* p; int layer; char* lds;
    DI const float* in(int i) const { return p->in[i]; }
    DI unsigned char* ws() const { return p->ws; }
    DI bf16_t* HB() const { return (bf16_t*)(p->ws + WS_HB); }
    DI bf16_t* P() const { return (bf16_t*)(p->ws + WS_P); }
    DI bf16_t* MG() const { return (bf16_t*)(p->ws + WS_MG); }
    DI bf16_t* ACT() const { return (bf16_t*)(p->ws + WS_ACT); }
    DI bf16_t* OB() const { return (bf16_t*)(p->ws + WS_OB); }
    DI bf16_t* QM() const { return (bf16_t*)(p->ws + WS_QM); }
    DI bf16_t* MK() const { return (bf16_t*)(p->ws + WS_MK); }
    DI bf16_t* W() const { return (bf16_t*)(p->ws + WS_W); }
    DI bf16_t* MEMB() const { return (bf16_t*)(p->ws + WS_MEMB); }
    DI bf16_t* MEMKV() const { return (bf16_t*)(p->ws + WS_MEMKV); }
    DI bf16_t* HC() const { return (bf16_t*)(p->ws + WS_HC); }
    DI bf16_t* KC() const { return (bf16_t*)(p->ws + WS_KC); }
    DI float* KMEAN() const { return (float*)(p->ws + WS_KMEAN); }
    DI float* CPART() const { return (float*)(p->ws + WS_CPART); }
    DI float* CBIAS() const { return (float*)(p->ws + WS_CPART + 32768); }
    DI int* LTOK() const { return (int*)(p->ws + WS_LTOK); }
    DI float* LW() const { return (float*)(p->ws + WS_LW); }
    DI unsigned* CTL() const { return (unsigned*)(p->ws + WS_CTL); }
    DI const float* hsrc() const { return layer == 0 ? p->in[0] : p->out; }
};

DI void phase_prologue(const Ctx& c) {
    const size_t gt = (size_t)blockIdx.x * NTHR + threadIdx.x, gs = (size_t)gridDim.x * NTHR;
    const float* x = c.in(0); bf16_t* hb = c.HB();
    for (size_t i = gt; i < (size_t)T * DM / 8; i += gs) {
        const f32x4 a = *(const f32x4*)(x + i * 8), b = *(const f32x4*)(x + i * 8 + 4);
        u32x4 o; o[0] = cvtpk(a[0], a[1]); o[1] = cvtpk(a[2], a[3]); o[2] = cvtpk(b[0], b[1]); o[3] = cvtpk(b[2], b[3]);
        *(u32x4*)(hb + i * 8) = o;
    }
    const float* mem = c.in(1); bf16_t* mb = c.MEMB();
    for (size_t i = gt; i < (size_t)1024 * 1024 / 8; i += gs) {
        const f32x4 a = *(const f32x4*)(mem + i * 8), b = *(const f32x4*)(mem + i * 8 + 4);
        u32x4 o; o[0] = cvtpk(a[0], a[1]); o[1] = cvtpk(a[2], a[3]); o[2] = cvtpk(b[0], b[1]); o[3] = cvtpk(b[2], b[3]);
        *(u32x4*)(mb + i * 8) = o;
    }
}

DI void conv_tile(const float* src, int ld_src, bf16_t* dst, int K, int kt, int nt, int kind, const float* gain, char* lds) {
    float* tile = (float*)lds; const int tid = threadIdx.x;
    const int k0 = kt * 64, n0 = nt * 64;
    __syncthreads();
    {
        const int nl = tid & 63; const int np = n0 + nl; int ns = np; bool valid = true;
        if (kind == 1) { if (np < 2592) ns = np; else if (np < 2848) ns = np + 12; else if (np < 2860) ns = np - 256; else valid = false; }
        else if (kind == 2) { const int j = np >> 6, cc = np & 63; ns = cc < 32 ? 32 * j + cc : 256 + 32 * j + cc - 32; }
        else if (kind == 3) { valid = np < 64; }
#pragma unroll
        for (int i = 0; i < 16; ++i) {
            const int kl = (tid >> 6) + 4 * i;
            float v = valid ? src[(size_t)(k0 + kl) * ld_src + ns] : 0.f;
            if (gain) v *= gain[k0 + kl];
            tile[kl * 65 + nl] = v;
        }
    }
    __syncthreads();
    {
        const int kl = tid & 63;
#pragma unroll
        for (int i = 0; i < 16; ++i) {
            const int nl = (tid >> 6) + 4 * i;
            const float v = tile[kl * 65 + nl];
            dst[(size_t)(n0 + nl) * K + k0 + kl] = (bf16_t)(cvtpk(v, v) & 0xffffu);
        }
    }
}
DI bool conv_job(int& t, const float* src, int ld_src, bf16_t* dst, int K, int N, int kind, const float* gain, char* lds) {
    const int nkt = K / 64, cnt = nkt * (N / 64);
    if (t < cnt) { conv_tile(src, ld_src, dst, K, t % nkt, t / nkt, kind, gain, lds); return true; }
    t -= cnt; return false;
}
DI void phase_weights(const Ctx& c) {
    const int l = c.layer; bf16_t* W = c.W(); char* lds = c.lds;
    constexpr int NT_IN = 16 * 46, NT_UQ = 4 * 6, NT_UKV = 2 * 8, NT_P1 = 32 * 2, NT_P2 = 2 * 2, NT_MEM = 16 * 8, NT_BR = 4 * 16, NT_G = 16 * 16, NT_OUT = 256, NT_UP = 16 * 8, NT_DN = 4 * 16;
    constexpr int TOTAL = NT_IN + NT_UQ + NT_UKV + 2 * NT_P1 + 2 * NT_P2 + NT_MEM + 5 * NT_BR + 5 * NT_G + NT_OUT + 16 * NT_UP + 16 * NT_DN + 64;
    for (int item = blockIdx.x; item < TOTAL; item += gridDim.x) {
        int t = item;
        if (conv_job(t, c.in(2) + (size_t)l * 1024 * 2860, 2860, W + W_IN, 1024, PW, 1, nullptr, lds)) continue;
        if (conv_job(t, c.in(5) + (size_t)l * 256 * 384, 384, W + W_UQ, 256, 384, 0, c.in(3) + l * 256, lds)) continue;
        if (conv_job(t, c.in(6) + (size_t)l * 128 * 512, 512, W + W_UKV, 128, 512, 0, c.in(4) + l * 128, lds)) continue;
        if (conv_job(t, c.in(8) + (size_t)l * 2048 * 128, 128, W + W_PHI1, 2048, 128, 0, nullptr, lds)) continue;
        if (conv_job(t, c.in(10) + (size_t)l * 2048 * 128, 128, W + W_PHI1 + 128 * 2048, 2048, 128, 0, nullptr, lds)) continue;
        if (conv_job(t, c.in(9) + (size_t)l * 128 * 64, 64, W + W_PHI2, 128, 128, 3, nullptr, lds)) continue;
        if (conv_job(t, c.in(11) + (size_t)l * 128 * 64, 64, W + W_PHI2 + 128 * 128, 128, 128, 3, nullptr, lds)) continue;
        if (conv_job(t, c.in(12) + (size_t)l * 1024 * 512, 512, W + W_MEM, 1024, 512, 0, nullptr, lds)) continue;
        if (t < 5 * NT_BR) { const int i = t / NT_BR; int tt = t % NT_BR; conv_job(tt, c.in(13) + ((size_t)l * 5 + i) * 256 * 1024, 1024, W + W_BR + (size_t)i * 1024 * 256, 256, 1024, 0, nullptr, lds); continue; }
        t -= 5 * NT_BR;
        if (t < 5 * NT_G) { const int i = t / NT_G; int tt = t % NT_G; conv_job(tt, c.in(14) + ((size_t)l * 5 + i) * 1024 * 1024, 1024, W + W_G + (size_t)i * 1024 * 1024, 1024, 1024, 0, nullptr, lds); continue; }
        t -= 5 * NT_G;
        if (conv_job(t, c.in(16) + (size_t)l * 1024 * 1024, 1024, W + W_OUT, 1024, 1024, 0, nullptr, lds)) continue;
        if (t < 16 * NT_UP) { const int e = t / NT_UP; int tt = t % NT_UP; conv_job(tt, c.in(23) + ((size_t)l * 16 + e) * 1024 * 512, 512, W + W_UP + (size_t)e * 512 * 1024, 1024, 512, 2, nullptr, lds); continue; }
        t -= 16 * NT_UP;
        if (t < 16 * NT_DN) { const int e = t / NT_DN; int tt = t % NT_DN; conv_job(tt, c.in(24) + ((size_t)l * 16 + e) * 256 * 1024, 1024, W + W_DN + (size_t)e * 1024 * 256, 256, 1024, 0, nullptr, lds); continue; }
        t -= 16 * NT_DN;
        {
            const int kv = t >> 5, pp = t & 31; const int tid = threadIdx.x, j = tid & 127, hh = tid >> 7;
            const float* w1 = c.in(kv ? 10 : 8) + (size_t)l * 2048 * 128; const float* pe = c.in(7) + (size_t)l * 2048;
            float s = 0.f;
            for (int k = pp * 64 + hh * 32; k < pp * 64 + hh * 32 + 32; ++k) s += pe[k] * w1[(size_t)k * 128 + j];
            float* red = (float*)lds;
            __syncthreads();
            if (hh) red[j] = s;
            __syncthreads();
            if (!hh) c.CPART()[(kv * 32 + pp) * 128 + j] = s + red[j];
        }
    }
}

DI void store_bf16_tile(const f32x16 (&acc)[2][2], bf16_t* dst  , size_t ldc) {
    const int tid = threadIdx.x, lane = tid & 63, w = tid >> 6, r = lane & 31, h = lane >> 5, wr = w >> 1, wc = w & 1;
#pragma unroll
    for (int mi = 0; mi < 2; ++mi)
#pragma unroll
        for (int ni = 0; ni < 2; ++ni)
#pragma unroll
            for (int g = 0; g < 4; ++g) {
                u32x2 wv; wv[0] = cvtpk(acc[mi][ni][4 * g], acc[mi][ni][4 * g + 1]); wv[1] = cvtpk(acc[mi][ni][4 * g + 2], acc[mi][ni][4 * g + 3]);
                *(u32x2*)(dst + (size_t)(64 * wr + 32 * mi + r) * ldc + 64 * wc + 32 * ni + 8 * g + 4 * h) = wv;
            }
}
DI void phase_proj(const Ctx& c) {
    const int tid = threadIdx.x, srow = tid >> 3, scol = (tid & 7) * 8;
    if (blockIdx.x == 0) {
        const float* cp = c.CPART(); float s = 0.f; const int kv = tid >> 7, j = tid & 127;
        for (int pp = 0; pp < 32; ++pp) s += cp[(kv * 32 + pp) * 128 + j];
        c.CBIAS()[tid] = s;
    }
    constexpr int NTN = PW / 128, NMAIN = (T / 128) * NTN, TOTAL = NMAIN + 32;
    for (int item = blockIdx.x; item < TOTAL; item += gridDim.x) {
        f32x16 acc[2][2]; zero_acc(acc);
        if (item < NMAIN) {
            const int mt = item / NTN, nt = item % NTN;
            const bf16_t* a = c.HB() + (size_t)(128 * mt + srow) * 1024 + scol;
            gemm_kloop(acc, a, a + 32 * 1024, a + 64 * 1024, a + 96 * 1024, 64, c.W() + W_IN + (size_t)(128 * nt) * 1024, 1024, 16, c.lds);
            store_bf16_tile(acc, c.P() + (size_t)(128 * mt) * PW + 128 * nt, PW);
        } else {
            const int j = item - NMAIN, mt = j >> 2, nt = j & 3;
            const bf16_t* a = c.MEMB() + (size_t)(128 * mt + srow) * 1024 + scol;
            gemm_kloop(acc, a, a + 32 * 1024, a + 64 * 1024, a + 96 * 1024, 64, c.W() + W_MEM + (size_t)(128 * nt) * 1024, 1024, 16, c.lds);
            store_bf16_tile(acc, c.MEMKV() + (size_t)(128 * mt) * 512 + 128 * nt, 512);
        }
    }
}

DI void phase_prep1(const Ctx& c) {
    const int tid = threadIdx.x, lane = tid & 63, w = tid >> 6, r = lane & 31, h = lane >> 5, wr = w >> 1, wc = w & 1;
    const int srow = tid >> 3, scol = (tid & 7) * 8;
    float* rstd = (float*)(c.lds + 40960);
    constexpr int N_C = 32, N_KM = 128, N_Q = 256 * 3, N_KV = 256 * 4, TOTAL = N_C + N_KM + N_Q + N_KV;
    for (int item = blockIdx.x; item < TOTAL; item += gridDim.x) {
        int t = item;
        if (t < N_C) {
            const int kv = t >> 4, mt = t & 15;
            f32x16 acc[2][2]; zero_acc(acc);
            const bf16_t* ap[4];
#pragma unroll
            for (int i = 0; i < 4; ++i) { const int gr = 128 * mt + srow + 32 * i, b = gr >> 9; int n = gr & 511; n = n > 510 ? 510 : n;
                ap[i] = c.P() + (size_t)(b * S + 16 * n) * PW + C_NKV + 64 * kv + scol; }
            gemm_kloop(acc, ap[0], ap[1], ap[2], ap[3], PW, c.W() + W_PHI1 + (size_t)kv * 128 * 2048, 2048, 32, c.lds);
            const float* cb = c.CBIAS() + kv * 128; bf16_t* hc = c.HC() + (size_t)kv * 2048 * 128 + (size_t)(128 * mt) * 128;
#pragma unroll
            for (int mi = 0; mi < 2; ++mi)
#pragma unroll
                for (int ni = 0; ni < 2; ++ni)
#pragma unroll
                    for (int g = 0; g < 4; ++g) {
                        const int col = 64 * wc + 32 * ni + 8 * g + 4 * h; const f32x4 bv = *(const f32x4*)(cb + col);
                        float o4[4];
#pragma unroll
                        for (int e = 0; e < 4; ++e) { const float x = acc[mi][ni][4 * g + e] + bv[e]; const float y = 0.7978845608028654f * (x + 0.044715f * x * x * x);
                            o4[e] = x / (1.f + ex2(-2.f * LOG2E * y)); }
                        u32x2 wv; wv[0] = cvtpk(o4[0], o4[1]); wv[1] = cvtpk(o4[2], o4[3]);
                        *(u32x2*)(hc + (size_t)(64 * wr + 32 * mi + r) * 128 + col) = wv;
                    }
            continue;
        }
        t -= N_C;
        if (t < N_KM) {
            const int b = t >> 5, blk = t & 31;
            const bf16_t* src = c.P() + (size_t)(b * S + blk * 256) * PW + C_MBK + tid;
            float s = 0.f;
            for (int i = 0; i < 256; ++i) s += bf2f(src[(size_t)i * PW]);
            c.KMEAN()[((b * 4 + (tid >> 6)) * 32 + blk) * 64 + (tid & 63)] = s * (1.f / 256.f);
            continue;
        }
        t -= N_KM;
        if (t < N_Q) {
            const int mt = t / 3, ct = t % 3;
            __syncthreads();
            { const int row = tid >> 1, half = tid & 1; const bf16_t* src = c.P() + (size_t)(128 * mt + row) * PW + C_CQ + half * 128; float ss = 0.f;
#pragma unroll
              for (int i = 0; i < 16; ++i) { const u32x4 v = *(const u32x4*)(src + 8 * i);
#pragma unroll
                  for (int e = 0; e < 4; ++e) { const float a = bflo(v[e]), bq = bfhi(v[e]); ss += a * a + bq * bq; } }
              ss += __shfl_xor(ss, 1);
              if (!half) rstd[row] = __builtin_amdgcn_rsqf(ss * (1.f / 256.f) + 1e-6f); }
            f32x16 acc[2][2]; zero_acc(acc);
            const bf16_t* a = c.P() + (size_t)(128 * mt + srow) * PW + C_CQ + scol;
            gemm_kloop(acc, a, a + 32 * (size_t)PW, a + 64 * (size_t)PW, a + 96 * (size_t)PW, 64, c.W() + W_UQ + (size_t)(128 * ct) * 256, 256, 4, c.lds);
            bf16_t* dst = c.QM() + (size_t)(128 * mt) * QMW + 128 * ct;
#pragma unroll
            for (int mi = 0; mi < 2; ++mi) { const float sc = rstd[64 * wr + 32 * mi + r];
#pragma unroll
                for (int ni = 0; ni < 2; ++ni)
#pragma unroll
                    for (int g = 0; g < 4; ++g) {
                        u32x2 wv; wv[0] = cvtpk(acc[mi][ni][4 * g] * sc, acc[mi][ni][4 * g + 1] * sc); wv[1] = cvtpk(acc[mi][ni][4 * g + 2] * sc, acc[mi][ni][4 * g + 3] * sc);
                        *(u32x2*)(dst + (size_t)(64 * wr + 32 * mi + r) * QMW + 64 * wc + 32 * ni + 8 * g + 4 * h) = wv;
                    } }
            continue;
        }
        t -= N_Q;
        {
            const int mt = t >> 2, ct = t & 3;
            __syncthreads();
            { const int row = tid >> 1, half = tid & 1; const bf16_t* src = c.P() + (size_t)(128 * mt + row) * PW + C_CKV + half * 64; float ss = 0.f;
#pragma unroll
              for (int i = 0; i < 8; ++i) { const u32x4 v = *(const u32x4*)(src + 8 * i);
#pragma unroll
                  for (int e = 0; e < 4; ++e) { const float a = bflo(v[e]), bq = bfhi(v[e]); ss += a * a + bq * bq; } }
              ss += __shfl_xor(ss, 1);
              if (!half) rstd[row] = __builtin_amdgcn_rsqf(ss * (1.f / 128.f) + 1e-6f);
              if (ct == 0) {
                  const int tok = 128 * mt + row; const float pos = (float)(tok & (S - 1));
                  const bf16_t* kr = c.P() + (size_t)tok * PW + C_KR + 8 * half;
                  const u32x4 x1 = *(const u32x4*)kr, x2 = *(const u32x4*)(kr + 16);
                  float o1[8], o2[8];
#pragma unroll
                  for (int j = 0; j < 8; ++j) { const int i = 8 * half + j; const float fr = exp2f(-(float)i * (13.287712379549449f / 16.f));
                      float sn, cs; sincosf(pos * fr, &sn, &cs);
                      const float a = (j & 1) ? bfhi(x1[j >> 1]) : bflo(x1[j >> 1]), bq = (j & 1) ? bfhi(x2[j >> 1]) : bflo(x2[j >> 1]);
                      o1[j] = a * cs - bq * sn; o2[j] = a * sn + bq * cs; }
                  u32x4 w1v, w2v;
#pragma unroll
                  for (int j = 0; j < 4; ++j) { w1v[j] = cvtpk(o1[2 * j], o1[2 * j + 1]); w2v[j] = cvtpk(o2[2 * j], o2[2 * j + 1]); }
                  bf16_t* d = c.MK() + (size_t)tok * MKW + 64 + 8 * half;
#pragma unroll
                  for (int hd = 0; hd < 4; ++hd) { *(u32x4*)(d + hd * 160) = w1v; *(u32x4*)(d + hd * 160 + 16) = w2v; }
              } }
            f32x16 acc[2][2]; zero_acc(acc);
            const bf16_t* a = c.P() + (size_t)(128 * mt + srow) * PW + C_CKV + scol;
            gemm_kloop(acc, a, a + 32 * (size_t)PW, a + 64 * (size_t)PW, a + 96 * (size_t)PW, 64, c.W() + W_UKV + (size_t)(128 * ct) * 128, 128, 2, c.lds);
            bf16_t* dst = c.MK() + (size_t)(128 * mt) * MKW + ct * 160 + (wc ? 96 : 0);
#pragma unroll
            for (int mi = 0; mi < 2; ++mi) { const float sc = rstd[64 * wr + 32 * mi + r];
#pragma unroll
                for (int ni = 0; ni < 2; ++ni)
#pragma unroll
                    for (int g = 0; g < 4; ++g) {
                        u32x2 wv; wv[0] = cvtpk(acc[mi][ni][4 * g] * sc, acc[mi][ni][4 * g + 1] * sc); wv[1] = cvtpk(acc[mi][ni][4 * g + 2] * sc, acc[mi][ni][4 * g + 3] * sc);
                        *(u32x2*)(dst + (size_t)(64 * wr + 32 * mi + r) * MKW + 32 * ni + 8 * g + 4 * h) = wv;
                    } }
        }
    }
}

DI void phase_prep2(const Ctx& c) {
    const int tid = threadIdx.x, lane = tid & 63, w = tid >> 6, r = lane & 31, h = lane >> 5, wr = w >> 1, wc = w & 1;
    const int srow = tid >> 3, scol = (tid & 7) * 8;
    for (int item = blockIdx.x; item < 32; item += gridDim.x) {
        const int kv = item >> 4, mt = item & 15;
        f32x16 acc[2][2]; zero_acc(acc);
        const bf16_t* a = c.HC() + (size_t)kv * 2048 * 128 + (size_t)(128 * mt + srow) * 128 + scol;
        gemm_kloop(acc, a, a + 32 * 128, a + 64 * 128, a + 96 * 128, 64, c.W() + W_PHI2 + (size_t)kv * 128 * 128, 128, 2, c.lds);
        if (wc == 0) {
            bf16_t* dst = c.KC() + (size_t)kv * 2048 * 64 + (size_t)(128 * mt) * 64;
#pragma unroll
            for (int mi = 0; mi < 2; ++mi)
#pragma unroll
                for (int ni = 0; ni < 2; ++ni)
#pragma unroll
                    for (int g = 0; g < 4; ++g) {
                        u32x2 wv; wv[0] = cvtpk(acc[mi][ni][4 * g], acc[mi][ni][4 * g + 1]); wv[1] = cvtpk(acc[mi][ni][4 * g + 2], acc[mi][ni][4 * g + 3]);
                        *(u32x2*)(dst + (size_t)(64 * wr + 32 * mi + r) * 64 + 32 * ni + 8 * g + 4 * h) = wv;
                    }
        }
    }
}

DI void sb_item(const Ctx& c, int b, int head, int qt) {
    const int tid = opaque_tid(), lane = tid & 63, w = tid >> 6, r = lane & 31, h = lane >> 5;
    const int q0 = 128 * qt, qpos = q0 + 32 * w + r; const size_t tok = (size_t)b * S + qpos;
    bf16x8 qf[4]; load_q64(qf, c.P() + tok * PW + C_SBQ + head * 64);
    const bf16_t* kbase = c.P() + (size_t)b * S * PW + C_SBK + head * 64; const bf16_t* vbase = c.P() + (size_t)b * S * PW + C_SBV + head * 64;
    volatile int* flags = (volatile int*)(c.lds + 40960);
    f32x16 o[2]; o[0] = zero16(); o[1] = zero16();
    float carry = 0.f;
    const int t_top = 2 * qt + 1;
    for (int t = t_top; t >= 0; --t) {
        KVRegs<64> R; kv_load<64>(R, kbase, PW, vbase, PW, t, S - 1);
        __syncthreads();
        if (t != t_top) { const int any = flags[0] | flags[1] | flags[2] | flags[3]; if (!any) break; }
        kv_store<64>(R, c.lds);
        __syncthreads();
        f32x16 s[2];
        qk_tile<64>(s, qf, c.lds);
        const int lim = qpos - 64 * t - 4 * h;
#pragma unroll
        for (int kh = 1; kh >= 0; --kh) {
            float G[4], Go[4], lkv[16];
#pragma unroll
            for (int g = 0; g < 4; ++g) { G[g] = 0.f;
#pragma unroll
                for (int e = 0; e < 4; ++e) { const int i = 4 * g + e; const int koff = 32 * kh + 8 * g + e;
                    const float z = s[kh][i] * 0.125f; const float az = fabsf(z);
                    const float sp = fmaxf(z, 0.f) + LN2 * lg2(1.f + ex2(-az * LOG2E));
                    const float lk = koff < lim ? -sp : 0.f;
                    lkv[i] = lk; s[kh][i] = z; G[g] += lk; } }
#pragma unroll
            for (int g = 0; g < 4; ++g) Go[g] = __shfl_xor(G[g], 32);
            float tot = 0.f, gs[4];
#pragma unroll
            for (int g = 3; g >= 0; --g) { gs[g] = tot + (h == 0 ? Go[g] : 0.f); tot += G[g] + Go[g]; }
#pragma unroll
            for (int g = 0; g < 4; ++g) { float insuf = 0.f;
#pragma unroll
                for (int e = 3; e >= 0; --e) { const int i = 4 * g + e; const int koff = 32 * kh + 8 * g + e;
                    const bool valid = koff < lim;
                    const float a = valid ? ex2((s[kh][i] + lkv[i] + carry + gs[g] + insuf) * LOG2E) : 0.f;
                    insuf += lkv[i]; s[kh][i] = a; } }
            carry += tot;
        }
        pv_tile<64>(o, s, c.lds);
        const int act = __any(carry >= -104.f);
        if (lane == 0) flags[w] = act;
    }
    write_o(c.OB() + tok * OBW + 0 + head * 64, o);
}

DI void moba_item(const Ctx& c, int b, int head, int qt) {
    const int tid = opaque_tid(), lane = tid & 63, w = tid >> 6, r = lane & 31, h = lane >> 5;
    const int q0 = 128 * qt, own = q0 >> 8, qpos = q0 + 32 * w + r; const size_t tok = (size_t)b * S + qpos;
    const bf16_t* qrow = c.P() + tok * PW + C_MBQ + head * 64;
    float* km = (float*)(c.lds + 24576);
    unsigned* uni = (unsigned*)(c.lds + 40960);
    __syncthreads();
    { const float* src = c.KMEAN() + (size_t)((b * 4 + head) * 32) * 64;
      for (int i = tid; i < own * 64; i += NTHR) km[i] = src[i]; }
    __syncthreads();
    unsigned mask = 1u << own;
    {
        u32x4 qq[8];
#pragma unroll
        for (int i = 0; i < 8; ++i) qq[i] = *(const u32x4*)(qrow + 8 * i);
        float v1 = -3e38f, v2 = -3e38f, v3 = -3e38f; int i1 = -1, i2 = -1, i3 = -1;
        for (int n = 0; n < own; ++n) {
            float gsc = 0.f; const float* kr = km + n * 64;
#pragma unroll
            for (int i = 0; i < 8; ++i)
#pragma unroll
                for (int e = 0; e < 4; ++e) { gsc += bflo(qq[i][e]) * kr[8 * i + 2 * e]; gsc += bfhi(qq[i][e]) * kr[8 * i + 2 * e + 1]; }
            if (gsc > v1) { v3 = v2; i3 = i2; v2 = v1; i2 = i1; v1 = gsc; i1 = n; }
            else if (gsc > v2) { v3 = v2; i3 = i2; v2 = gsc; i2 = n; }
            else if (gsc > v3) { v3 = gsc; i3 = n; }
        }
        if (i1 >= 0) mask |= 1u << i1; if (i2 >= 0) mask |= 1u << i2; if (i3 >= 0) mask |= 1u << i3;
    }
    unsigned um = mask;
#pragma unroll
    for (int o = 32; o >= 1; o >>= 1) um |= (unsigned)__shfl_xor((int)um, o);
    if (lane == 0) uni[w] = um;
    __syncthreads();
    NeedBlk4 need; need.u = uni[0] | uni[1] | uni[2] | uni[3];
    bf16x8 qf[4]; load_q64(qf, qrow);
    PolMoba pol; pol.qpos = qpos; pol.sc2 = 0.125f * LOG2E; pol.sl2 = exp2f(-2.f * (float)(head + 1)) * LOG2E; pol.mask = mask; pol.lim = -1; pol.base = 0.f;
    float m = -1e30f, l = 0.f; f32x16 o[2]; o[0] = zero16(); o[1] = zero16();
    const bf16_t* kbase = c.P() + (size_t)b * S * PW + C_MBK + head * 64; const bf16_t* vbase = c.P() + (size_t)b * S * PW + C_MBV + head * 64;
    flash_pass<64>(qf, kbase, PW, vbase, PW, S - 1, 0, 2 * qt + 2, need, (q0 + 32 * w + 31) >> 6, pol, m, l, o, c.lds);
    l += __shfl_xor(l, 32);
    const float inv = 1.f / l;
#pragma unroll
    for (int i = 0; i < 16; ++i) { o[0][i] *= inv; o[1][i] *= inv; }
    write_o(c.OB() + tok * OBW + 256 + head * 64, o);
}

DI void mla_item(const Ctx& c, int b, int head, int qt) {
    const int tid = opaque_tid(), lane = tid & 63, w = tid >> 6, r = lane & 31, h = lane >> 5;
    const int q0 = 128 * qt, qpos = q0 + 32 * w + r; const size_t tok = (size_t)b * S + qpos;
    const bf16_t* qrow = c.QM() + tok * QMW + head * 96;
    bf16x8 qf[6];
#pragma unroll
    for (int ks = 0; ks < 6; ++ks) qf[ks] = *(const bf16x8*)(qrow + 16 * ks + 8 * h);
    {
        float o1[8], o2[8];
#pragma unroll
        for (int j = 0; j < 8; ++j) { const int i = 8 * h + j; const float fr = exp2f(-(float)i * (13.287712379549449f / 16.f));
            float sn, cs; sincosf((float)qpos * fr, &sn, &cs);
            const float a = bf2f((unsigned short)qf[4][j]), bq = bf2f((unsigned short)qf[5][j]);
            o1[j] = a * cs - bq * sn; o2[j] = a * sn + bq * cs; }
        u32x4 w1v, w2v;
#pragma unroll
        for (int j = 0; j < 4; ++j) { w1v[j] = cvtpk(o1[2 * j], o1[2 * j + 1]); w2v[j] = cvtpk(o2[2 * j], o2[2 * j + 1]); }
        qf[4] = __builtin_bit_cast(bf16x8, w1v); qf[5] = __builtin_bit_cast(bf16x8, w2v);
    }
    PolCausal pol; pol.qpos = qpos; pol.lim = -1; pol.sc2 = 0.10206207261596577f * LOG2E;
    float m = -1e30f, l = 0.f; f32x16 o[2]; o[0] = zero16(); o[1] = zero16();
    const bf16_t* kbase = c.MK() + (size_t)b * S * MKW + head * 160; const bf16_t* vbase = kbase + 96;
    flash_pass<96>(qf, kbase, MKW, vbase, MKW, S - 1, 0, 2 * qt + 2, NeedAll(), (q0 + 32 * w + 31) >> 6, pol, m, l, o, c.lds);
    l += __shfl_xor(l, 32);
    const float inv = 1.f / l;
#pragma unroll
    for (int i = 0; i < 16; ++i) { o[0][i] *= inv; o[1][i] *= inv; }
    write_o(c.OB() + tok * OBW + 512 + head * 64, o);
}

DI void mem_item(const Ctx& c, int b, int head, int qt) {
    const int tid = opaque_tid(), lane = tid & 63, w = tid >> 6, r = lane & 31;
    const int q0 = 128 * qt, qpos = q0 + 32 * w + r; const size_t tok = (size_t)b * S + qpos;
    bf16x8 qf[4]; load_q64(qf, c.P() + tok * PW + C_QM + head * 64);
    PolMem pol; pol.sc2 = 0.125f * LOG2E;
    float m = -1e30f, l = 0.f; f32x16 o[2]; o[0] = zero16(); o[1] = zero16();
    const bf16_t* kbase = c.MEMKV() + (size_t)b * 256 * 512 + head * 64; const bf16_t* vbase = kbase + 256;
    flash_pass<64>(qf, kbase, 512, vbase, 512, 255, 0, 4, NeedAll(), 1 << 30, pol, m, l, o, c.lds);
    l += __shfl_xor(l, 32);
    const float inv = 1.f / l;
#pragma unroll
    for (int i = 0; i < 16; ++i) { o[0][i] *= inv; o[1][i] *= inv; }
    write_o(c.OB() + tok * OBW + 1024 + head * 64, o);
}

DI void nsa_item(const Ctx& c, int b, int qg) {
    const int tid = opaque_tid(), lane = tid & 63, w = tid >> 6, r = lane & 31, h = lane >> 5;
    const int head = w, q0 = 32 * qg, qpos = q0 + r; const size_t tok = (size_t)b * S + qpos;
    unsigned* imp = (unsigned*)(c.lds + 24576);
    unsigned* selm = (unsigned*)(c.lds + 40960);
    unsigned* uni = (unsigned*)(c.lds + 41472);
    __syncthreads();
    for (int i = tid; i < 32 * 128; i += NTHR) imp[i] = 0u;
    if (tid < 128) selm[tid] = 0u;
    if (tid < 4) uni[tid] = 0u;
    bf16x8 qf[4]; load_q64(qf, c.P() + tok * PW + C_NQ + head * 64);
    const float sc2 = 0.125f * LOG2E, sl2 = exp2f(-2.f * (float)(head + 1)) * LOG2E;
    const bf16_t* grow = c.P() + tok * PW + C_GN + head * 3;
    const float g0 = 1.f / (1.f + ex2(-bf2f(grow[0]) * LOG2E)), g1 = 1.f / (1.f + ex2(-bf2f(grow[1]) * LOG2E)), g2 = 1.f / (1.f + ex2(-bf2f(grow[2]) * LOG2E));
    float* stash = (float*)(c.ws() + WS_STASH) + (size_t)blockIdx.x * 8192 + tid;
    const bf16_t* Pb = c.P() + (size_t)b * S * PW;
    const int nct = ((2 * qg) >> 6) + 1;
    const bf16_t* kc = c.KC() + (size_t)b * 512 * 64; const bf16_t* vc = c.KC() + (size_t)2048 * 64 + (size_t)b * 512 * 64;
    float m_c, inv_c;
    {
        PolCmp pol; pol.qpos = qpos; pol.sc2 = sc2; pol.sl2 = sl2; pol.lim = -1; pol.base = 0.f;
        float m = -1e30f, l = 0.f; f32x16 o[2]; o[0] = zero16(); o[1] = zero16();
        flash_pass<64>(qf, kc, 64, vc, 64, 510, 0, nct, NeedAll(), 1 << 30, pol, m, l, o, c.lds);
        l += __shfl_xor(l, 32);
        const bool has = m > -0.5e30f;
        inv_c = has ? 1.f / l : 0.f; m_c = m;
        const float f = inv_c * g0;
#pragma unroll
        for (int i = 0; i < 16; ++i) { stash[i * NTHR] = o[0][i] * f; stash[(16 + i) * NTHR] = o[1][i] * f; }
        for (int t = 0; t < nct; ++t) {
            KVRegs<64> R; kv_load<64>(R, kc, 64, vc, 64, t, 510);
            __syncthreads();
            kv_store<64>(R, c.lds);
            __syncthreads();
            f32x16 s[2]; qk_tile<64>(s, qf, c.lds); pol.prep(t);
#pragma unroll
            for (int kh = 0; kh < 2; ++kh)
#pragma unroll
                for (int g = 0; g < 4; ++g) {
                    float p4[4];
#pragma unroll
                    for (int e = 0; e < 4; ++e) p4[e] = ex2(pol.score(s[kh][4 * g + e], 32 * kh + 8 * g + e) - m_c) * inv_c;
                    const int sb = 16 * t + 8 * kh + 2 * g + h;
                    const float sum4 = (p4[0] + p4[1]) + (p4[2] + p4[3]);
                    atomicAdd(&imp[r * 128 + sb], (unsigned)(sum4 * 268435456.f + 0.5f));
                    if (sb + 1 < 128) atomicAdd(&imp[r * 128 + sb + 1], (unsigned)(p4[3] * 268435456.f + 0.5f));
                }
        }
    }
    __syncthreads();
    {
        const int qi = tid >> 3, sub = tid & 7; const int cur = (q0 + qi) >> 6;
        unsigned cs[16]; int rank[16];
#pragma unroll
        for (int k = 0; k < 16; ++k) { const int sidx = sub + 8 * k; cs[k] = (sidx == 0 || sidx == cur) ? 0xffffffffu : imp[qi * 128 + (sidx & 127)]; rank[k] = 0; }
        for (int sp = 0; sp <= cur; ++sp) {
            const unsigned v = (sp == 0 || sp == cur) ? 0xffffffffu : imp[qi * 128 + sp];
#pragma unroll
            for (int k = 0; k < 16; ++k) { const int sidx = sub + 8 * k; rank[k] += (v > cs[k] || (v == cs[k] && sp < sidx)) ? 1 : 0; }
        }
#pragma unroll
        for (int k = 0; k < 16; ++k) { const int sidx = sub + 8 * k;
            if (sidx <= cur && rank[k] < 16) { atomicOr(&selm[qi * 4 + (sidx >> 5)], 1u << (sidx & 31)); atomicOr(&uni[sidx >> 5], 1u << (sidx & 31)); } }
    }
    __syncthreads();
    {
        PolSel pol; pol.qpos = qpos; pol.sc2 = sc2; pol.sl2 = sl2; pol.mlo = (unsigned long long)selm[r * 4] | ((unsigned long long)selm[r * 4 + 1] << 32); pol.mhi = (unsigned long long)selm[r * 4 + 2] | ((unsigned long long)selm[r * 4 + 3] << 32); pol.lim = -1; pol.base = 0.f;
        NeedBits128 need; need.lo = (unsigned long long)uni[0] | ((unsigned long long)uni[1] << 32); need.hi = (unsigned long long)uni[2] | ((unsigned long long)uni[3] << 32);
        float m = -1e30f, l = 0.f; f32x16 o[2]; o[0] = zero16(); o[1] = zero16();
        flash_pass<64>(qf, Pb + C_NKV + 128, PW, Pb + C_NKV + 192, PW, S - 1, 0, (q0 >> 6) + 1, need, 1 << 30, pol, m, l, o, c.lds);
        l += __shfl_xor(l, 32);
        const float f = g1 / l;
#pragma unroll
        for (int i = 0; i < 16; ++i) { stash[i * NTHR] += o[0][i] * f; stash[(16 + i) * NTHR] += o[1][i] * f; }
    }
    {
        PolWin pol; pol.qpos = qpos; pol.sc2 = sc2; pol.sl2 = sl2; pol.lim = -1; pol.base = 0.f;
        const int lo = q0 - 511; const int t_lo = lo > 0 ? (lo >> 6) : 0;
        float m = -1e30f, l = 0.f; f32x16 o[2]; o[0] = zero16(); o[1] = zero16();
        flash_pass<64>(qf, Pb + C_NKV + 256, PW, Pb + C_NKV + 320, PW, S - 1, t_lo, (q0 >> 6) + 1, NeedAll(), 1 << 30, pol, m, l, o, c.lds);
        l += __shfl_xor(l, 32);
        const float f = g2 / l;
#pragma unroll
        for (int i = 0; i < 16; ++i) { o[0][i] = stash[i * NTHR] + o[0][i] * f; o[1][i] = stash[(16 + i) * NTHR] + o[1][i] * f; }
        write_o(c.OB() + tok * OBW + 768 + head * 64, o);
    }
}

DI void phase_attn(const Ctx& c) {
    unsigned* qhead = c.CTL() + CW_Q + 16 * c.layer;
    volatile int* slot = (volatile int*)(c.lds + 41984);
    for (;;) {
        __syncthreads();
        if (threadIdx.x == 0) *slot = (int)__hip_atomic_fetch_add(qhead, 1u, __ATOMIC_RELAXED, __HIP_MEMORY_SCOPE_AGENT);
        __syncthreads();
        const int item = __builtin_amdgcn_readfirstlane(*slot);
        if (item >= 5120) break;
#ifndef AONLY
#define AONLY 31
#endif
        if (item < 1024) { if (AONLY & 1) nsa_item(c, item & 3, 255 - (item >> 2)); }
        else if (item < 3072) { const int j = item - 1024, qt = 63 - (j >> 5), rem = j & 31, b = (rem >> 2) & 3, head = rem & 3;
            if (rem >> 4) { if (AONLY & 2) moba_item(c, b, head, qt); } else { if (AONLY & 4) mla_item(c, b, head, qt); } }
        else if (item < 4096) { const int j = item - 3072; if (AONLY & 8) mem_item(c, (j >> 2) & 3, j & 3, j >> 4); }
        else { const int j = item - 4096; if (AONLY & 16) sb_item(c, (j >> 2) & 3, j & 3, j >> 4); }
    }
}

DI void phase_gate(const Ctx& c) {
    const int tid = opaque_tid(), lane = tid & 63, w = tid >> 6, r = lane & 31, h = lane >> 5, wr = w >> 1, wc = w & 1;
    const int srow = tid >> 3, scol = (tid & 7) * 8; const int l = c.layer;
    for (int item = blockIdx.x; item < 256 * 8; item += gridDim.x) {
        const int mt = item >> 3, nt = item & 7;
        unsigned mgp[2][2][8];
#pragma unroll
        for (int mi = 0; mi < 2; ++mi)
#pragma unroll
            for (int ni = 0; ni < 2; ++ni)
#pragma unroll
                for (int k = 0; k < 8; ++k) mgp[mi][ni][k] = 0u;
        for (int i = 0; i < 5; ++i) {
            unsigned brp[2][2][8];
            {
                f32x16 br[2][2]; zero_acc(br);
                const bf16_t* a = c.OB() + (size_t)(128 * mt + srow) * OBW + 256 * i + scol;
                gemm_kloop(br, a, a + 32 * OBW, a + 64 * OBW, a + 96 * OBW, 64, c.W() + W_BR + (size_t)i * 1024 * 256 + (size_t)(128 * nt) * 256, 256, 4, c.lds);
#pragma unroll
                for (int mi = 0; mi < 2; ++mi)
#pragma unroll
                    for (int ni = 0; ni < 2; ++ni)
#pragma unroll
                        for (int k = 0; k < 8; ++k) brp[mi][ni][k] = cvtpk(br[mi][ni][2 * k], br[mi][ni][2 * k + 1]);
            }
            f32x16 ga[2][2]; zero_acc(ga);
            const bf16_t* a = c.HB() + (size_t)(128 * mt + srow) * 1024 + scol;
            gemm_kloop(ga, a, a + 32 * 1024, a + 64 * 1024, a + 96 * 1024, 64, c.W() + W_G + (size_t)i * 1024 * 1024 + (size_t)(128 * nt) * 1024, 1024, 16, c.lds);
            const float* bg = c.in(15) + ((size_t)l * 5 + i) * 1024 + 128 * nt + 64 * wc + 4 * h;
#pragma unroll
            for (int ni = 0; ni < 2; ++ni)
#pragma unroll
                for (int g = 0; g < 4; ++g) {
                    const f32x4 bv = *(const f32x4*)(bg + 32 * ni + 8 * g);
#pragma unroll
                    for (int mi = 0; mi < 2; ++mi)
#pragma unroll
                        for (int e2 = 0; e2 < 2; ++e2) {
                            const float g0 = 1.f / (1.f + ex2(-(ga[mi][ni][4 * g + 2 * e2] + bv[2 * e2]) * LOG2E));
                            const float g1 = 1.f / (1.f + ex2(-(ga[mi][ni][4 * g + 2 * e2 + 1] + bv[2 * e2 + 1]) * LOG2E));
                            const unsigned pb = brp[mi][ni][2 * g + e2], pm = mgp[mi][ni][2 * g + e2];
                            mgp[mi][ni][2 * g + e2] = cvtpk(bflo(pm) + g0 * bflo(pb), bfhi(pm) + g1 * bfhi(pb));
                        }
                }
        }
        bf16_t* dst = c.MG() + (size_t)(128 * mt) * 1024 + 128 * nt;
#pragma unroll
        for (int mi = 0; mi < 2; ++mi)
#pragma unroll
            for (int ni = 0; ni < 2; ++ni)
#pragma unroll
                for (int g = 0; g < 4; ++g) {
                    u32x2 wv; wv[0] = mgp[mi][ni][2 * g]; wv[1] = mgp[mi][ni][2 * g + 1];
                    *(u32x2*)(dst + (size_t)(64 * wr + 32 * mi + r) * 1024 + 64 * wc + 32 * ni + 8 * g + 4 * h) = wv;
                }
    }
}

DI void phase_out(const Ctx& c) {
    const int tid = threadIdx.x, lane = tid & 63, w = tid >> 6, r = lane & 31, h = lane >> 5, wr = w >> 1, wc = w & 1;
    const int srow = tid >> 3, scol = (tid & 7) * 8;
    const float* hs = c.hsrc(); float* out = c.p->out;
    for (int item = blockIdx.x; item < 256 * 8; item += gridDim.x) {
        const int mt = item >> 3, nt = item & 7;
        f32x16 acc[2][2]; zero_acc(acc);
        const bf16_t* a = c.MG() + (size_t)(128 * mt + srow) * 1024 + scol;
        gemm_kloop(acc, a, a + 32 * 1024, a + 64 * 1024, a + 96 * 1024, 64, c.W() + W_OUT + (size_t)(128 * nt) * 1024, 1024, 16, c.lds);
#pragma unroll
        for (int mi = 0; mi < 2; ++mi)
#pragma unroll
            for (int ni = 0; ni < 2; ++ni)
#pragma unroll
                for (int g = 0; g < 4; ++g) {
                    const size_t off = (size_t)(128 * mt + 64 * wr + 32 * mi + r) * 1024 + 128 * nt + 64 * wc + 32 * ni + 8 * g + 4 * h;
                    const f32x4 hv = *(const f32x4*)(hs + off); f32x4 ov;
#pragma unroll
                    for (int e = 0; e < 4; ++e) ov[e] = ALPHA * hv[e] + acc[mi][ni][4 * g + e];
                    *(f32x4*)(out + off) = ov;
                }
    }
}

template <bool ROUTE> DI void phase_ln(const Ctx& c) {
    const int tid = threadIdx.x, lane = tid & 63, w = tid >> 6; const int l = c.layer;
    float* out = c.p->out; bf16_t* hb = c.HB();
    const float* gam = c.in(ROUTE ? 17 : 25) + l * 1024; const float* bet = c.in(ROUTE ? 18 : 26) + l * 1024;
    f32x4 gv[4], bv[4];
#pragma unroll
    for (int j = 0; j < 4; ++j) { gv[j] = *(const f32x4*)(gam + 4 * lane + 256 * j); bv[j] = *(const f32x4*)(bet + 4 * lane + 256 * j); }
    for (int row = blockIdx.x * 4 + w; row < T; row += gridDim.x * 4) {
        float* xr = out + (size_t)row * 1024;
        f32x4 x[4]; float s = 0.f;
#pragma unroll
        for (int j = 0; j < 4; ++j) { x[j] = *(const f32x4*)(xr + 4 * lane + 256 * j); s += (x[j][0] + x[j][1]) + (x[j][2] + x[j][3]); }
        const float mean = wave_sum(s) * (1.f / 1024.f);
        float v = 0.f;
#pragma unroll
        for (int j = 0; j < 4; ++j)
#pragma unroll
            for (int e = 0; e < 4; ++e) { const float d = x[j][e] - mean; v += d * d; }
        const float rs = 1.f / sqrtf(wave_sum(v) * (1.f / 1024.f) + 1e-5f);
#pragma unroll
        for (int j = 0; j < 4; ++j) {
#pragma unroll
            for (int e = 0; e < 4; ++e) x[j][e] = (x[j][e] - mean) * rs * gv[j][e] + bv[j][e];
            *(f32x4*)(xr + 4 * lane + 256 * j) = x[j];
            u32x2 pk; pk[0] = cvtpk(x[j][0], x[j][1]); pk[1] = cvtpk(x[j][2], x[j][3]);
            *(u32x2*)(hb + (size_t)row * 1024 + 4 * lane + 256 * j) = pk;
        }
        if (ROUTE) {
            const float* wrg = c.in(19) + (size_t)l * 1024 * 4;
            float gl[4] = {0.f, 0.f, 0.f, 0.f};
#pragma unroll
            for (int j = 0; j < 4; ++j)
#pragma unroll
                for (int e = 0; e < 4; ++e) { const f32x4 wv = *(const f32x4*)(wrg + (size_t)(4 * lane + 256 * j + e) * 4);
#pragma unroll
                    for (int q = 0; q < 4; ++q) gl[q] += x[j][e] * wv[q]; }
#pragma unroll
            for (int q = 0; q < 4; ++q) gl[q] = wave_sum(gl[q]) + c.in(20)[l * 4 + q];
            int gsel = 0; float gmax = gl[0];
#pragma unroll
            for (int q = 1; q < 4; ++q) if (gl[q] > gmax) { gmax = gl[q]; gsel = q; }
            float gsum = 0.f;
#pragma unroll
            for (int q = 0; q < 4; ++q) gsum += expf(gl[q] - gmax);
            const float pg_sel = 1.f / gsum;
            const float* wre = c.in(21) + ((size_t)l * 4 + gsel) * 1024 * 4;
            float el[4] = {0.f, 0.f, 0.f, 0.f};
#pragma unroll
            for (int j = 0; j < 4; ++j)
#pragma unroll
                for (int e = 0; e < 4; ++e) { const f32x4 wv = *(const f32x4*)(wre + (size_t)(4 * lane + 256 * j + e) * 4);
#pragma unroll
                    for (int q = 0; q < 4; ++q) el[q] += x[j][e] * wv[q]; }
#pragma unroll
            for (int q = 0; q < 4; ++q) el[q] = wave_sum(el[q]) + c.in(22)[(l * 4 + gsel) * 4 + q];
            int e1 = 0; float m1 = el[0];
#pragma unroll
            for (int q = 1; q < 4; ++q) if (el[q] > m1) { m1 = el[q]; e1 = q; }
            int e2 = -1; float m2 = -3e38f;
#pragma unroll
            for (int q = 0; q < 4; ++q) if (q != e1 && el[q] > m2) { m2 = el[q]; e2 = q; }
            const float p2 = expf(m2 - m1);
            const float w1 = pg_sel / (1.f + p2), w2 = pg_sel * p2 / (1.f + p2);
            const int lo = e1 < e2 ? e1 : e2, hi = e1 < e2 ? e2 : e1;
            const float wlo = e1 < e2 ? w1 : w2, whi = e1 < e2 ? w2 : w1;
            const int pidx = lo == 0 ? hi - 1 : (lo == 1 ? hi + 1 : 5);
            const int bucket = gsel * 6 + pidx;
            if (lane == 0) {
                const unsigned pos = __hip_atomic_fetch_add(c.CTL() + CW_CNT + 32 * l + bucket, 1u, __ATOMIC_RELAXED, __HIP_MEMORY_SCOPE_AGENT);
                c.LTOK()[(size_t)bucket * T + pos] = row;
                c.LW()[((size_t)bucket * T + pos) * 2] = wlo; c.LW()[((size_t)bucket * T + pos) * 2 + 1] = whi;
            }
        }
    }
}

DI int moe_table(const Ctx& c, int* tab) {
    __syncthreads();
    if (threadIdx.x == 0) { int acc = 0;
        for (int bkt = 0; bkt < 24; ++bkt) { const int n = (int)c.CTL()[CW_CNT + 32 * c.layer + bkt]; tab[32 + bkt] = n; tab[bkt] = acc; acc += (n + 127) >> 7; }
        tab[24] = acc; }
    __syncthreads();
    return tab[24];
}
DI void moe_decode(const int* tab, int rt, int& bkt, int& r0, int& nvalid, int& elo, int& ehi) {
    int bk = 0;
    for (int i = 0; i < 24; ++i) if (tab[i] <= rt && rt < tab[i + 1]) bk = i;
    bkt = bk; r0 = 128 * (rt - tab[bk]); const int n = tab[32 + bk] - r0; nvalid = n < 128 ? n : 128;
    const int g = bk / 6, pidx = bk % 6;
    const int lo = pidx < 3 ? 0 : (pidx < 5 ? 1 : 2), hi = pidx < 3 ? pidx + 1 : (pidx < 5 ? pidx - 1 : 3);
    elo = g * 4 + lo; ehi = g * 4 + hi;
}
DI void phase_moe_up(const Ctx& c) {
    const int tid = threadIdx.x, lane = tid & 63, w = tid >> 6, r = lane & 31, h = lane >> 5, wr = w >> 1, wc = w & 1;
    const int srow = tid >> 3, scol = (tid & 7) * 8;
    int* tab = (int*)(c.lds + 40960);
    const int RT = moe_table(c, tab);
    for (int item = blockIdx.x; item < RT * 8; item += gridDim.x) {
        const int rt = item >> 3, ct = item & 7, es = ct >> 2, q4 = ct & 3;
        int bkt, r0, nvalid, elo, ehi; moe_decode(tab, rt, bkt, r0, nvalid, elo, ehi);
        const int* ltok = c.LTOK() + (size_t)bkt * T + r0;
        const bf16_t* ap[4];
#pragma unroll
        for (int i = 0; i < 4; ++i) { int lr = srow + 32 * i; lr = lr < nvalid ? lr : nvalid - 1; ap[i] = c.HB() + (size_t)ltok[lr] * 1024 + scol; }
        const int e = es ? ehi : elo;
        f32x16 acc[2][2]; zero_acc(acc);
        gemm_kloop(acc, ap[0], ap[1], ap[2], ap[3], 64, c.W() + W_UP + (size_t)e * 512 * 1024 + (size_t)(128 * q4) * 1024, 1024, 16, c.lds);
        const float* lw = c.LW() + ((size_t)bkt * T + r0) * 2 + es;
#pragma unroll
        for (int mi = 0; mi < 2; ++mi) {
            int lr = 64 * wr + 32 * mi + r; const int lrc = lr < nvalid ? lr : nvalid - 1;
            const float wt = lw[(size_t)lrc * 2];
            bf16_t* dst = c.ACT() + (size_t)(128 * rt + lr) * 512 + es * 256 + 32 * (2 * q4 + wc) + 4 * h;
#pragma unroll
            for (int g = 0; g < 4; ++g) { float o4[4];
#pragma unroll
                for (int e4 = 0; e4 < 4; ++e4) { const float a = acc[mi][0][4 * g + e4], u = acc[mi][1][4 * g + e4]; o4[e4] = a / (1.f + ex2(-a * LOG2E)) * u * wt; }
                u32x2 wv; wv[0] = cvtpk(o4[0], o4[1]); wv[1] = cvtpk(o4[2], o4[3]);
                *(u32x2*)(dst + 8 * g) = wv; }
        }
    }
}
DI void phase_moe_down(const Ctx& c) {
    const int tid = threadIdx.x, lane = tid & 63, w = tid >> 6, r = lane & 31, h = lane >> 5, wr = w >> 1, wc = w & 1;
    const int srow = tid >> 3, scol = (tid & 7) * 8;
    int* tab = (int*)(c.lds + 40960);
    const int RT = moe_table(c, tab);
    float* out = c.p->out;
    for (int item = blockIdx.x; item < RT * 8; item += gridDim.x) {
        const int rt = item >> 3, nt = item & 7;
        int bkt, r0, nvalid, elo, ehi; moe_decode(tab, rt, bkt, r0, nvalid, elo, ehi);
        const int* ltok = c.LTOK() + (size_t)bkt * T + r0;
        f32x16 acc[2][2]; zero_acc(acc);
        const bf16_t* a = c.ACT() + (size_t)(128 * rt + srow) * 512 + scol;
        gemm_kloop(acc, a, a + 32 * 512, a + 64 * 512, a + 96 * 512, 64, c.W() + W_DN + (size_t)elo * 1024 * 256 + (size_t)(128 * nt) * 256, 256, 4, c.lds);
        gemm_kloop(acc, a + 256, a + 256 + 32 * 512, a + 256 + 64 * 512, a + 256 + 96 * 512, 64, c.W() + W_DN + (size_t)ehi * 1024 * 256 + (size_t)(128 * nt) * 256, 256, 4, c.lds);
#pragma unroll
        for (int mi = 0; mi < 2; ++mi) {
            const int lr = 64 * wr + 32 * mi + r;
            if (lr < nvalid) {
                const size_t tok = (size_t)ltok[lr];
#pragma unroll
                for (int ni = 0; ni < 2; ++ni)
#pragma unroll
                    for (int g = 0; g < 4; ++g) {
                        const size_t off = tok * 1024 + 128 * nt + 64 * wc + 32 * ni + 8 * g + 4 * h;
                        const f32x4 hv = *(const f32x4*)(out + off); f32x4 ov;
#pragma unroll
                        for (int e = 0; e < 4; ++e) ov[e] = ALPHA * hv[e] + acc[mi][ni][4 * g + e];
                        *(f32x4*)(out + off) = ov;
                    }
            }
        }
    }
}

enum { PH_PRO = 0, PH_W, PH_PROJ, PH_PREP1, PH_PREP2, PH_ATTN, PH_GATE, PH_OUT, PH_LN1, PH_MUP, PH_MDN, PH_LN2 };
template <int PH> DI void run_phase(const Ctx& c) {
    if (PH == PH_PRO) phase_prologue(c);
    else if (PH == PH_W) phase_weights(c);
    else if (PH == PH_PROJ) phase_proj(c);
    else if (PH == PH_PREP1) phase_prep1(c);
    else if (PH == PH_PREP2) phase_prep2(c);
    else if (PH == PH_ATTN) phase_attn(c);
    else if (PH == PH_GATE) phase_gate(c);
    else if (PH == PH_OUT) phase_out(c);
    else if (PH == PH_LN1) phase_ln<true>(c);
    else if (PH == PH_MUP) phase_moe_up(c);
    else if (PH == PH_MDN) phase_moe_down(c);
    else if (PH == PH_LN2) phase_ln<false>(c);
}
extern __shared__ __attribute__((aligned(16))) char dyn_lds[];
template <int PH> __global__ void __launch_bounds__(NTHR, 2) k_phase(Params p, int layer) {
    Ctx c; c.p = &p; c.layer = layer; c.lds = dyn_lds;
    run_phase<PH>(c);
}

extern "C" void kernel_launch(void* const* d_in, const int* in_sizes, int n_in, void* d_out, int out_size, void* d_ws, size_t ws_size, hipStream_t stream) {
    Params p{};
    for (int i = 0; i < 27; ++i) p.in[i] = (const float*)d_in[i];
    p.out = (float*)d_out; p.ws = (unsigned char*)d_ws;
    hipMemsetAsync(d_ws, 0, 65536, stream);
    const int grid = 512;
#define LAUNCH(PH, L) hipLaunchKernelGGL((k_phase<PH>), dim3(grid), dim3(NTHR), LDS_BYTES, stream, p, (L))
    LAUNCH(PH_PRO, 0);
    for (int l = 0; l < NL; ++l) {
        LAUNCH(PH_W, l); LAUNCH(PH_PROJ, l); LAUNCH(PH_PREP1, l); LAUNCH(PH_PREP2, l); LAUNCH(PH_ATTN, l); LAUNCH(PH_GATE, l);
        LAUNCH(PH_OUT, l); LAUNCH(PH_LN1, l); LAUNCH(PH_MUP, l); LAUNCH(PH_MDN, l); LAUNCH(PH_LN2, l);
    }
}
```

```cpp
#include <hip/hip_runtime.h>
#include <stdint.h>

#ifndef N_LAUNCH_MODE
#define N_LAUNCH_MODE 1
#endif

typedef unsigned short bf16_t;
typedef short bf16x8 __attribute__((ext_vector_type(8)));
typedef short s16x4 __attribute__((ext_vector_type(4)));
typedef short v4i16_t __attribute__((ext_vector_type(4)));
typedef float f32x16 __attribute__((ext_vector_type(16)));
typedef float f32x4 __attribute__((ext_vector_type(4)));
typedef float f32x2 __attribute__((ext_vector_type(2)));
typedef unsigned u32x4 __attribute__((ext_vector_type(4)));
typedef unsigned u32x2 __attribute__((ext_vector_type(2)));
typedef __bf16 bf16x2_t __attribute__((ext_vector_type(2)));
#define LAS __attribute__((address_space(3)))
#define DI __device__ __forceinline__

constexpr int NB = 4, S = 8192, DM = 1024, NL = 4, T = NB * S;
constexpr int PW = 2944;
constexpr int C_SBQ = 0, C_SBK = 256, C_SBV = 512, C_MBQ = 768, C_MBK = 1024, C_MBV = 1280, C_CQ = 1536, C_CKV = 1792, C_KR = 1920,
              C_NQ = 1952, C_NKV = 2208, C_QM = 2592, C_GN = 2848;
constexpr int OBW = 1280;
constexpr int QMW = 384, MKW = 640;
constexpr float LOG2E = 1.4426950408889634f, LN2 = 0.6931471805599453f;
constexpr float ALPHA = 1.681792830507429f;
constexpr int NTHR = 256;
constexpr int LDS_BYTES = 69632;
constexpr int LDS_MISC = 65536;

constexpr size_t W_IN = 0, W_UQ = W_IN + (size_t)PW * 1024, W_UKV = W_UQ + 384 * 256, W_PHI1 = W_UKV + 512 * 128, W_PHI2 = W_PHI1 + 2 * 128 * 2048,
                 W_MEM = W_PHI2 + 2 * 128 * 128, W_BR = W_MEM + 512 * 1024, W_G = W_BR + 5 * 1024 * 256, W_OUT = W_G + 5 * 1024 * 1024,
                 W_UP = W_OUT + 1024 * 1024, W_DN = W_UP + 16 * 512 * 1024, W_END = W_DN + 16 * 1024 * 256;

constexpr size_t MiB = 1u << 20;
constexpr size_t WS_CTL = 0;
constexpr size_t WS_HB = 1 * MiB;
constexpr size_t WS_P = WS_HB + 64 * MiB;
constexpr size_t WS_MG = WS_P;
constexpr size_t WS_ACT = WS_P + 64 * MiB;
constexpr size_t WS_OB = WS_P + 184 * MiB;
constexpr size_t WS_QM = WS_OB + 80 * MiB;
constexpr size_t WS_MK = WS_QM + 24 * MiB;
constexpr size_t WS_W = WS_MK + 40 * MiB;
constexpr size_t WS_MEMB = WS_W + 47 * MiB;
constexpr size_t WS_MEMKV = WS_MEMB + 2 * MiB;
constexpr size_t WS_HC = WS_MEMKV + 1 * MiB;
constexpr size_t WS_KC = WS_HC + 1 * MiB;
constexpr size_t WS_KMEAN = WS_KC + 1 * MiB;
constexpr size_t WS_CPART = WS_KMEAN + 1 * MiB;
constexpr size_t WS_LTOK = WS_CPART + 1 * MiB;
constexpr size_t WS_LW = WS_LTOK + 3 * MiB;
constexpr size_t WS_STASH = WS_LW + 6 * MiB;
constexpr size_t WS_HB8 = WS_STASH + 16 * MiB;
constexpr size_t WS_END = WS_HB8 + 32 * MiB;
static_assert(WS_END <= 508 * MiB, "workspace map");
static_assert(W_END * 2 <= 47 * MiB, "weights");
constexpr int CW_Q = 64;
constexpr int CW_CNT = 20480;
constexpr int CW_BAR = 1024;
constexpr int CW_MB = 32768;

struct Params { const float* in[27]; float* out; unsigned char* ws; };

DI unsigned cvtpk(float lo, float hi) { f32x2 v = {lo, hi}; bf16x2_t b = __builtin_convertvector(v, bf16x2_t); return __builtin_bit_cast(unsigned, b); }
DI float bf2f(unsigned short x) { return __builtin_bit_cast(float, (unsigned)x << 16); }
DI float bflo(unsigned u) { return __builtin_bit_cast(float, u << 16); }
DI float bfhi(unsigned u) { return __builtin_bit_cast(float, u & 0xffff0000u); }
DI unsigned pk4_fp8(float a, float b, float c, float d) { int v = 0;
    a = __builtin_amdgcn_fmed3f(a, -448.f, 448.f); b = __builtin_amdgcn_fmed3f(b, -448.f, 448.f); c = __builtin_amdgcn_fmed3f(c, -448.f, 448.f); d = __builtin_amdgcn_fmed3f(d, -448.f, 448.f); v = __builtin_amdgcn_cvt_pk_fp8_f32(a, b, v, false); v = __builtin_amdgcn_cvt_pk_fp8_f32(c, d, v, true); return (unsigned)v; }
DI f32x16 mfma(bf16x8 a, bf16x8 b, f32x16 c) { return __builtin_amdgcn_mfma_f32_32x32x16_bf16(a, b, c, 0, 0, 0); }
DI float ex2(float x) { return __builtin_amdgcn_exp2f(x); }
DI float rcpf_(float x) { return __builtin_amdgcn_rcpf(x); }
DI float lg2(float x) { return __builtin_amdgcn_logf(x); }
DI float wave_sum(float v) {
#pragma unroll
    for (int o = 32; o >= 1; o >>= 1) v += __shfl_xor(v, o);
    return v;
}
DI s16x4 vtr(const bf16_t* p) { return __builtin_bit_cast(s16x4, __builtin_amdgcn_ds_read_tr16_b64_v4i16((LAS v4i16_t*)(LAS char*)(p))); }
DI int opaque_tid() { int t = threadIdx.x; asm volatile("" : "+v"(t)); return t; }
DI f32x16 zero16() { f32x16 z;
#pragma unroll
    for (int i = 0; i < 16; ++i) z[i] = 0.f; return z; }

constexpr int NST = 2, STAGE_B = 32768;
DI void glds16(const void* gsrc, unsigned lds_dst) { unsigned keep;
    asm volatile("s_mov_b32 %0, m0\n\ts_mov_b32 m0, %2\n\ts_nop 0\n\tglobal_load_lds_dwordx4 %1, off\n\ts_mov_b32 m0, %0" : "=&s"(keep) : "v"(gsrc), "s"(lds_dst) : "memory"); }
#define WAIT_V(n) asm volatile("s_waitcnt vmcnt(" #n ")" ::: "memory")
DI void dma_lane(int tid, int& rowE, int& cbE, int& cbO) { const int lane = tid & 63, w = tid >> 6; rowE = 32 * w + (lane >> 3);
    cbE = 16 * ((lane & 7) ^ (lane >> 4)); cbO = 16 * ((lane & 7) ^ (4 + (lane >> 4))); }
struct NoNext { static constexpr bool ON = false; DI void operator()(unsigned, unsigned) const {} };
struct NextSt { static constexpr bool ON = true; const char *aE, *aO, *aE2, *aO2, *bE, *bO; size_t b16; bool on;
    DI void operator()(unsigned dstA, unsigned dstB) const;
};
template <int F8, bool AREG, class NX = NoNext, int SCA = 127, int SCB = 127>
DI void gemm_dma(f32x16 (&acc)[2][2], const char* aE, const char* aO, const char* aE2, const char* aO2, size_t a16, size_t astride,
                 const char* bE, const char* bO, size_t b16, int nst, char* lds, int pv = 0, NX nx = NX()) {
    const int tid = opaque_tid(), lane = tid & 63, w = tid >> 6, r = lane & 31, h = lane >> 5, wr = w >> 1, wc = w & 1;
    const unsigned lbase = (unsigned)(size_t)(LAS char*)lds;
    const unsigned dstA = (unsigned)__builtin_amdgcn_readfirstlane((int)(lbase + 4096u * (unsigned)w));
    const unsigned dstB = dstA + 16384u;
    if (AREG) { aE2 = aE + a16; aO2 = aO + a16; }
    const char* bE2 = bE + b16; const char* bO2 = bO + b16;
#define GD_STAGE(t) do { const int t_ = (t); const size_t ao_ = (size_t)t_ * astride, bo_ = (size_t)t_ * 128; \
        const unsigned so_ = (unsigned)(t_ & (NST - 1)) * (unsigned)STAGE_B; \
        if (!(pv & 2)) { glds16(aE + ao_, dstA + so_); glds16(aO + ao_, dstA + so_ + 1024u); glds16(aE2 + ao_, dstA + so_ + 2048u); glds16(aO2 + ao_, dstA + so_ + 3072u); \
                         glds16(bE + bo_, dstB + so_); glds16(bO + bo_, dstB + so_ + 1024u); glds16(bE2 + bo_, dstB + so_ + 2048u); glds16(bO2 + bo_, dstB + so_ + 3072u); } } while (0)
    if (!(pv & 8)) {
    WAIT_V(0);
    __builtin_amdgcn_s_barrier();
    GD_STAGE(0);
    }
    const int sw = (r >> 1) & 7;
    const char* fa = lds + (64 * wr + r) * 128;
    const char* fb = lds + 16384 + (64 * wc + r) * 128;
    for (int t = 0; t < nst; ++t) {
        WAIT_V(0);
        __builtin_amdgcn_s_barrier();
        asm volatile("" ::: "memory");
        if (t + 1 < nst) GD_STAGE(t + 1);
        else if (NX::ON) nx(dstA, dstB);
        const char* sa = fa + (t & (NST - 1)) * STAGE_B; const char* sb = fb + (t & (NST - 1)) * STAGE_B;
        if (F8 == 1) {
#pragma unroll
            for (int ks = 0; ks < 8; ++ks) {
                const int co = ((ks ^ sw) << 4) + 8 * h;
                const long fa0 = *(const long*)(sa + co), fa1 = *(const long*)(sa + 32 * 128 + co);
                const long fb0 = *(const long*)(sb + co), fb1 = *(const long*)(sb + 32 * 128 + co);
                acc[0][0] = __builtin_amdgcn_mfma_f32_32x32x16_fp8_fp8(fb0, fa0, acc[0][0], 0, 0, 0); acc[0][1] = __builtin_amdgcn_mfma_f32_32x32x16_fp8_fp8(fb1, fa0, acc[0][1], 0, 0, 0);
                acc[1][0] = __builtin_amdgcn_mfma_f32_32x32x16_fp8_fp8(fb0, fa1, acc[1][0], 0, 0, 0); acc[1][1] = __builtin_amdgcn_mfma_f32_32x32x16_fp8_fp8(fb1, fa1, acc[1][1], 0, 0, 0);
            }
        } else if (F8 == 2) {
#pragma unroll
            for (int ks = 0; ks < 2; ++ks) {
                const int c0 = ((4 * ks + 2 * h) ^ sw) << 4, c1 = ((4 * ks + 2 * h + 1) ^ sw) << 4;
                typedef int i32x4 __attribute__((ext_vector_type(4))); typedef int i32x8 __attribute__((ext_vector_type(8)));
                const i32x4 a0l = *(const i32x4*)(sa + c0), a0h = *(const i32x4*)(sa + c1), a1l = *(const i32x4*)(sa + 32 * 128 + c0), a1h = *(const i32x4*)(sa + 32 * 128 + c1);
                const i32x4 b0l = *(const i32x4*)(sb + c0), b0h = *(const i32x4*)(sb + c1), b1l = *(const i32x4*)(sb + 32 * 128 + c0), b1h = *(const i32x4*)(sb + 32 * 128 + c1);
                const i32x8 fa0 = __builtin_shufflevector(a0l, a0h, 0, 1, 2, 3, 4, 5, 6, 7), fa1 = __builtin_shufflevector(a1l, a1h, 0, 1, 2, 3, 4, 5, 6, 7);
                const i32x8 fb0 = __builtin_shufflevector(b0l, b0h, 0, 1, 2, 3, 4, 5, 6, 7), fb1 = __builtin_shufflevector(b1l, b1h, 0, 1, 2, 3, 4, 5, 6, 7);
                acc[0][0] = __builtin_amdgcn_mfma_scale_f32_32x32x64_f8f6f4(fb0, fa0, acc[0][0], 0, 0, 0, SCA, 0, SCB); acc[0][1] = __builtin_amdgcn_mfma_scale_f32_32x32x64_f8f6f4(fb1, fa0, acc[0][1], 0, 0, 0, SCA, 0, SCB);
                acc[1][0] = __builtin_amdgcn_mfma_scale_f32_32x32x64_f8f6f4(fb0, fa1, acc[1][0], 0, 0, 0, SCA, 0, SCB); acc[1][1] = __builtin_amdgcn_mfma_scale_f32_32x32x64_f8f6f4(fb1, fa1, acc[1][1], 0, 0, 0, SCA, 0, SCB);
            }
        } else {
#pragma unroll
            for (int ks = 0; ks < 4; ++ks) {
                const int co = ((2 * ks + h) ^ sw) << 4;
                if (pv & 4) continue;
                const bf16x8 fa0 = *(const bf16x8*)(sa + co), fa1 = *(const bf16x8*)(sa + 32 * 128 + co);
                const bf16x8 fb0 = *(const bf16x8*)(sb + co), fb1 = *(const bf16x8*)(sb + 32 * 128 + co);
                if (pv & 1) { asm volatile("" :: "v"(fa0), "v"(fa1), "v"(fb0), "v"(fb1)); continue; }
                acc[0][0] = mfma(fb0, fa0, acc[0][0]); acc[0][1] = mfma(fb1, fa0, acc[0][1]);
                acc[1][0] = mfma(fb0, fa1, acc[1][0]); acc[1][1] = mfma(fb1, fa1, acc[1][1]);
            }
        }
    }
#undef GD_STAGE
}
DI void NextSt::operator()(unsigned dstA, unsigned dstB) const {
    if (on) { glds16(aE, dstA); glds16(aO, dstA + 1024u); glds16(aE2, dstA + 2048u); glds16(aO2, dstA + 3072u);
              glds16(bE, dstB); glds16(bO, dstB + 1024u); glds16(bE + b16, dstB + 2048u); glds16(bO + b16, dstB + 3072u); }
}
DI NextSt next_reg(const void* A0, size_t pa, const void* B0, size_t pb, bool on, int tid) {
    int rowE, cbE, cbO; dma_lane(tid, rowE, cbE, cbO);
    const char* aE = (const char*)A0 + (size_t)rowE * pa; const char* bE = (const char*)B0 + (size_t)rowE * pb;
    NextSt n; n.aE = aE + cbE; n.aO = aE + 8 * pa + cbO; n.aE2 = n.aE + 16 * pa; n.aO2 = n.aO + 16 * pa; n.bE = bE + cbE; n.bO = bE + 8 * pb + cbO; n.b16 = 16 * pb; n.on = on;
    return n;
}
template <class NX = NoNext>
DI void gemm_reg(f32x16 (&acc)[2][2], const bf16_t* A, size_t lda, const bf16_t* B, size_t ldb, int K, char* lds, int pv = 0, NX nx = NX()) {
    int rowE, cbE, cbO; dma_lane(opaque_tid(), rowE, cbE, cbO);
    const char* aE = (const char*)(A + (size_t)rowE * lda); const char* bE = (const char*)(B + (size_t)rowE * ldb);
    gemm_dma<0, true, NX>(acc, aE + cbE, aE + 16 * lda + cbO, nullptr, nullptr, 32 * lda, 128, bE + cbE, bE + 16 * ldb + cbO, 32 * ldb, K / 64, lds, pv, nx);
}
DI float bf_lo(unsigned u) { return __uint_as_float(u << 16); }
DI float bf_hi(unsigned u) { return __uint_as_float(u & 0xffff0000u); }
DI void zero_acc(f32x16 (&acc)[2][2]) { acc[0][0] = zero16(); acc[0][1] = zero16(); acc[1][0] = zero16(); acc[1][1] = zero16(); }

constexpr int VP = 72;
#ifndef NSA_PRE
#define NSA_PRE false
#endif
#ifndef MLA_PRE
#define MLA_PRE false
#endif
#ifndef MOBA_PRE
#define MOBA_PRE false
#endif
DI u32x4 ldg16(const void* p) { return *(const __attribute__((address_space(1))) u32x4*)p; }
template <int DQK> struct KVRegs { u32x4 k[DQK / 32]; u32x4 v[2]; };
template <int DQK> DI void kv_load(KVRegs<DQK>& R, const bf16_t* kbase, size_t kpitch, const bf16_t* vbase, size_t vpitch, int t, int keymax, int tid) {
    int key = 64 * t + (tid >> 2); key = key > keymax ? keymax : key;
    const bf16_t* kp = kbase + (size_t)key * kpitch + (tid & 3) * (DQK / 4);
#pragma unroll
    for (int i = 0; i < DQK / 32; ++i) R.k[i] = ldg16(kp + 8 * i);
    const bf16_t* vp = vbase + (size_t)key * vpitch + (tid & 3) * 16;
    R.v[0] = ldg16(vp); R.v[1] = ldg16(vp + 8);
}
template <int DQK> DI void kv_store(const KVRegs<DQK>& R, char* lds, int tid) {
    constexpr int KP = DQK + 8;
    bf16_t* Ks = (bf16_t*)lds; bf16_t* Vs = (bf16_t*)(lds + 64 * KP * 2);
    bf16_t* kp = Ks + (tid >> 2) * KP + (tid & 3) * (DQK / 4);
#pragma unroll
    for (int i = 0; i < DQK / 32; ++i) *(u32x4*)(kp + 8 * i) = R.k[i];
    bf16_t* vp = Vs + (tid >> 2) * VP + (tid & 3) * 16;
    *(u32x4*)vp = R.v[0]; *(u32x4*)(vp + 8) = R.v[1];
}
template <int DQK> DI void qk_tile(f32x16 (&s)[2], const bf16x8 (&qf)[DQK / 16], const char* lds, int tid) {
    constexpr int KP = DQK + 8; const int lane = tid & 63, r = lane & 31, h = lane >> 5;
    const bf16_t* Ks = (const bf16_t*)lds;
#pragma unroll
    for (int kh = 0; kh < 2; ++kh) {
        s[kh] = zero16();
#pragma unroll
        for (int ks = 0; ks < DQK / 16; ++ks) {
            const bf16x8 kf = *(const bf16x8*)(Ks + (32 * kh + r) * KP + 16 * ks + 8 * h);
            s[kh] = mfma(kf, qf[ks], s[kh]);
        }
    }
}
template <int DQK> DI void load_v(bf16x8 (&vf)[2][2][2], const char* lds, int tid) {
    constexpr int KP = DQK + 8; const int lane = tid & 63, h = lane >> 5;
    const bf16_t* Vs = (const bf16_t*)(lds + 64 * KP * 2);
    const int q4 = (lane & 15) >> 2, p4 = lane & 3, blk = (lane >> 4) & 1;
    const bf16_t* vb = Vs + (4 * h + q4) * VP + 16 * blk + 4 * p4;
#pragma unroll
    for (int kh = 0; kh < 2; ++kh)
#pragma unroll
        for (int st = 0; st < 2; ++st)
#pragma unroll
            for (int db = 0; db < 2; ++db) {
                const bf16_t* vp = vb + (32 * kh + 16 * st) * VP + 32 * db;
                const s16x4 lo = vtr(vp), hi = vtr(vp + 8 * VP);
                vf[kh][st][db] = __builtin_shufflevector(lo, hi, 0, 1, 2, 3, 4, 5, 6, 7);
            }
}
DI void pv_mma(f32x16 (&o)[2], const f32x16 (&p)[2], const bf16x8 (&vf)[2][2][2]) {
#pragma unroll
    for (int kh = 0; kh < 2; ++kh)
#pragma unroll
        for (int st = 0; st < 2; ++st) {
            u32x4 pk;
            pk[0] = cvtpk(p[kh][8 * st + 0], p[kh][8 * st + 1]); pk[1] = cvtpk(p[kh][8 * st + 2], p[kh][8 * st + 3]);
            pk[2] = cvtpk(p[kh][8 * st + 4], p[kh][8 * st + 5]); pk[3] = cvtpk(p[kh][8 * st + 6], p[kh][8 * st + 7]);
            const bf16x8 pf = __builtin_bit_cast(bf16x8, pk);
            o[0] = mfma(vf[kh][st][0], pf, o[0]); o[1] = mfma(vf[kh][st][1], pf, o[1]);
        }
}
template <int DQK> DI void pv_tile(f32x16 (&o)[2], const f32x16 (&p)[2], const char* lds, int tid) { bf16x8 vf[2][2][2]; load_v<DQK>(vf, lds, tid); pv_mma(o, p, vf); }
template <int DQK, class Pol, bool FULL, bool PRE> DI void flash_tile(const bf16x8 (&qf)[DQK / 16], const char* lds, int t, const Pol& pol, float& m, float& l, f32x16 (&o)[2], int tid) {
    f32x16 s[2];
    qk_tile<DQK>(s, qf, lds, tid);
    bf16x8 vf[2][2][2]; if (PRE) load_v<DQK>(vf, lds, tid);
    float mx = -1e30f;
    if (Pol::HAS_BIAS) {
#pragma unroll
        for (int kh = 0; kh < 2; ++kh)
#pragma unroll
            for (int i = 0; i < 16; ++i) {
                const int koff = 32 * kh + 8 * (i >> 2) + (i & 3);
                const float v = FULL ? pol.score_full(s[kh][i], koff) : pol.score(s[kh][i], koff);
                s[kh][i] = v; mx = fmaxf(mx, v);
            }
    } else {
#pragma unroll
        for (int kh = 0; kh < 2; ++kh)
#pragma unroll
            for (int i = 0; i < 16; ++i) {
                const int koff = 32 * kh + 8 * (i >> 2) + (i & 3);
                const float v = (FULL || pol.valid(koff)) ? s[kh][i] : -1e30f;
                s[kh][i] = v; mx = fmaxf(mx, v);
            }
        mx *= pol.sc2;
    }
    if (__any(mx > m + 8.f)) {
        mx = fmaxf(mx, __shfl_xor(mx, 32));
        const float mn = fmaxf(m, mx);
        const float alpha = ex2(m - mn);
        m = mn; l *= alpha;
#pragma unroll
        for (int i = 0; i < 16; ++i) { o[0][i] *= alpha; o[1][i] *= alpha; }
    }
    f32x2 rs2 = {0.f, 0.f};
    const float negm = -m, sc = Pol::HAS_BIAS ? 1.f : pol.sc2;
#pragma unroll
    for (int kh = 0; kh < 2; ++kh)
#pragma unroll
        for (int i = 0; i < 16; i += 2) {
            const float p0 = ex2(Pol::HAS_BIAS ? s[kh][i] + negm : fmaf(s[kh][i], sc, negm)), p1 = ex2(Pol::HAS_BIAS ? s[kh][i + 1] + negm : fmaf(s[kh][i + 1], sc, negm));
            s[kh][i] = p0; s[kh][i + 1] = p1; rs2 += (f32x2){p0, p1};
        }
    l += rs2[0] + rs2[1];
    if (!PRE) load_v<DQK>(vf, lds, tid);
    pv_mma(o, s, vf);
}
template <int DQK, bool USE_FULL, bool PRE, class Pol, class Need>
DI void flash_pass(const bf16x8 (&qf)[DQK / 16], const bf16_t* kbase, size_t kpitch, const bf16_t* vbase, size_t vpitch, int keymax,
                   int t_lo, int t_hi, Need need, int wave_tmax, Pol& pol, float& m, float& l, f32x16 (&o)[2], char* lds, int tid) {
    KVRegs<DQK> R;
    int t = t_hi - 1; while (t >= t_lo && !need(t)) --t;
    if (t >= t_lo) kv_load<DQK>(R, kbase, kpitch, vbase, vpitch, t, keymax, tid);
    while (t >= t_lo) {
        int tn = t - 1; while (tn >= t_lo && !need(tn)) --tn;
        __syncthreads();
        kv_store<DQK>(R, lds, tid);
        __syncthreads();
        if (tn >= t_lo) kv_load<DQK>(R, kbase, kpitch, vbase, vpitch, tn, keymax, tid);
        if (t <= wave_tmax) {
            pol.prep(t);
            if (USE_FULL && __all(pol.lane_full())) flash_tile<DQK, Pol, true, PRE>(qf, lds, t, pol, m, l, o, tid);
            else flash_tile<DQK, Pol, false, PRE>(qf, lds, t, pol, m, l, o, tid);
        }
        t = tn;
    }
}
struct NeedAll { DI bool operator()(int) const { return true; } };
struct NeedBits128 { unsigned long long lo, hi; DI bool operator()(int t) const { const unsigned long long w = t < 64 ? lo : hi; return (w >> (t & 63)) & 1ull; } };
struct NeedBlk4 { unsigned u; DI bool operator()(int t) const { return (u >> (t >> 2)) & 1u; } };

struct PolCausal { static constexpr bool HAS_BIAS = false; int qpos; float sc2; int lim, h4; DI void prep(int t) { lim = qpos - 64 * t - h4; }
    DI bool valid(int koff) const { return koff <= lim; }
    DI bool lane_full() const { return lim >= 59; }
    DI float score(float d, int koff) const { return koff <= lim ? d * sc2 : -1e30f; }
    DI float score_full(float d, int) const { return d * sc2; } };
struct PolMem { static constexpr bool HAS_BIAS = false; float sc2; DI bool valid(int) const { return true; } DI void prep(int) {} DI bool lane_full() const { return true; } DI float score(float d, int) const { return d * sc2; } DI float score_full(float d, int) const { return d * sc2; } };
struct PolMoba { static constexpr bool HAS_BIAS = true; DI bool valid(int) const { return true; } int qpos; float sc2, sl2; unsigned mask; int lim, h4; float base;
    DI void prep(int t) { const int kb = 64 * t + h4; lim = ((mask >> (t >> 2)) & 1u) ? qpos - kb : -1; base = sl2 * (float)(kb - qpos); }
    DI bool lane_full() const { return lim >= 59; }
    DI float score(float d, int koff) const { return koff <= lim ? fmaf(d, sc2, fmaf(sl2, (float)koff, base)) : -1e30f; }
    DI float score_full(float d, int koff) const { return fmaf(d, sc2, fmaf(sl2, (float)koff, base)); } };
struct PolRoute { static constexpr bool HAS_BIAS = true; DI bool valid(int) const { return true; } int qpos; float sc2, sl2; int h4; float base;
    DI void prep(int t) { const int kb = 64 * t + h4; base = sl2 * (float)(kb - qpos); }
    DI bool lane_full() const { return true; }
    DI float score(float d, int koff) const { return fmaf(d, sc2, fmaf(sl2, (float)koff, base)); }
    DI float score_full(float d, int koff) const { return fmaf(d, sc2, fmaf(sl2, (float)koff, base)); } };
struct PolCmp { static constexpr bool HAS_BIAS = true; DI bool valid(int) const { return true; } int qpos; float sc2, sl2; int lim, h4; float base;
    DI void prep(int t) { const int kb = 64 * t + h4; const int klim = (qpos - 31) >> 4; const int l1 = klim - kb, l2 = 510 - kb; lim = l1 < l2 ? l1 : l2; base = sl2 * (float)(16 * kb + 31 - qpos); }
    DI bool lane_full() const { return lim >= 59; }
    DI float score(float d, int koff) const { return koff <= lim ? fmaf(d, sc2, fmaf(16.f * sl2, (float)koff, base)) : -1e30f; }
    DI float score_full(float d, int koff) const { return fmaf(d, sc2, fmaf(16.f * sl2, (float)koff, base)); } };
struct PolSel { static constexpr bool HAS_BIAS = true; DI bool valid(int) const { return true; } int qpos; float sc2, sl2; unsigned long long mlo, mhi; int lim, h4; float base;
    DI void prep(int t) { const int kb = 64 * t + h4; const unsigned long long w = t < 64 ? mlo : mhi; lim = ((w >> (t & 63)) & 1ull) ? qpos - kb : -1; base = sl2 * (float)(kb - qpos); }
    DI bool lane_full() const { return lim >= 59; }
    DI float score(float d, int koff) const { return koff <= lim ? fmaf(d, sc2, fmaf(sl2, (float)koff, base)) : -1e30f; }
    DI float score_full(float d, int koff) const { return fmaf(d, sc2, fmaf(sl2, (float)koff, base)); } };
struct PolWin { static constexpr bool HAS_BIAS = true; DI bool valid(int) const { return true; } int qpos; float sc2, sl2; int lim, h4; float base;
    DI void prep(int t) { const int kb = 64 * t + h4; lim = qpos - kb; base = sl2 * (float)(kb - qpos); }
    DI bool lane_full() const { return lim >= 59 && lim < 512; }
    DI float score(float d, int koff) const { return (koff <= lim && koff > lim - 512) ? fmaf(d, sc2, fmaf(sl2, (float)koff, base)) : -1e30f; }
    DI float score_full(float d, int koff) const { return fmaf(d, sc2, fmaf(sl2, (float)koff, base)); } };

DI void store_pair16(bf16_t* rowp, u32x2 a, u32x2 b, int h) {
    const auto r0 = __builtin_amdgcn_permlane32_swap(a[0], b[0], false, false);
    const auto r1 = __builtin_amdgcn_permlane32_swap(a[1], b[1], false, false);
    u32x4 v; v[0] = r0[0]; v[1] = r1[0]; v[2] = r0[1]; v[3] = r1[1];
    *(u32x4*)(rowp + 8 * h) = v;
}
DI void store_pair8(unsigned char* rowp, unsigned a, unsigned b, int h) {
    const auto r0 = __builtin_amdgcn_permlane32_swap(a, b, false, false);
    u32x2 v; v[0] = r0[0]; v[1] = r0[1];
    *(u32x2*)(rowp + 8 * h) = v;
}
DI void write_o_bf16(bf16_t* orow, const f32x16 (&o)[2], int tid) {
    const int h = (tid & 63) >> 5;
#pragma unroll
    for (int db = 0; db < 2; ++db)
#pragma unroll
        for (int g = 0; g < 4; g += 2) {
            u32x2 wa, wb; wa[0] = cvtpk(o[db][4 * g], o[db][4 * g + 1]); wa[1] = cvtpk(o[db][4 * g + 2], o[db][4 * g + 3]);
            wb[0] = cvtpk(o[db][4 * g + 4], o[db][4 * g + 5]); wb[1] = cvtpk(o[db][4 * g + 6], o[db][4 * g + 7]);
            store_pair16(orow + 32 * db + 8 * g, wa, wb, h);
        }
}
DI void write_o(unsigned char* orow, const f32x16 (&o)[2], int tid) {
    const int h = (tid & 63) >> 5;
#pragma unroll
    for (int db = 0; db < 2; ++db)
#pragma unroll
        for (int g = 0; g < 4; ++g)
            *(unsigned*)(orow + 32 * db + 8 * g + 4 * h) = pk4_fp8(16.f * o[db][4 * g], 16.f * o[db][4 * g + 1], 16.f * o[db][4 * g + 2], 16.f * o[db][4 * g + 3]);
}
DI void load_q64(bf16x8 (&qf)[4], const bf16_t* qrow, int tid) { const int h = (tid & 63) >> 5;
#pragma unroll
    for (int ks = 0; ks < 4; ++ks) qf[ks] = *(const bf16x8*)(qrow + 16 * ks + 8 * h); }

struct Ctx {
    const Params* p; int layer; char* lds; unsigned char* wsp; int qslot;
    const __attribute__((address_space(4))) char* ka;
    DI const float* in(int i) const { return (const float*)*(const __attribute__((address_space(1))) float* const __attribute__((address_space(4)))*)(ka + 8 * i); }
    DI float* outp() const { return (float*)*(__attribute__((address_space(1))) float* const __attribute__((address_space(4)))*)(ka + 216); }
    DI unsigned char* ws() const { return wsp; }
    DI bf16_t* HB() const { return (bf16_t*)(wsp + WS_HB); }
    DI unsigned char* HB8() const { return wsp + WS_HB8; }
    DI bf16_t* P() const { return (bf16_t*)(wsp + WS_P); }
    DI bf16_t* MG() const { return (bf16_t*)(wsp + WS_MG); }
    DI bf16_t* ACT() const { return (bf16_t*)(wsp + WS_ACT); }
    DI unsigned char* OB() const { return wsp + WS_OB; }
    DI bf16_t* QM() const { return (bf16_t*)(wsp + WS_QM); }
    DI bf16_t* MK() const { return (bf16_t*)(wsp + WS_MK); }
    DI bf16_t* W() const { return (bf16_t*)(wsp + WS_W); }
    DI bf16_t* MEMB() const { return (bf16_t*)(wsp + WS_MEMB); }
    DI bf16_t* MEMKV() const { return (bf16_t*)(wsp + WS_MEMKV); }
    DI bf16_t* HC() const { return (bf16_t*)(wsp + WS_HC); }
    DI bf16_t* KC() const { return (bf16_t*)(wsp + WS_KC); }
    DI float* KMEAN() const { return (float*)(wsp + WS_KMEAN); }
    DI float* CPART() const { return (float*)(wsp + WS_CPART); }
    DI float* CBIAS() const { return (float*)(wsp + WS_CPART + 32768); }
    DI int* LTOK() const { return (int*)(wsp + WS_LTOK); }
    DI unsigned short* MBLIST() const { return (unsigned short*)(wsp + WS_LTOK); }
    DI unsigned* MBSEL() const { return (unsigned*)(wsp + WS_LTOK + 8 * MiB); }
    DI unsigned char* MBPART() const { return wsp + WS_HB; }
    DI float* LW() const { return (float*)(wsp + WS_LW); }
    DI unsigned* CTL() const { return (unsigned*)(wsp + WS_CTL); }
    DI const float* hsrc() const { return layer == 0 ? in(0) : outp(); }
    DI bf16_t* YB() const { return (bf16_t*)(wsp + WS_OB); }
};

DI bool xcd_item(int k, int NM, int NN, int& mt, int& nt) {
    const int x = blockIdx.x & 7, j = blockIdx.x >> 3, g8 = gridDim.x >> 3;
    const int per = (NM + 7) >> 3;
    const int i = j + k * g8;
    if (i >= per * NN) return false;
    mt = x * per + i / NN; nt = i % NN;
    return true;
}
DI int hb8_pos(int c) { return 16 * ((c & 255) >> 2) + 4 * (c >> 8) + (c & 3); }
DI void phase_prologue(const Ctx& c) {
    const size_t gt = (size_t)blockIdx.x * NTHR + opaque_tid(), gs = (size_t)gridDim.x * NTHR;
    const float* x = c.in(0);
    for (size_t i = gt; i < (size_t)T * DM / 8; i += gs) {
        const f32x4 a = *(const f32x4*)(x + i * 8), b = *(const f32x4*)(x + i * 8 + 4);
        const size_t row_ = (i * 8) >> 10; const int c_ = (int)((i * 8) & 1023);
        *(unsigned*)(c.HB8() + row_ * 1024 + hb8_pos(c_)) = pk4_fp8(a[0], a[1], a[2], a[3]); *(unsigned*)(c.HB8() + row_ * 1024 + hb8_pos(c_ + 4)) = pk4_fp8(b[0], b[1], b[2], b[3]);
    }
    const float* mem = c.in(1); bf16_t* mb = c.MEMB();
    for (size_t i = gt; i < (size_t)1024 * 1024 / 8; i += gs) {
        const f32x4 a = *(const f32x4*)(mem + i * 8), b = *(const f32x4*)(mem + i * 8 + 4);
        u32x4 o; o[0] = cvtpk(a[0], a[1]); o[1] = cvtpk(a[2], a[3]); o[2] = cvtpk(b[0], b[1]); o[3] = cvtpk(b[2], b[3]);
        *(u32x4*)(mb + i * 8) = o;
    }
}

DI void conv_tile(const float* src, int ld_src, bf16_t* dst, int K, int kt, int nt, int kind, const float* gain, char* lds) {
    float* tile = (float*)lds; const int tid = opaque_tid();
    const int k0 = kt * 64, n0 = nt * 64;
    __syncthreads();
    {
        const int nl = tid & 63; const int np = n0 + nl; int ns = np; bool valid = true;
        if (kind == 1) { if (np < 2592) ns = np; else if (np < 2848) ns = np + 12; else if (np < 2860) ns = np - 256; else valid = false; }
        else if (kind == 2) { const int j = np >> 6, cc = np & 63; ns = cc < 32 ? 32 * j + cc : 256 + 32 * j + cc - 32; }
        else if (kind == 3) { valid = np < 64; }
#pragma unroll
        for (int i = 0; i < 16; ++i) {
            const int kl = (tid >> 6) + 4 * i;
            float v = valid ? src[(size_t)(k0 + kl) * ld_src + ns] : 0.f;
            if (gain) v *= gain[k0 + kl];
            tile[kl * 65 + nl] = v;
        }
    }
    __syncthreads();
    {
        const int kl = tid & 63;
#pragma unroll
        for (int i = 0; i < 16; ++i) {
            const int nl = (tid >> 6) + 4 * i;
            const float v = tile[kl * 65 + nl];
            dst[(size_t)(n0 + nl) * K + k0 + kl] = (bf16_t)(cvtpk(v, v) & 0xffffu);
        }
    }
}
DI void conv_tile_f8(const float* src, int ld_src, unsigned char* dst8, int K, int kt, int nt, int kind, float scale, char* lds) {
    float* tile = (float*)lds; const int tid = opaque_tid();
    const int k0 = kt * 64, n0 = nt * 64;
    __syncthreads();
    {
        const int nl = tid & 63; const int np = n0 + nl; int ns = np; bool valid = true;
        if (kind == 1) { if (np < 2592) ns = np; else if (np < 2848) ns = np + 12; else if (np < 2860) ns = np - 256; else valid = false; }
        else if (kind == 2) { const int j = np >> 6, cc = np & 63; ns = cc < 32 ? 32 * j + cc : 256 + 32 * j + cc - 32; }
#pragma unroll
        for (int i = 0; i < 16; ++i) { const int kl = (tid >> 6) + 4 * i; tile[kl * 65 + nl] = valid ? src[(size_t)(k0 + kl) * ld_src + ns] * scale : 0.f; }
    }
    __syncthreads();
#pragma unroll
    for (int q = 0; q < 4; ++q) { const int kq = tid & 15, nl = (tid >> 4) + 16 * q;
        *(unsigned*)(dst8 + (size_t)(n0 + nl) * K + k0 + 4 * kq) = pk4_fp8(tile[(4 * kq) * 65 + nl], tile[(4 * kq + 1) * 65 + nl], tile[(4 * kq + 2) * 65 + nl], tile[(4 * kq + 3) * 65 + nl]); }
}
DI bool conv_job_f8(int& t, const float* src, int ld_src, unsigned char* dst8, int K, int N, int kind, float scale, char* lds) {
    const int nkt = K / 64, cnt = nkt * (N / 64);
    if (t < cnt) { conv_tile_f8(src, ld_src, dst8, K, t % nkt, t / nkt, kind, scale, lds); return true; }
    t -= cnt; return false;
}
DI bool conv_job(int& t, const float* src, int ld_src, bf16_t* dst, int K, int N, int kind, const float* gain, char* lds) {
    const int nkt = K / 64, cnt = nkt * (N / 64);
    if (t < cnt) { conv_tile(src, ld_src, dst, K, t % nkt, t / nkt, kind, gain, lds); return true; }
    t -= cnt; return false;
}
struct WJob { const __attribute__((address_space(1))) float* src; const __attribute__((address_space(1))) float* gain; __attribute__((address_space(1))) unsigned char* dst; float scale; int ld, K, k0, n0, kind, f8, perm; };
DI bool w_decode(const Ctx& c, int item, WJob& j) {
    const int l = c.layer; unsigned char* W = (unsigned char*)c.W(); int t = item;
    j.gain = (const __attribute__((address_space(1))) float*)nullptr; j.scale = 1.f; j.kind = 0; j.f8 = 0; j.perm = 0;
    int N = 0; size_t dsto = 0;
#define WJ_ENT(CNT, SRC, LD, DSTE, DST8ADD, KK, NN, KIND, GAIN, SCALE, F8) \
    if (t < (CNT)) { j.src = (const __attribute__((address_space(1))) float*)(SRC); j.ld = (LD); dsto = (DSTE); j.K = (KK); N = (NN); j.kind = (KIND); j.gain = (const __attribute__((address_space(1))) float*)(GAIN); j.scale = (SCALE); j.f8 = (F8); j.perm = ((DSTE) == W_IN || (DSTE) == W_G || (DSTE) == W_UP) ? 1 : 0; j.dst = (__attribute__((address_space(1))) unsigned char*)(W + 2 * dsto + (DST8ADD)); \
                     const int nkt = (KK) / 64; j.k0 = 64 * (t % nkt); j.n0 = 64 * (t / nkt); return true; } t -= (CNT);
    WJ_ENT(16 * 46, c.in(2) + (size_t)l * 1024 * 2860, 2860, W_IN, 0, 1024, PW, 1, nullptr, 32.f, 1)
    WJ_ENT(4 * 6, c.in(5) + (size_t)l * 256 * 384, 384, W_UQ, 0, 256, 384, 0, c.in(3) + l * 256, 1.f, 0)
    WJ_ENT(2 * 8, c.in(6) + (size_t)l * 128 * 512, 512, W_UKV, 0, 128, 512, 0, c.in(4) + l * 128, 1.f, 0)
    WJ_ENT(32 * 2, c.in(8) + (size_t)l * 2048 * 128, 128, W_PHI1, 0, 2048, 128, 0, nullptr, 1.f, 0)
    WJ_ENT(32 * 2, c.in(10) + (size_t)l * 2048 * 128, 128, W_PHI1 + 128 * 2048, 0, 2048, 128, 0, nullptr, 1.f, 0)
    WJ_ENT(2 * 2, c.in(9) + (size_t)l * 128 * 64, 64, W_PHI2, 0, 128, 128, 3, nullptr, 1.f, 0)
    WJ_ENT(2 * 2, c.in(11) + (size_t)l * 128 * 64, 64, W_PHI2 + 128 * 128, 0, 128, 128, 3, nullptr, 1.f, 0)
    WJ_ENT(16 * 8, c.in(12) + (size_t)l * 1024 * 512, 512, W_MEM, 0, 1024, 512, 0, nullptr, 1.f, 0)
    if (t < 5 * 64) { const int i = t / 64; t %= 64; WJ_ENT(64, c.in(13) + ((size_t)l * 5 + i) * 256 * 1024, 1024, W_BR, (size_t)i * 1024 * 256, 256, 1024, 0, nullptr, 32.f, 1) } t -= 5 * 64;
    if (t < 5 * 256) { const int i = t / 256; t %= 256; WJ_ENT(256, c.in(14) + ((size_t)l * 5 + i) * 1024 * 1024, 1024, W_G, (size_t)i * 1024 * 1024, 1024, 1024, 0, nullptr, 32.f, 1) } t -= 5 * 256;
    WJ_ENT(256, c.in(16) + (size_t)l * 1024 * 1024, 1024, W_OUT, 0, 1024, 1024, 0, nullptr, 64.f, 1)
    if (t < 16 * 128) { const int e = t / 128; t %= 128; WJ_ENT(128, c.in(23) + ((size_t)l * 16 + e) * 1024 * 512, 512, W_UP, (size_t)e * 512 * 1024, 1024, 512, 2, nullptr, 32.f, 1) } t -= 16 * 128;
    if (t < 16 * 64) { const int e = t / 64; t %= 64; WJ_ENT(64, c.in(24) + ((size_t)l * 16 + e) * 256 * 1024, 1024, W_DN, (size_t)e * 1024 * 256, 256, 1024, 0, nullptr, 32.f, 1) } t -= 16 * 64;
#undef WJ_ENT
    j.k0 = t; (void)N;
    return false;
}
DI void w_load(const WJob& j, float (&v)[16], int tid) {
    const int nl = tid & 63, np = j.n0 + nl; int ns = np; bool valid = true;
    if (j.kind == 1) { if (np < 2592) ns = np; else if (np < 2848) ns = np + 12; else if (np < 2860) ns = np - 256; else valid = false; }
    else if (j.kind == 2) { const int jj = np >> 6, cc = np & 63; ns = cc < 32 ? 32 * jj + cc : 256 + 32 * jj + cc - 32; }
    else if (j.kind == 3) { valid = np < 64; }
    const __attribute__((address_space(1))) float* s = j.src + (size_t)(j.k0 + (tid >> 6)) * j.ld + ns;
#pragma unroll
    for (int i = 0; i < 16; ++i) v[i] = valid ? s[(size_t)(4 * i) * j.ld] : 0.f;
    if (j.gain) {
#pragma unroll
        for (int i = 0; i < 16; ++i) v[i] *= j.gain[j.k0 + (tid >> 6) + 4 * i];
    }
}
DI void w_finish(const WJob& j, const float (&v)[16], char* lds, int tid) {
    float* tile = (float*)lds;
    __syncthreads();
#pragma unroll
    for (int i = 0; i < 16; ++i) tile[((tid >> 6) + 4 * i) * 65 + (tid & 63)] = v[i] * j.scale;
    __syncthreads();
    if (j.f8) {
#pragma unroll
        for (int q = 0; q < 4; ++q) { const int kq = tid & 15, nl = (tid >> 4) + 16 * q;
            const int kc_ = j.k0 + 4 * kq;
            *(__attribute__((address_space(1))) unsigned*)(j.dst + (size_t)(j.n0 + nl) * j.K + (j.perm ? hb8_pos(kc_) : kc_)) = pk4_fp8(tile[(4 * kq) * 65 + nl], tile[(4 * kq + 1) * 65 + nl], tile[(4 * kq + 2) * 65 + nl], tile[(4 * kq + 3) * 65 + nl]); }
    } else {
        __attribute__((address_space(1))) bf16_t* d = (__attribute__((address_space(1))) bf16_t*)j.dst;
#pragma unroll
        for (int q = 0; q < 8; ++q) { const int kp = tid & 31, nl = (tid >> 5) + 8 * q;
            *(__attribute__((address_space(1))) unsigned*)(d + (size_t)(j.n0 + nl) * j.K + j.k0 + 2 * kp) = cvtpk(tile[(2 * kp) * 65 + nl], tile[(2 * kp + 1) * 65 + nl]); }
    }
}
DI void w_cpart(const Ctx& c, int t) {
    const int l = c.layer; const int kv = t >> 5, pp = t & 31; const int tid = opaque_tid(), j = tid & 127, hh = tid >> 7;
    const float* w1 = c.in(kv ? 10 : 8) + (size_t)l * 2048 * 128; const float* pe = c.in(7) + (size_t)l * 2048;
    float s = 0.f;
    for (int k = pp * 64 + hh * 32; k < pp * 64 + hh * 32 + 32; ++k) s += pe[k] * w1[(size_t)k * 128 + j];
    float* red = (float*)c.lds;
    __syncthreads();
    if (hh) red[j] = s;
    __syncthreads();
    if (!hh) c.CPART()[(kv * 32 + pp) * 128 + j] = s + red[j];
}
DI void phase_weights(const Ctx& c) {
    constexpr int TOTAL = 16 * 46 + 4 * 6 + 2 * 8 + 2 * 64 + 2 * 4 + 128 + 5 * 64 + 5 * 256 + 256 + 16 * 128 + 16 * 64 + 64;
    const int tid = opaque_tid(); const int G = gridDim.x;
    int item = blockIdx.x;
    WJob cur; cur.perm = 0; cur.src = (const __attribute__((address_space(1))) float*)nullptr; cur.gain = (const __attribute__((address_space(1))) float*)nullptr; cur.dst = (__attribute__((address_space(1))) unsigned char*)nullptr; cur.scale = 1.f; cur.ld = 0; cur.K = 0; cur.k0 = 0; cur.n0 = 0; cur.kind = 0; cur.f8 = 0;
    float v[16]; bool is_tile = false;
#pragma unroll
    for (int i = 0; i < 16; ++i) v[i] = 0.f;
    if (item < TOTAL) { is_tile = w_decode(c, item, cur); if (is_tile) w_load(cur, v, tid); }
    while (item < TOTAL) {
        const int nitem = item + G;
        WJob nxt = cur; float vn[16]; bool ntile = false;
#pragma unroll
        for (int i = 0; i < 16; ++i) vn[i] = 0.f;
        if (nitem < TOTAL) { ntile = w_decode(c, nitem, nxt); if (ntile) w_load(nxt, vn, tid); }
        if (is_tile) w_finish(cur, v, c.lds, tid); else w_cpart(c, cur.k0);
        cur = nxt; is_tile = ntile; item = nitem;
#pragma unroll
        for (int i = 0; i < 16; ++i) v[i] = vn[i];
    }
}

DI void store_bf16_tile(const f32x16 (&acc)[2][2], bf16_t* dst  , size_t ldc) {
    const int tid = opaque_tid(), lane = tid & 63, w = tid >> 6, r = lane & 31, h = lane >> 5, wr = w >> 1, wc = w & 1;
#pragma unroll
    for (int mi = 0; mi < 2; ++mi)
#pragma unroll
        for (int ni = 0; ni < 2; ++ni)
#pragma unroll
            for (int g = 0; g < 4; g += 2) {
                u32x2 wa, wb; wa[0] = cvtpk(acc[mi][ni][4 * g], acc[mi][ni][4 * g + 1]); wa[1] = cvtpk(acc[mi][ni][4 * g + 2], acc[mi][ni][4 * g + 3]);
                wb[0] = cvtpk(acc[mi][ni][4 * g + 4], acc[mi][ni][4 * g + 5]); wb[1] = cvtpk(acc[mi][ni][4 * g + 6], acc[mi][ni][4 * g + 7]);
                store_pair16(dst + (size_t)(64 * wr + 32 * mi + r) * ldc + 64 * wc + 32 * ni + 8 * g, wa, wb, h);
            }
}
DI void phase_proj(const Ctx& c) {
    const int tid = opaque_tid(), srow = tid >> 3, scol = (tid & 7) * 8;
    if (blockIdx.x == 0) {
        const float* cp = c.CPART(); float s = 0.f; const int kv = tid >> 7, j = tid & 127;
        for (int pp = 0; pp < 32; ++pp) s += cp[(kv * 32 + pp) * 128 + j];
        c.CBIAS()[tid] = s;
    }
    constexpr int NTN = PW / 128;
    int mt, nt; bool have = xcd_item(0, T / 128, NTN, mt, nt);
    for (int k = 0; have; ++k) {
        int mt2 = 0, nt2 = 0; const bool have2 = xcd_item(k + 1, T / 128, NTN, mt2, nt2);
        f32x16 acc[2][2]; zero_acc(acc);
        { int rowE, cbE, cbO; dma_lane(tid, rowE, cbE, cbO);
          const char* a8 = (const char*)(c.HB8() + (size_t)(128 * mt + rowE) * 1024);
          const char* b8 = (const char*)(c.W() + W_IN) + (size_t)(128 * nt + rowE) * 1024;
          const NextSt nx = next_reg(c.HB8() + (size_t)(128 * mt2) * 1024, 1024, (const char*)(c.W() + W_IN) + (size_t)(128 * nt2) * 1024, 1024, have2, tid);
          gemm_dma<2, true, NextSt, 122, 127>(acc, a8 + cbE, a8 + 8 * 1024 + cbO, nullptr, nullptr, 16 * 1024, 128, b8 + cbE, b8 + 8 * 1024 + cbO, 16 * 1024, 8, c.lds, k ? 8 : 0, nx); }
        store_bf16_tile(acc, c.P() + (size_t)(128 * mt) * PW + 128 * nt, PW);
        if (nt == 8 || nt == 9) {
            const int lane_ = tid & 63, w_ = tid >> 6, r_ = lane_ & 31, h_ = lane_ >> 5, wr_ = w_ >> 1, wc_ = w_ & 1;
            float* red = (float*)(c.lds + LDS_MISC + 2048);
#pragma unroll
            for (int ni = 0; ni < 2; ++ni)
#pragma unroll
                for (int i = 0; i < 16; ++i) {
                    float v = acc[0][ni][i] + acc[1][ni][i];
#pragma unroll
                    for (int o = 1; o <= 16; o <<= 1) v += __shfl_xor(v, o);
                    if (r_ == 0) red[wr_ * 128 + 64 * wc_ + 32 * ni + 8 * (i >> 2) + 4 * h_ + (i & 3)] = v;
                }
            __syncthreads();
            if (tid < 128) c.KMEAN()[(size_t)mt * 256 + (nt - 8) * 128 + tid] = red[tid] + red[128 + tid];
            __syncthreads();
        }
        mt = mt2; nt = nt2; have = have2;
    }
    {
        const int first = gridDim.x >= 512 ? 256 : 0;
        for (int item = (int)blockIdx.x - first; item >= 0 && item < 32; item += gridDim.x) {
            f32x16 acc[2][2]; zero_acc(acc);
            const int mt = item >> 2, nt = item & 3;
            gemm_reg(acc, c.MEMB() + (size_t)(128 * mt) * 1024, 1024, c.W() + W_MEM + (size_t)(128 * nt) * 1024, 1024, 1024, c.lds);
            store_bf16_tile(acc, c.MEMKV() + (size_t)(128 * mt) * 512 + 128 * nt, 512);
        }
    }
}

DI void sel_item(const Ctx& c, int item) {
    const int tid = opaque_tid(), lane = tid & 63, w = tid >> 6, r = lane & 31, h = lane >> 5;
    float* km = (float*)(c.lds + 24576);
    {
        const int qt = item >> 4, b = (item >> 2) & 3, head = item & 3, bh = b * 4 + head;
        const int q0 = 128 * qt, own = q0 >> 8, qpos = q0 + 32 * w + r; const size_t tok = (size_t)b * S + qpos;
        const bf16_t* qrow = c.P() + tok * PW + C_MBQ + head * 64;
        __syncthreads();
        { const float* kp = c.KMEAN() + (size_t)(b * 64) * 256 + head * 64;
          for (int i = tid; i < own * 64; i += NTHR) { const int n = i >> 6, d = i & 63; km[i] = (kp[(size_t)(2 * n) * 256 + d] + kp[(size_t)(2 * n + 1) * 256 + d]) * (1.f / 256.f); } }
        __syncthreads();
        u32x4 qq[8];
#pragma unroll
        for (int i = 0; i < 8; ++i) qq[i] = *(const u32x4*)(qrow + 8 * i);
        float v1 = -3e38f, v2 = -3e38f, v3 = -3e38f; int i1 = 255, i2 = 255, i3 = 255;
        for (int n = 0; n < own; ++n) {
            float gsc = 0.f; const float* kr = km + n * 64;
#pragma unroll
            for (int i = 0; i < 8; ++i)
#pragma unroll
                for (int e = 0; e < 4; ++e) { gsc += bflo(qq[i][e]) * kr[8 * i + 2 * e]; gsc += bfhi(qq[i][e]) * kr[8 * i + 2 * e + 1]; }
            if (gsc > v1) { v3 = v2; i3 = i2; v2 = v1; i2 = i1; v1 = gsc; i1 = n; }
            else if (gsc > v2) { v3 = v2; i3 = i2; v2 = gsc; i2 = n; }
            else if (gsc > v3) { v3 = gsc; i3 = n; }
        }
        if (h == 0) {
            c.MBSEL()[(size_t)bh * S + qpos] = (unsigned)i1 | ((unsigned)i2 << 8) | ((unsigned)i3 << 16);
            unsigned* cnt = c.CTL() + CW_MB + (512 * c.layer + bh * 32) * 64;
            unsigned short* lst = c.MBLIST() + (size_t)(bh * 32) * 8192;
            if (i1 < 255) { const unsigned pos = __hip_atomic_fetch_add(cnt + 64 * i1, 1u, __ATOMIC_RELAXED, __HIP_MEMORY_SCOPE_AGENT); lst[(size_t)i1 * 8192 + pos] = (unsigned short)(qpos | (0 << 13)); }
            if (i2 < 255) { const unsigned pos = __hip_atomic_fetch_add(cnt + 64 * i2, 1u, __ATOMIC_RELAXED, __HIP_MEMORY_SCOPE_AGENT); lst[(size_t)i2 * 8192 + pos] = (unsigned short)(qpos | (1 << 13)); }
            if (i3 < 255) { const unsigned pos = __hip_atomic_fetch_add(cnt + 64 * i3, 1u, __ATOMIC_RELAXED, __HIP_MEMORY_SCOPE_AGENT); lst[(size_t)i3 * 8192 + pos] = (unsigned short)(qpos | (2 << 13)); }
        }
    }
}
DI void phase_prep1(const Ctx& c) {
    const int tid = opaque_tid(), lane = tid & 63, w = tid >> 6, r = lane & 31, h = lane >> 5, wr = w >> 1, wc = w & 1;
    const int srow = tid >> 3, scol = (tid & 7) * 8;
    float* rstd = (float*)(c.lds + LDS_MISC);
    constexpr int N_C = 32, N_KM = 1024, N_Q = 256 * 3, N_KV = 256 * 4, TOTAL = N_C + N_KM + N_Q + N_KV;
    unsigned* qh = c.CTL() + 512 + 16 * c.layer;
    volatile int* qslot = (volatile int*)(c.lds + LDS_MISC + 3584);
    for (;;) {
        __syncthreads();
        if (threadIdx.x == 0) *qslot = (int)__hip_atomic_fetch_add(qh, 1u, __ATOMIC_RELAXED, __HIP_MEMORY_SCOPE_AGENT);
        __syncthreads();
        const int item = __builtin_amdgcn_readfirstlane(*qslot);
        if (item >= TOTAL) break;
        int t = item;
        if (t < N_C) {
            const int kv = t >> 4, mt = t & 15;
            f32x16 acc[2][2]; zero_acc(acc);
            int rowE, cbE, cbO; dma_lane(tid, rowE, cbE, cbO);
            const char* ap[4];
#pragma unroll
            for (int i = 0; i < 4; ++i) { const int gr = 128 * mt + rowE + 8 * i, b = gr >> 9; int n = gr & 511; n = n > 510 ? 510 : n;
                ap[i] = (const char*)(c.P() + (size_t)(b * S + 16 * n) * PW + C_NKV + 64 * kv) + ((i & 1) ? cbO : cbE); }
            const char* bp = (const char*)(c.W() + W_PHI1 + (size_t)kv * 128 * 2048 + (size_t)rowE * 2048);
            gemm_dma<0, false>(acc, ap[0], ap[1], ap[2], ap[3], 0, (size_t)PW * 2, bp + cbE, bp + 8 * 2048 * 2 + cbO, 16 * 2048 * 2, 32, c.lds);
            const float* cbias = c.CBIAS() + kv * 128; bf16_t* hc = c.HC() + (size_t)kv * 2048 * 128 + (size_t)(128 * mt) * 128;
#pragma unroll
            for (int mi = 0; mi < 2; ++mi)
#pragma unroll
                for (int ni = 0; ni < 2; ++ni)
#pragma unroll
                    for (int g = 0; g < 4; ++g) {
                        const int col = 64 * wc + 32 * ni + 8 * g + 4 * h; const f32x4 bv = *(const f32x4*)(cbias + col);
                        float o4[4];
#pragma unroll
                        for (int e = 0; e < 4; ++e) { const float x = acc[mi][ni][4 * g + e] + bv[e]; const float y = 0.7978845608028654f * (x + 0.044715f * x * x * x);
                            o4[e] = x * rcpf_(1.f + ex2(-2.f * LOG2E * y)); }
                        u32x2 wv; wv[0] = cvtpk(o4[0], o4[1]); wv[1] = cvtpk(o4[2], o4[3]);
                        *(u32x2*)(hc + (size_t)(64 * wr + 32 * mi + r) * 128 + col) = wv;
                    }
            f32x16 acc2[2][2]; zero_acc(acc2);
            gemm_reg(acc2, hc, 128, c.W() + W_PHI2 + (size_t)kv * 128 * 128, 128, 128, c.lds);
            if (wc == 0) {
                bf16_t* dst = c.KC() + (size_t)kv * 2048 * 64 + (size_t)(128 * mt) * 64;
#pragma unroll
                for (int mi = 0; mi < 2; ++mi)
#pragma unroll
                    for (int ni = 0; ni < 2; ++ni)
#pragma unroll
                        for (int g = 0; g < 4; ++g) {
                            u32x2 wv; wv[0] = cvtpk(acc2[mi][ni][4 * g], acc2[mi][ni][4 * g + 1]); wv[1] = cvtpk(acc2[mi][ni][4 * g + 2], acc2[mi][ni][4 * g + 3]);
                            *(u32x2*)(dst + (size_t)(64 * wr + 32 * mi + r) * 64 + 32 * ni + 8 * g + 4 * h) = wv;
                        }
            }
            continue;
        }
        t -= N_C;
        if (t < N_KM) { sel_item(c, t); continue; }
        t -= N_KM;
        if (t < N_Q) {
            const int mt = t / 3, ct = t % 3;
            __syncthreads();
            { const int row = tid >> 1, half = tid & 1; const bf16_t* src = c.P() + (size_t)(128 * mt + row) * PW + C_CQ + half * 128; float ss = 0.f;
#pragma unroll
              for (int i = 0; i < 16; ++i) { const u32x4 v = *(const u32x4*)(src + 8 * i);
#pragma unroll
                  for (int e = 0; e < 4; ++e) { const float a = bflo(v[e]), bq = bfhi(v[e]); ss += a * a + bq * bq; } }
              ss += __shfl_xor(ss, 1);
              if (!half) rstd[row] = __builtin_amdgcn_rsqf(ss * (1.f / 256.f) + 1e-6f); }
            f32x16 acc[2][2]; zero_acc(acc);
            gemm_reg(acc, c.P() + (size_t)(128 * mt) * PW + C_CQ, PW, c.W() + W_UQ + (size_t)(128 * ct) * 256, 256, 256, c.lds);
            bf16_t* dst = c.QM() + (size_t)(128 * mt) * QMW + 128 * ct;
#pragma unroll
            for (int mi = 0; mi < 2; ++mi) { const float sc = rstd[64 * wr + 32 * mi + r];
#pragma unroll
                for (int ni = 0; ni < 2; ++ni)
#pragma unroll
                    for (int g = 0; g < 4; g += 2) {
                        u32x2 wa, wb; wa[0] = cvtpk(acc[mi][ni][4 * g] * sc, acc[mi][ni][4 * g + 1] * sc); wa[1] = cvtpk(acc[mi][ni][4 * g + 2] * sc, acc[mi][ni][4 * g + 3] * sc);
                        wb[0] = cvtpk(acc[mi][ni][4 * g + 4] * sc, acc[mi][ni][4 * g + 5] * sc); wb[1] = cvtpk(acc[mi][ni][4 * g + 6] * sc, acc[mi][ni][4 * g + 7] * sc);
                        store_pair16(dst + (size_t)(64 * wr + 32 * mi + r) * QMW + 64 * wc + 32 * ni + 8 * g, wa, wb, h);
                    } }
            continue;
        }
        t -= N_Q;
        {
            const int mt = t >> 2, ct = t & 3;
            __syncthreads();
            { const int row = tid >> 1, half = tid & 1; const bf16_t* src = c.P() + (size_t)(128 * mt + row) * PW + C_CKV + half * 64; float ss = 0.f;
#pragma unroll
              for (int i = 0; i < 8; ++i) { const u32x4 v = *(const u32x4*)(src + 8 * i);
#pragma unroll
                  for (int e = 0; e < 4; ++e) { const float a = bflo(v[e]), bq = bfhi(v[e]); ss += a * a + bq * bq; } }
              ss += __shfl_xor(ss, 1);
              if (!half) rstd[row] = __builtin_amdgcn_rsqf(ss * (1.f / 128.f) + 1e-6f);
              if (ct == 0) {
                  const int tok = 128 * mt + row; const float pos = (float)(tok & (S - 1));
                  const bf16_t* kr = c.P() + (size_t)tok * PW + C_KR + 8 * half;
                  const u32x4 x1 = *(const u32x4*)kr, x2 = *(const u32x4*)(kr + 16);
                  float o1[8], o2[8];
#pragma unroll
                  for (int j = 0; j < 8; ++j) { const int i = 8 * half + j; const float fr = ex2(-(float)i * (13.287712379549449f / 16.f)) * 0.15915494309189535f;
                      const float tt = pos * fr; const float ph = tt - floorf(tt); const float sn = __builtin_amdgcn_sinf(ph), cs = __builtin_amdgcn_cosf(ph);
                      const float a = (j & 1) ? bfhi(x1[j >> 1]) : bflo(x1[j >> 1]), bq = (j & 1) ? bfhi(x2[j >> 1]) : bflo(x2[j >> 1]);
                      o1[j] = a * cs - bq * sn; o2[j] = a * sn + bq * cs; }
                  u32x4 w1v, w2v;
#pragma unroll
                  for (int j = 0; j < 4; ++j) { w1v[j] = cvtpk(o1[2 * j], o1[2 * j + 1]); w2v[j] = cvtpk(o2[2 * j], o2[2 * j + 1]); }
                  bf16_t* d = c.MK() + (size_t)tok * MKW + 64 + 8 * half;
#pragma unroll
                  for (int hd = 0; hd < 4; ++hd) { *(u32x4*)(d + hd * 160) = w1v; *(u32x4*)(d + hd * 160 + 16) = w2v; }
              } }
            f32x16 acc[2][2]; zero_acc(acc);
            gemm_reg(acc, c.P() + (size_t)(128 * mt) * PW + C_CKV, PW, c.W() + W_UKV + (size_t)(128 * ct) * 128, 128, 128, c.lds);
            bf16_t* dst = c.MK() + (size_t)(128 * mt) * MKW + ct * 160 + (wc ? 96 : 0);
#pragma unroll
            for (int mi = 0; mi < 2; ++mi) { const float sc = rstd[64 * wr + 32 * mi + r];
#pragma unroll
                for (int ni = 0; ni < 2; ++ni)
#pragma unroll
                    for (int g = 0; g < 4; g += 2) {
                        u32x2 wa, wb; wa[0] = cvtpk(acc[mi][ni][4 * g] * sc, acc[mi][ni][4 * g + 1] * sc); wa[1] = cvtpk(acc[mi][ni][4 * g + 2] * sc, acc[mi][ni][4 * g + 3] * sc);
                        wb[0] = cvtpk(acc[mi][ni][4 * g + 4] * sc, acc[mi][ni][4 * g + 5] * sc); wb[1] = cvtpk(acc[mi][ni][4 * g + 6] * sc, acc[mi][ni][4 * g + 7] * sc);
                        store_pair16(dst + (size_t)(64 * wr + 32 * mi + r) * MKW + 32 * ni + 8 * g, wa, wb, h);
                    } }
        }
    }
}

DI void phase_prep2(const Ctx& c) {
    const int tid = opaque_tid(), lane = tid & 63, w = tid >> 6, r = lane & 31, h = lane >> 5, wr = w >> 1, wc = w & 1;
    const int srow = tid >> 3, scol = (tid & 7) * 8;
    for (int item = blockIdx.x; item < 32; item += gridDim.x) {
        const int kv = item >> 4, mt = item & 15;
        f32x16 acc[2][2]; zero_acc(acc);
        gemm_reg(acc, c.HC() + (size_t)kv * 2048 * 128 + (size_t)(128 * mt) * 128, 128, c.W() + W_PHI2 + (size_t)kv * 128 * 128, 128, 128, c.lds);
        if (wc == 0) {
            bf16_t* dst = c.KC() + (size_t)kv * 2048 * 64 + (size_t)(128 * mt) * 64;
#pragma unroll
            for (int mi = 0; mi < 2; ++mi)
#pragma unroll
                for (int ni = 0; ni < 2; ++ni)
#pragma unroll
                    for (int g = 0; g < 4; ++g) {
                        u32x2 wv; wv[0] = cvtpk(acc[mi][ni][4 * g], acc[mi][ni][4 * g + 1]); wv[1] = cvtpk(acc[mi][ni][4 * g + 2], acc[mi][ni][4 * g + 3]);
                        *(u32x2*)(dst + (size_t)(64 * wr + 32 * mi + r) * 64 + 32 * ni + 8 * g + 4 * h) = wv;
                    }
        }
    }
}

DI void sb_item(const Ctx& c, int b, int head, int qt) {
    const int tid = opaque_tid(), lane = tid & 63, w = tid >> 6, r = lane & 31, h = lane >> 5;
    const int q0 = 128 * qt, qpos = q0 + 32 * w + r; const size_t tok = (size_t)b * S + qpos;
    bf16x8 qf[4]; load_q64(qf, c.P() + tok * PW + C_SBQ + head * 64, tid);
    const bf16_t* kbase = c.P() + (size_t)b * S * PW + C_SBK + head * 64; const bf16_t* vbase = c.P() + (size_t)b * S * PW + C_SBV + head * 64;
    volatile int* flags = (volatile int*)(c.lds + 40960);
    f32x16 o[2]; o[0] = zero16(); o[1] = zero16();
    float carry = 0.f;
    const int t_top = 2 * qt + 1;
    KVRegs<64> R; kv_load<64>(R, kbase, PW, vbase, PW, t_top, S - 1, tid);
    for (int t = t_top; t >= 0; --t) {
        __syncthreads();
        if (t != t_top) { const int any = flags[0] | flags[1] | flags[2] | flags[3]; if (!any) break; }
        kv_store<64>(R, c.lds, tid);
        __syncthreads();
        if (t > 0) kv_load<64>(R, kbase, PW, vbase, PW, t - 1, S - 1, tid);
        f32x16 s[2];
        qk_tile<64>(s, qf, c.lds, tid);
        const int lim = qpos - 64 * t - 4 * h;
#pragma unroll
        for (int kh = 1; kh >= 0; --kh) {
            float G[4], Go[4], lkv[16];
#pragma unroll
            for (int g = 0; g < 4; ++g) { G[g] = 0.f;
#pragma unroll
                for (int e = 0; e < 4; ++e) { const int i = 4 * g + e; const int koff = 32 * kh + 8 * g + e;
                    const float z = s[kh][i] * 0.125f; const float az = fabsf(z);
                    const float sp = fmaxf(z, 0.f) + LN2 * lg2(1.f + ex2(-az * LOG2E));
                    const float lk = koff < lim ? -sp : 0.f;
                    lkv[i] = lk; s[kh][i] = z; G[g] += lk; } }
#pragma unroll
            for (int g = 0; g < 4; ++g) Go[g] = __shfl_xor(G[g], 32);
            float tot = 0.f, gs[4];
#pragma unroll
            for (int g = 3; g >= 0; --g) { gs[g] = tot + (h == 0 ? Go[g] : 0.f); tot += G[g] + Go[g]; }
#pragma unroll
            for (int g = 0; g < 4; ++g) { float insuf = 0.f;
#pragma unroll
                for (int e = 3; e >= 0; --e) { const int i = 4 * g + e; const int koff = 32 * kh + 8 * g + e;
                    const bool valid = koff < lim;
                    const float a = valid ? ex2((s[kh][i] + lkv[i] + carry + gs[g] + insuf) * LOG2E) : 0.f;
                    insuf += lkv[i]; s[kh][i] = a; } }
            carry += tot;
        }
        pv_tile<64>(o, s, c.lds, tid);
        const int act = __any(carry >= -104.f);
        if (lane == 0) flags[w] = act;
    }
    write_o(c.OB() + tok * OBW + 0 + head * 64, o, tid);
}

DI void moba_sel_item(const Ctx& c, int bhblk, int chunk) {
    const int tid = opaque_tid(), lane = tid & 63, w = tid >> 6, r = lane & 31, h = lane >> 5;
    const int bh = bhblk >> 5, blk = bhblk & 31, b = bh >> 2, head = bh & 3;
    const int cnt = (int)c.CTL()[CW_MB + (512 * c.layer + bhblk) * 64];
    int e = chunk * 128 + 32 * w + r; const bool live = e < cnt; e = live ? e : cnt - 1;
    const unsigned ent = c.MBLIST()[(size_t)bhblk * 8192 + e];
    const int qpos = ent & 0x1FFF, slot = ent >> 13;
    const bf16_t* qrow = c.P() + ((size_t)b * S + qpos) * PW + C_MBQ + head * 64;
    bf16x8 qf[4]; load_q64(qf, qrow, tid);
    PolRoute pol; pol.qpos = qpos; pol.sc2 = 0.125f * LOG2E; pol.sl2 = exp2f(-2.f * (float)(head + 1)) * LOG2E; pol.h4 = 4 * h; pol.base = 0.f;
    float m = -1e30f, l = 0.f; f32x16 o[2]; o[0] = zero16(); o[1] = zero16();
    const bf16_t* kbase = c.P() + (size_t)b * S * PW + C_MBK + head * 64; const bf16_t* vbase = c.P() + (size_t)b * S * PW + C_MBV + head * 64;
    flash_pass<64, true, false>(qf, kbase, PW, vbase, PW, S - 1, 4 * blk, 4 * blk + 4, NeedAll(), 1 << 30, pol, m, l, o, c.lds, tid);
    l += __shfl_xor(l, 32);
    const float inv = 1.f / l;
#pragma unroll
    for (int i = 0; i < 16; ++i) { o[0][i] *= inv; o[1][i] *= inv; }
    if (live) {
        unsigned char* rec = c.MBPART() + ((size_t)(bh * S + qpos) * 3 + slot) * 144;
        if (h == 0) { f32x2 ml = {m, l}; *(f32x2*)rec = ml; }
        write_o_bf16((bf16_t*)(rec + 16), o, tid);
    }
}
DI void moba_own_item(const Ctx& c, int b, int head, int qt) {
    const int tid = opaque_tid(), lane = tid & 63, w = tid >> 6, r = lane & 31, h = lane >> 5;
    const int q0 = 128 * qt, own = q0 >> 8, qpos = q0 + 32 * w + r, bh = b * 4 + head; const size_t tok = (size_t)b * S + qpos;
    const bf16_t* qrow = c.P() + tok * PW + C_MBQ + head * 64;
    bf16x8 qf[4]; load_q64(qf, qrow, tid);
    PolMoba pol; pol.qpos = qpos; pol.sc2 = 0.125f * LOG2E; pol.sl2 = exp2f(-2.f * (float)(head + 1)) * LOG2E; pol.mask = 1u << own; pol.lim = -1; pol.h4 = 4 * h; pol.base = 0.f;
    float m = -1e30f, l = 0.f; f32x16 o[2]; o[0] = zero16(); o[1] = zero16();
    const bf16_t* kbase = c.P() + (size_t)b * S * PW + C_MBK + head * 64; const bf16_t* vbase = c.P() + (size_t)b * S * PW + C_MBV + head * 64;
    flash_pass<64, true, false>(qf, kbase, PW, vbase, PW, S - 1, 4 * own, 2 * qt + 2, NeedAll(), (q0 + 32 * w + 31) >> 6, pol, m, l, o, c.lds, tid);
    l += __shfl_xor(l, 32);
    const unsigned sel = c.MBSEL()[(size_t)bh * S + qpos];
    const unsigned char* rec0 = c.MBPART() + (size_t)(bh * S + qpos) * 3 * 144;
    float mk[3], lk[3]; float M = m;
#pragma unroll
    for (int k = 0; k < 3; ++k) { const bool on = ((sel >> (8 * k)) & 255u) != 255u; const f32x2 ml = on ? *(const f32x2*)(rec0 + k * 144) : (f32x2){-1e30f, 0.f}; mk[k] = ml[0]; lk[k] = ml[1]; M = fmaxf(M, mk[k]); }
    const float wown = ex2(m - M); float den = l * wown;
#pragma unroll
    for (int i = 0; i < 16; ++i) { o[0][i] *= wown; o[1][i] *= wown; }
#pragma unroll
    for (int k = 0; k < 3; ++k) {
        const float wk = lk[k] * ex2(mk[k] - M); den += wk;
        if (((sel >> (8 * k)) & 255u) != 255u) {
            const bf16_t* ok = (const bf16_t*)(rec0 + k * 144 + 16);
#pragma unroll
            for (int db = 0; db < 2; ++db)
#pragma unroll
                for (int g = 0; g < 4; ++g) { const u32x2 v = *(const u32x2*)(ok + 32 * db + 8 * g + 4 * h);
                    o[db][4 * g] += wk * bflo(v[0]); o[db][4 * g + 1] += wk * bfhi(v[0]); o[db][4 * g + 2] += wk * bflo(v[1]); o[db][4 * g + 3] += wk * bfhi(v[1]); }
        }
    }
    const float inv = 1.f / den;
#pragma unroll
    for (int i = 0; i < 16; ++i) { o[0][i] *= inv; o[1][i] *= inv; }
    write_o(c.OB() + tok * OBW + 256 + head * 64, o, tid);
}
DI void phase_attn_b(const Ctx& c) {
    for (int item = blockIdx.x; item < 1024; item += gridDim.x) { __syncthreads(); moba_own_item(c, (item >> 2) & 3, item & 3, item >> 4); }
}

DI void mla_item(const Ctx& c, int b, int head, int qt) {
    const int tid = opaque_tid(), lane = tid & 63, w = tid >> 6, r = lane & 31, h = lane >> 5;
    const int q0 = 128 * qt, qpos = q0 + 32 * w + r; const size_t tok = (size_t)b * S + qpos;
    const bf16_t* qrow = c.QM() + tok * QMW + head * 96;
    bf16x8 qf[6];
#pragma unroll
    for (int ks = 0; ks < 6; ++ks) qf[ks] = *(const bf16x8*)(qrow + 16 * ks + 8 * h);
    {
        float o1[8], o2[8];
#pragma unroll
        for (int j = 0; j < 8; ++j) { const int i = 8 * h + j; const float fr = ex2(-(float)i * (13.287712379549449f / 16.f)) * 0.15915494309189535f;
            const float tt = (float)qpos * fr; const float ph = tt - floorf(tt); const float sn = __builtin_amdgcn_sinf(ph), cs = __builtin_amdgcn_cosf(ph);
            const float a = bf2f((unsigned short)qf[4][j]), bq = bf2f((unsigned short)qf[5][j]);
            o1[j] = a * cs - bq * sn; o2[j] = a * sn + bq * cs; }
        u32x4 w1v, w2v;
#pragma unroll
        for (int j = 0; j < 4; ++j) { w1v[j] = cvtpk(o1[2 * j], o1[2 * j + 1]); w2v[j] = cvtpk(o2[2 * j], o2[2 * j + 1]); }
        qf[4] = __builtin_bit_cast(bf16x8, w1v); qf[5] = __builtin_bit_cast(bf16x8, w2v);
    }
    PolCausal pol; pol.qpos = qpos; pol.lim = -1; pol.h4 = 4 * h; pol.sc2 = 0.10206207261596577f * LOG2E;
    float m = -1e30f, l = 0.f; f32x16 o[2]; o[0] = zero16(); o[1] = zero16();
    const bf16_t* kbase = c.MK() + (size_t)b * S * MKW + head * 160; const bf16_t* vbase = kbase + 96;
    flash_pass<96, true, MLA_PRE>(qf, kbase, MKW, vbase, MKW, S - 1, 0, 2 * qt + 2, NeedAll(), (q0 + 32 * w + 31) >> 6, pol, m, l, o, c.lds, tid);
    l += __shfl_xor(l, 32);
    const float inv = 1.f / l;
#pragma unroll
    for (int i = 0; i < 16; ++i) { o[0][i] *= inv; o[1][i] *= inv; }
    write_o(c.OB() + tok * OBW + 512 + head * 64, o, tid);
}

DI void mem_item(const Ctx& c, int b, int head, int qt) {
    const int tid = opaque_tid(), lane = tid & 63, w = tid >> 6, r = lane & 31;
    const int q0 = 128 * qt, qpos = q0 + 32 * w + r; const size_t tok = (size_t)b * S + qpos;
    bf16x8 qf[4]; load_q64(qf, c.P() + tok * PW + C_QM + head * 64, tid);
    PolMem pol; pol.sc2 = 0.125f * LOG2E;
    float m = -1e30f, l = 0.f; f32x16 o[2]; o[0] = zero16(); o[1] = zero16();
    const bf16_t* kbase = c.MEMKV() + (size_t)b * 256 * 512 + head * 64; const bf16_t* vbase = kbase + 256;
    flash_pass<64, true, true>(qf, kbase, 512, vbase, 512, 255, 0, 4, NeedAll(), 1 << 30, pol, m, l, o, c.lds, tid);
    l += __shfl_xor(l, 32);
    const float inv = 1.f / l;
#pragma unroll
    for (int i = 0; i < 16; ++i) { o[0][i] *= inv; o[1][i] *= inv; }
    write_o(c.OB() + tok * OBW + 1024 + head * 64, o, tid);
}

DI void nsa_item(const Ctx& c, int b, int qg) {
    const int tid = opaque_tid(), lane = tid & 63, w = tid >> 6, r = lane & 31, h = lane >> 5;
    const int head = w, q0 = 32 * qg, qpos = q0 + r; const size_t tok = (size_t)b * S + qpos;
    constexpr int IP = 130;
    unsigned* imp = (unsigned*)(c.lds + 24576);
    unsigned* selm = (unsigned*)(c.lds + 41216);
    unsigned* uni = (unsigned*)(c.lds + 41728);
    __syncthreads();
    for (int i = tid; i < 32 * IP; i += NTHR) imp[i] = 0u;
    if (tid < 128) selm[tid] = 0u;
    if (tid < 4) uni[tid] = 0u;
    bf16x8 qf[4]; load_q64(qf, c.P() + tok * PW + C_NQ + head * 64, tid);
    const float sc2 = 0.125f * LOG2E, sl2 = exp2f(-2.f * (float)(head + 1)) * LOG2E;
    const bf16_t* grow = c.P() + tok * PW + C_GN + head * 3;
    const float g0 = 1.f / (1.f + ex2(-bf2f(grow[0]) * LOG2E)), g1 = 1.f / (1.f + ex2(-bf2f(grow[1]) * LOG2E)), g2 = 1.f / (1.f + ex2(-bf2f(grow[2]) * LOG2E));
    float* stash0 = (float*)(c.ws() + WS_STASH) + (size_t)blockIdx.x * 8192 + tid * 32;
    const bf16_t* Pb = c.P() + (size_t)b * S * PW;
    const int nct = ((2 * qg) >> 6) + 1;
    const bf16_t* kc = c.KC() + (size_t)b * 512 * 64; const bf16_t* vc = c.KC() + (size_t)2048 * 64 + (size_t)b * 512 * 64;
    float m_c, inv_c;
    {
        PolCmp pol; pol.qpos = qpos; pol.sc2 = sc2; pol.sl2 = sl2; pol.lim = -1; pol.h4 = 4 * h; pol.base = 0.f;
        float m = -1e30f, l = 0.f; f32x16 o[2]; o[0] = zero16(); o[1] = zero16();
        flash_pass<64, false, NSA_PRE>(qf, kc, 64, vc, 64, 510, 0, nct, NeedAll(), 1 << 30, pol, m, l, o, c.lds, tid);
        l += __shfl_xor(l, 32);
        const bool has = m > -0.5e30f;
        inv_c = has ? 1.f / l : 0.f; m_c = m;
        const float f = inv_c * g0;
        __attribute__((address_space(1))) float* stash = (__attribute__((address_space(1))) float*)stash0; asm volatile("" : "+v"(stash));
#pragma unroll
        for (int i = 0; i < 16; ++i) { stash[i] = o[0][i] * f; stash[16 + i] = o[1][i] * f; }
        KVRegs<64> R; kv_load<64>(R, kc, 64, vc, 64, 0, 510, tid);
        for (int t = 0; t < nct; ++t) {
            __syncthreads();
            kv_store<64>(R, c.lds, tid);
            __syncthreads();
            if (t + 1 < nct) kv_load<64>(R, kc, 64, vc, 64, t + 1, 510, tid);
            f32x16 s[2]; qk_tile<64>(s, qf, c.lds, tid); pol.prep(t);
#pragma unroll
            for (int kh = 0; kh < 2; ++kh)
#pragma unroll
                for (int g = 0; g < 4; ++g) {
                    float p4[4];
#pragma unroll
                    for (int e = 0; e < 4; ++e) p4[e] = ex2(pol.score(s[kh][4 * g + e], 32 * kh + 8 * g + e) - m_c) * inv_c;
                    const int sb = 16 * t + 8 * kh + 2 * g + h;
                    const float sum4 = (p4[0] + p4[1]) + (p4[2] + p4[3]);
                    atomicAdd(&imp[r * IP + sb], (unsigned)(sum4 * 268435456.f + 0.5f));
                    if (sb + 1 < 128) atomicAdd(&imp[r * IP + sb + 1], (unsigned)(p4[3] * 268435456.f + 0.5f));
                }
        }
    }
    __syncthreads();
    {
        const int qi = tid >> 3, sub = tid & 7; const int cur = (q0 + qi) >> 6;
        for (int half = 0; half < 2; ++half) {
            unsigned cs[8]; int rank[8];
#pragma unroll
            for (int k = 0; k < 8; ++k) { const int sidx = sub + 8 * (8 * half + k); cs[k] = (sidx == 0 || sidx == cur) ? 0xffffffffu : imp[qi * IP + (sidx & 127)]; rank[k] = 0; }
            if (sub + 64 * half > cur) break;
            for (int sp = 0; sp <= cur; ++sp) {
                const unsigned v = (sp == 0 || sp == cur) ? 0xffffffffu : imp[qi * IP + sp];
#pragma unroll
                for (int k = 0; k < 8; ++k) { const int sidx = sub + 8 * (8 * half + k); rank[k] += (v > cs[k] || (v == cs[k] && sp < sidx)) ? 1 : 0; }
            }
#pragma unroll
            for (int k = 0; k < 8; ++k) { const int sidx = sub + 8 * (8 * half + k);
                if (sidx <= cur && rank[k] < 16) { atomicOr(&selm[qi * 4 + (sidx >> 5)], 1u << (sidx & 31)); atomicOr(&uni[sidx >> 5], 1u << (sidx & 31)); } }
        }
    }
    __syncthreads();
    {
        PolSel pol; pol.qpos = qpos; pol.sc2 = sc2; pol.sl2 = sl2; pol.mlo = (unsigned long long)selm[r * 4] | ((unsigned long long)selm[r * 4 + 1] << 32); pol.mhi = (unsigned long long)selm[r * 4 + 2] | ((unsigned long long)selm[r * 4 + 3] << 32); pol.lim = -1; pol.h4 = 4 * h; pol.base = 0.f;
        NeedBits128 need; need.lo = (unsigned long long)uni[0] | ((unsigned long long)uni[1] << 32); need.hi = (unsigned long long)uni[2] | ((unsigned long long)uni[3] << 32);
        float m = -1e30f, l = 0.f; f32x16 o[2]; o[0] = zero16(); o[1] = zero16();
        flash_pass<64, false, NSA_PRE>(qf, Pb + C_NKV + 128, PW, Pb + C_NKV + 192, PW, S - 1, 0, (q0 >> 6) + 1, need, 1 << 30, pol, m, l, o, c.lds, tid);
        l += __shfl_xor(l, 32);
        const float f = g1 / l;
        __attribute__((address_space(1))) float* stash = (__attribute__((address_space(1))) float*)stash0; asm volatile("" : "+v"(stash));
#pragma unroll
        for (int i = 0; i < 16; ++i) { stash[i] += o[0][i] * f; stash[16 + i] += o[1][i] * f; }
    }
    {
        PolWin pol; pol.qpos = qpos; pol.sc2 = sc2; pol.sl2 = sl2; pol.lim = -1; pol.h4 = 4 * h; pol.base = 0.f;
        const int lo = q0 - 511; const int t_lo = lo > 0 ? (lo >> 6) : 0;
        float m = -1e30f, l = 0.f; f32x16 o[2]; o[0] = zero16(); o[1] = zero16();
        flash_pass<64, true, NSA_PRE>(qf, Pb + C_NKV + 256, PW, Pb + C_NKV + 320, PW, S - 1, t_lo, (q0 >> 6) + 1, NeedAll(), 1 << 30, pol, m, l, o, c.lds, tid);
        l += __shfl_xor(l, 32);
        const float f = g2 / l;
        __attribute__((address_space(1))) float* stash = (__attribute__((address_space(1))) float*)stash0; asm volatile("" : "+v"(stash));
#pragma unroll
        for (int i = 0; i < 16; ++i) { o[0][i] = stash[i] + o[0][i] * f; o[1][i] = stash[16 + i] + o[1][i] * f; }
        write_o(c.OB() + tok * OBW + 768 + head * 64, o, tid);
    }
}

DI void phase_attn(const Ctx& c) {
    unsigned* qhead = c.CTL() + CW_Q + 16 * c.layer + c.qslot;
    volatile int* slot = (volatile int*)(c.lds + 41984);
    int* pre = (int*)(c.lds + LDS_MISC);
    {
        const int tid = opaque_tid();
        __syncthreads();
        if (tid < 64) {
            const unsigned* cnt = c.CTL() + CW_MB + (512 * c.layer + 8 * tid) * 64;
            int loc[8], s = 0;
#pragma unroll
            for (int i = 0; i < 8; ++i) { loc[i] = s; s += ((int)cnt[64 * i] + 127) >> 7; }
            int incl = s;
#pragma unroll
            for (int o = 1; o < 64; o <<= 1) { const int v = __shfl_up(incl, o); if (tid >= o) incl += v; }
            const int excl = incl - s;
#pragma unroll
            for (int i = 0; i < 8; ++i) pre[8 * tid + i] = excl + loc[i];
            if (tid == 63) pre[512] = incl;
        }
        __syncthreads();
    }
    const int nsel = pre[512];
    for (;;) {
        __syncthreads();
        if (threadIdx.x == 0) *slot = (int)__hip_atomic_fetch_add(qhead, 1u, __ATOMIC_RELAXED, __HIP_MEMORY_SCOPE_AGENT);
        __syncthreads();
        const int item = __builtin_amdgcn_readfirstlane(*slot);
        if (item >= 4096 + nsel) break;
        if (item < 1024) { nsa_item(c, item & 3, 255 - (item >> 2)); }
        else if (item < 2048) { const int j = item - 1024; mla_item(c, (j >> 2) & 3, j & 3, 63 - (j >> 4)); }
        else if (item < 2048 + nsel) {
            const int idx = item - 2048; int lo = 0, hi = 511;
            while (lo < hi) { const int mid = (lo + hi + 1) >> 1; if (pre[mid] <= idx) lo = mid; else hi = mid - 1; }
            moba_sel_item(c, lo, idx - pre[lo]);
        }
        else if (item < 3072 + nsel) { const int j = item - 2048 - nsel; mem_item(c, (j >> 2) & 3, j & 3, j >> 4); }
        else { const int j = item - 3072 - nsel; sb_item(c, (j >> 2) & 3, j & 3, j >> 4); }
    }
}

DI void phase_gate(const Ctx& c) {
    const int tid = opaque_tid(), lane = tid & 63, w = tid >> 6, r = lane & 31, h = lane >> 5, wr = w >> 1, wc = w & 1;
    const int srow = tid >> 3, scol = (tid & 7) * 8; const int l = c.layer;
    for (int k = 0;; ++k) {
        int mt, nt; if (!xcd_item(k, 256, 8, mt, nt)) break;
        unsigned mgp[2][2][8];
#pragma unroll
        for (int mi = 0; mi < 2; ++mi)
#pragma unroll
            for (int ni = 0; ni < 2; ++ni)
#pragma unroll
                for (int k = 0; k < 8; ++k) mgp[mi][ni][k] = 0u;
        for (int i = 0; i < 5; ++i) {
            unsigned brp[2][2][8];
            {
                f32x16 br[2][2]; zero_acc(br);
                { int rowE, cbE, cbO; dma_lane(tid, rowE, cbE, cbO);
                  const char* a8 = (const char*)c.OB() + (size_t)(128 * mt + rowE) * OBW + 256 * i;
                  const char* b8 = (const char*)(c.W() + W_BR) + (size_t)i * 1024 * 256 + (size_t)(128 * nt + rowE) * 256;
                  gemm_dma<2, true, NoNext, 122, 123>(br, a8 + cbE, a8 + 8 * OBW + cbO, nullptr, nullptr, 16 * OBW, 128, b8 + cbE, b8 + 8 * 256 + cbO, 16 * 256, 2, c.lds); }
#pragma unroll
                for (int mi = 0; mi < 2; ++mi)
#pragma unroll
                    for (int ni = 0; ni < 2; ++ni)
#pragma unroll
                        for (int k = 0; k < 8; ++k) brp[mi][ni][k] = cvtpk(br[mi][ni][2 * k], br[mi][ni][2 * k + 1]);
            }
            f32x16 ga[2][2]; zero_acc(ga);
            { int rowE, cbE, cbO; dma_lane(tid, rowE, cbE, cbO);
              const char* a8 = (const char*)(c.HB8() + (size_t)(128 * mt + rowE) * 1024);
              const char* b8 = (const char*)(c.W() + W_G) + (size_t)i * 1024 * 1024 + (size_t)(128 * nt + rowE) * 1024;
              gemm_dma<2, true, NoNext, 122, 127>(ga, a8 + cbE, a8 + 8 * 1024 + cbO, nullptr, nullptr, 16 * 1024, 128, b8 + cbE, b8 + 8 * 1024 + cbO, 16 * 1024, 8, c.lds); }
            const float* bg = c.in(15) + ((size_t)l * 5 + i) * 1024 + 128 * nt + 64 * wc + 4 * h;
#pragma unroll
            for (int ni = 0; ni < 2; ++ni)
#pragma unroll
                for (int g = 0; g < 4; ++g) {
                    f32x4 bv = *(const f32x4*)(bg + 32 * ni + 8 * g);
#pragma unroll
                    for (int e = 0; e < 4; ++e) bv[e] *= -LOG2E;
#pragma unroll
                    for (int mi = 0; mi < 2; ++mi)
#pragma unroll
                        for (int e2 = 0; e2 < 2; ++e2) {
                            const float g0 = rcpf_(1.f + ex2(fmaf(ga[mi][ni][4 * g + 2 * e2], -LOG2E, bv[2 * e2])));
                            const float g1 = rcpf_(1.f + ex2(fmaf(ga[mi][ni][4 * g + 2 * e2 + 1], -LOG2E, bv[2 * e2 + 1])));
                            const unsigned pb = brp[mi][ni][2 * g + e2], pm = mgp[mi][ni][2 * g + e2];
                            mgp[mi][ni][2 * g + e2] = cvtpk(bflo(pm) + g0 * bflo(pb), bfhi(pm) + g1 * bfhi(pb));
                        }
                }
        }
        unsigned char* dst = (unsigned char*)c.MG() + (size_t)(128 * mt) * 1024 + 128 * nt;
#pragma unroll
        for (int mi = 0; mi < 2; ++mi)
#pragma unroll
            for (int ni = 0; ni < 2; ++ni)
#pragma unroll
                for (int g = 0; g < 4; g += 2) {
                    const unsigned p0 = mgp[mi][ni][2 * g], p1 = mgp[mi][ni][2 * g + 1], p2 = mgp[mi][ni][2 * g + 2], p3 = mgp[mi][ni][2 * g + 3];
                    store_pair8(dst + (size_t)(64 * wr + 32 * mi + r) * 1024 + 64 * wc + 32 * ni + 8 * g, pk4_fp8(8.f * bflo(p0), 8.f * bfhi(p0), 8.f * bflo(p1), 8.f * bfhi(p1)),
                                pk4_fp8(8.f * bflo(p2), 8.f * bfhi(p2), 8.f * bflo(p3), 8.f * bfhi(p3)), h);
                }
    }
}

DI void phase_out(const Ctx& c) {
    const int tid = opaque_tid(), lane = tid & 63, w = tid >> 6, r = lane & 31, h = lane >> 5, wr = w >> 1, wc = w & 1;
    const int srow = tid >> 3, scol = (tid & 7) * 8;
    bf16_t* yb = c.YB();
    int mt, nt; bool have = xcd_item(0, 256, 8, mt, nt);
    for (int k = 0; have; ++k) {
        int mt2 = 0, nt2 = 0; const bool have2 = xcd_item(k + 1, 256, 8, mt2, nt2);
        f32x16 acc[2][2]; zero_acc(acc);
        { int rowE, cbE, cbO; dma_lane(tid, rowE, cbE, cbO);
          const char* a8 = (const char*)c.MG() + (size_t)(128 * mt + rowE) * 1024;
          const char* b8 = (const char*)(c.W() + W_OUT) + (size_t)(128 * nt + rowE) * 1024;
          const NextSt nx = next_reg((const char*)c.MG() + (size_t)(128 * mt2) * 1024, 1024, (const char*)(c.W() + W_OUT) + (size_t)(128 * nt2) * 1024, 1024, have2, tid);
          gemm_dma<2, true, NextSt, 121, 124>(acc, a8 + cbE, a8 + 8 * 1024 + cbO, nullptr, nullptr, 16 * 1024, 128, b8 + cbE, b8 + 8 * 1024 + cbO, 16 * 1024, 8, c.lds, k ? 8 : 0, nx); }
#pragma unroll
        for (int mi = 0; mi < 2; ++mi)
#pragma unroll
            for (int ni = 0; ni < 2; ++ni)
#pragma unroll
                for (int g = 0; g < 4; g += 2) {
                    const size_t off = (size_t)(128 * mt + 64 * wr + 32 * mi + r) * 1024 + 128 * nt + 64 * wc + 32 * ni + 8 * g;
                    u32x2 oa, ob; oa[0] = cvtpk(acc[mi][ni][4 * g], acc[mi][ni][4 * g + 1]); oa[1] = cvtpk(acc[mi][ni][4 * g + 2], acc[mi][ni][4 * g + 3]);
                    ob[0] = cvtpk(acc[mi][ni][4 * g + 4], acc[mi][ni][4 * g + 5]); ob[1] = cvtpk(acc[mi][ni][4 * g + 6], acc[mi][ni][4 * g + 7]);
                    store_pair16(yb + off, oa, ob, h);
                }
        mt = mt2; nt = nt2; have = have2;
    }
}

template <bool ROUTE> DI void phase_ln(const Ctx& c) {
    const int tid = opaque_tid(), lane = tid & 63, w = tid >> 6; const int l = c.layer;
    float* out = c.outp(); const bf16_t* yb = c.YB();
    const float* hs = (ROUTE && l == 0) ? c.in(0) : out;
    const float* gam = c.in(ROUTE ? 17 : 25) + l * 1024; const float* bet = c.in(ROUTE ? 18 : 26) + l * 1024;
#define LNCOL(j) (4 * lane + 256 * (j))
    f32x4 gv[4], bv[4];
#pragma unroll
    for (int j = 0; j < 4; ++j) { gv[j] = *(const f32x4*)(gam + LNCOL(j)); bv[j] = *(const f32x4*)(bet + LNCOL(j)); }
    constexpr int RB = 4;
    const int gw = blockIdx.x * 4 + w, nw = gridDim.x * 4;
    for (int row0 = gw * RB; row0 < T; row0 += nw * RB) {
        f32x4 x[RB][4];
#pragma unroll
        for (int q = 0; q < RB; ++q)
#pragma unroll
            for (int j = 0; j < 4; ++j) { const size_t o_ = (size_t)(row0 + q) * 1024 + LNCOL(j);
                const u32x2 raw = *(const u32x2*)(yb + o_); const f32x4 h0 = *(const f32x4*)(hs + o_);
                x[q][j][0] = ALPHA * h0[0] + bf_lo(raw[0]); x[q][j][1] = ALPHA * h0[1] + bf_hi(raw[0]); x[q][j][2] = ALPHA * h0[2] + bf_lo(raw[1]); x[q][j][3] = ALPHA * h0[3] + bf_hi(raw[1]); }
        float mean[RB], rs[RB];
#pragma unroll
        for (int q = 0; q < RB; ++q) { float s = 0.f;
#pragma unroll
            for (int j = 0; j < 4; ++j) s += (x[q][j][0] + x[q][j][1]) + (x[q][j][2] + x[q][j][3]);
            mean[q] = s; }
#pragma unroll
        for (int o = 32; o >= 1; o >>= 1)
#pragma unroll
            for (int q = 0; q < RB; ++q) mean[q] += __shfl_xor(mean[q], o);
#pragma unroll
        for (int q = 0; q < RB; ++q) { mean[q] *= (1.f / 1024.f); float v = 0.f;
#pragma unroll
            for (int j = 0; j < 4; ++j)
#pragma unroll
                for (int e = 0; e < 4; ++e) { const float d = x[q][j][e] - mean[q]; v += d * d; }
            rs[q] = v; }
#pragma unroll
        for (int o = 32; o >= 1; o >>= 1)
#pragma unroll
            for (int q = 0; q < RB; ++q) rs[q] += __shfl_xor(rs[q], o);
#pragma unroll
        for (int q = 0; q < RB; ++q) {
            const float r = __builtin_amdgcn_rsqf(rs[q] * (1.f / 1024.f) + 1e-5f); const size_t ro = (size_t)(row0 + q) * 1024;
#pragma unroll
            for (int j = 0; j < 4; ++j) {
#pragma unroll
                for (int e = 0; e < 4; ++e) x[q][j][e] = (x[q][j][e] - mean[q]) * r * gv[j][e] + bv[j][e];
                *(f32x4*)(out + ro + LNCOL(j)) = x[q][j];
            }
            { u32x4 o8;
#pragma unroll
              for (int j = 0; j < 4; ++j) o8[j] = pk4_fp8(x[q][j][0], x[q][j][1], x[q][j][2], x[q][j][3]);
              *(u32x4*)(c.HB8() + ro + 16 * lane) = o8; }
        }
        if (ROUTE) {
            const float* wrg = c.in(19) + (size_t)l * 1024 * 4;
            float gl[RB][4];
#pragma unroll
            for (int q = 0; q < RB; ++q)
#pragma unroll
                for (int g = 0; g < 4; ++g) gl[q][g] = 0.f;
#pragma unroll
            for (int j = 0; j < 4; ++j)
#pragma unroll
                for (int e = 0; e < 4; ++e) { const f32x4 wv = *(const f32x4*)(wrg + (size_t)(LNCOL(j) + e) * 4);
#pragma unroll
                    for (int q = 0; q < RB; ++q)
#pragma unroll
                        for (int g = 0; g < 4; ++g) gl[q][g] += x[q][j][e] * wv[g]; }
#pragma unroll
            for (int o = 32; o >= 1; o >>= 1)
#pragma unroll
                for (int q = 0; q < RB; ++q)
#pragma unroll
                    for (int g = 0; g < 4; ++g) gl[q][g] += __shfl_xor(gl[q][g], o);
            int gsel[RB]; float pg_sel[RB];
            const f32x4 brg = *(const f32x4*)(c.in(20) + l * 4);
#pragma unroll
            for (int q = 0; q < RB; ++q) {
#pragma unroll
                for (int g = 0; g < 4; ++g) gl[q][g] += brg[g];
                int gs = 0; float gmax = gl[q][0];
#pragma unroll
                for (int g = 1; g < 4; ++g) if (gl[q][g] > gmax) { gmax = gl[q][g]; gs = g; }
                float gsum = 0.f;
#pragma unroll
                for (int g = 0; g < 4; ++g) gsum += ex2((gl[q][g] - gmax) * LOG2E);
                gsel[q] = gs; pg_sel[q] = rcpf_(gsum);
            }
            float el[RB][4];
#pragma unroll
            for (int q = 0; q < RB; ++q) {
                const float* wre = c.in(21) + ((size_t)l * 4 + gsel[q]) * 1024 * 4;
#pragma unroll
                for (int g = 0; g < 4; ++g) el[q][g] = 0.f;
#pragma unroll
                for (int j = 0; j < 4; ++j)
#pragma unroll
                    for (int e = 0; e < 4; ++e) { const f32x4 wv = *(const f32x4*)(wre + (size_t)(LNCOL(j) + e) * 4);
#pragma unroll
                        for (int g = 0; g < 4; ++g) el[q][g] += x[q][j][e] * wv[g]; }
            }
#pragma unroll
            for (int o = 32; o >= 1; o >>= 1)
#pragma unroll
                for (int q = 0; q < RB; ++q)
#pragma unroll
                    for (int g = 0; g < 4; ++g) el[q][g] += __shfl_xor(el[q][g], o);
            int mybucket = 0; float mywlo = 0.f, mywhi = 0.f;
#pragma unroll
            for (int q = 0; q < RB; ++q) {
                const f32x4 bre = *(const f32x4*)(c.in(22) + (l * 4 + gsel[q]) * 4);
#pragma unroll
                for (int g = 0; g < 4; ++g) el[q][g] += bre[g];
                int e1 = 0; float m1 = el[q][0];
#pragma unroll
                for (int g = 1; g < 4; ++g) if (el[q][g] > m1) { m1 = el[q][g]; e1 = g; }
                int e2 = -1; float m2 = -3e38f;
#pragma unroll
                for (int g = 0; g < 4; ++g) if (g != e1 && el[q][g] > m2) { m2 = el[q][g]; e2 = g; }
                const float p2 = ex2((m2 - m1) * LOG2E);
                const float w1 = pg_sel[q] * rcpf_(1.f + p2), w2 = w1 * p2;
                const int lo = e1 < e2 ? e1 : e2, hi = e1 < e2 ? e2 : e1;
                const float wlo = e1 < e2 ? w1 : w2, whi = e1 < e2 ? w2 : w1;
                const int pidx = lo == 0 ? hi - 1 : (lo == 1 ? hi + 1 : 5);
                if (lane == q) { mybucket = gsel[q] * 6 + pidx; mywlo = wlo; mywhi = whi; }
            }
            if (lane < RB) {
                const unsigned pos = __hip_atomic_fetch_add(c.CTL() + CW_CNT + (32 * l + mybucket) * 64, 1u, __ATOMIC_RELAXED, __HIP_MEMORY_SCOPE_AGENT);
                c.LTOK()[(size_t)mybucket * T + pos] = row0 + lane;
                c.LW()[((size_t)mybucket * T + pos) * 2] = mywlo; c.LW()[((size_t)mybucket * T + pos) * 2 + 1] = mywhi;
            }
        }
    }
}

DI int moe_table(const Ctx& c, int* tab) {
    __syncthreads();
    if (threadIdx.x == 0) { int acc = 0;
        for (int bkt = 0; bkt < 24; ++bkt) { const int n = (int)c.CTL()[CW_CNT + (32 * c.layer + bkt) * 64]; tab[32 + bkt] = n; tab[bkt] = acc; acc += (n + 127) >> 7; }
        tab[24] = acc; }
    __syncthreads();
    return tab[24];
}
DI void moe_decode(const int* tab, int rt, int& bkt, int& r0, int& nvalid, int& elo, int& ehi) {
    int bk = 0;
    for (int i = 0; i < 24; ++i) if (tab[i] <= rt && rt < tab[i + 1]) bk = i;
    bkt = bk; r0 = 128 * (rt - tab[bk]); const int n = tab[32 + bk] - r0; nvalid = n < 128 ? n : 128;
    const int g = bk / 6, pidx = bk % 6;
    const int lo = pidx < 3 ? 0 : (pidx < 5 ? 1 : 2), hi = pidx < 3 ? pidx + 1 : (pidx < 5 ? pidx - 1 : 3);
    elo = g * 4 + lo; ehi = g * 4 + hi;
}
DI void phase_moe_up(const Ctx& c) {
    const int tid = opaque_tid(), lane = tid & 63, w = tid >> 6, r = lane & 31, h = lane >> 5, wr = w >> 1, wc = w & 1;
    const int srow = tid >> 3, scol = (tid & 7) * 8;
    int* tab = (int*)(c.lds + LDS_MISC + 1024);
    const int RT = moe_table(c, tab);
    for (int k = 0;; ++k) {
        int rt, ct; if (!xcd_item(k, RT, 8, rt, ct)) break;
        if (rt >= RT) continue;
        const int es = ct >> 2, q4 = ct & 3;
        int bkt, r0, nvalid, elo, ehi; moe_decode(tab, rt, bkt, r0, nvalid, elo, ehi);
        const int* ltok = c.LTOK() + (size_t)bkt * T + r0;
        int rowE, cbE, cbO; dma_lane(tid, rowE, cbE, cbO);
        const char* ap[4];
#pragma unroll
        for (int i = 0; i < 4; ++i) { int lr = rowE + 8 * i; lr = lr < nvalid ? lr : nvalid - 1; ap[i] = (const char*)(c.HB8() + (size_t)ltok[lr] * 1024) + ((i & 1) ? cbO : cbE); }
        const int e = es ? ehi : elo;
        f32x16 acc[2][2]; zero_acc(acc);
        const char* bp = (const char*)(c.W() + W_UP) + (size_t)e * 512 * 1024 + (size_t)(128 * q4 + rowE) * 1024;
        gemm_dma<2, false, NoNext, 122, 127>(acc, ap[0], ap[1], ap[2], ap[3], 0, 128, bp + cbE, bp + 8 * 1024 + cbO, 16 * 1024, 8, c.lds);
        const float* lw = c.LW() + ((size_t)bkt * T + r0) * 2 + es;
#pragma unroll
        for (int mi = 0; mi < 2; ++mi) {
            int lr = 64 * wr + 32 * mi + r; const int lrc = lr < nvalid ? lr : nvalid - 1;
            const float wt = lw[(size_t)lrc * 2];
            unsigned char* dst = (unsigned char*)c.ACT() + (size_t)(128 * rt + lr) * 512 + es * 256 + 32 * (2 * q4 + wc);
#pragma unroll
            for (int g = 0; g < 4; g += 2) { unsigned pk[2];
#pragma unroll
                for (int gg = 0; gg < 2; ++gg) { float o4[4];
#pragma unroll
                    for (int e4 = 0; e4 < 4; ++e4) { const float a = acc[mi][0][4 * (g + gg) + e4], u = acc[mi][1][4 * (g + gg) + e4]; o4[e4] = a * rcpf_(1.f + ex2(a * -LOG2E)) * u * wt; }
                    pk[gg] = pk4_fp8(16.f * o4[0], 16.f * o4[1], 16.f * o4[2], 16.f * o4[3]); }
                store_pair8(dst + 8 * g, pk[0], pk[1], h); }
        }
    }
}
DI void phase_moe_down(const Ctx& c) {
    const int tid = opaque_tid(), lane = tid & 63, w = tid >> 6, r = lane & 31, h = lane >> 5, wr = w >> 1, wc = w & 1;
    const int srow = tid >> 3, scol = (tid & 7) * 8;
    int* tab = (int*)(c.lds + LDS_MISC + 1024);
    const int RT = moe_table(c, tab);
    bf16_t* yb = c.YB();
    for (int k = 0;; ++k) {
        int rt, nt; if (!xcd_item(k, RT, 8, rt, nt)) break;
        if (rt >= RT) continue;
        int bkt, r0, nvalid, elo, ehi; moe_decode(tab, rt, bkt, r0, nvalid, elo, ehi);
        const int* ltok = c.LTOK() + (size_t)bkt * T + r0;
        f32x16 acc[2][2]; zero_acc(acc);
        for (int es = 0; es < 2; ++es) {
          int rowE, cbE, cbO; dma_lane(opaque_tid(), rowE, cbE, cbO);
          const char* a8 = (const char*)c.ACT() + (size_t)(128 * rt + rowE) * 512 + 256 * es;
          const char* b8 = (const char*)(c.W() + W_DN) + (size_t)(es ? ehi : elo) * 1024 * 256 + (size_t)(128 * nt + rowE) * 256;
          gemm_dma<2, true, NoNext, 122, 123>(acc, a8 + cbE, a8 + 8 * 512 + cbO, nullptr, nullptr, 16 * 512, 128, b8 + cbE, b8 + 8 * 256 + cbO, 16 * 256, 2, c.lds); }
#pragma unroll
        for (int mi = 0; mi < 2; ++mi) {
            const int lr = 64 * wr + 32 * mi + r;
            if (lr < nvalid) {
                const size_t tok = (size_t)ltok[lr];
#pragma unroll
                for (int ni = 0; ni < 2; ++ni)
#pragma unroll
                    for (int g = 0; g < 4; g += 2) {
                        const size_t off = tok * 1024 + 128 * nt + 64 * wc + 32 * ni + 8 * g;
                        u32x2 oa, ob; oa[0] = cvtpk(acc[mi][ni][4 * g], acc[mi][ni][4 * g + 1]); oa[1] = cvtpk(acc[mi][ni][4 * g + 2], acc[mi][ni][4 * g + 3]);
                        ob[0] = cvtpk(acc[mi][ni][4 * g + 4], acc[mi][ni][4 * g + 5]); ob[1] = cvtpk(acc[mi][ni][4 * g + 6], acc[mi][ni][4 * g + 7]);
                        store_pair16(yb + off, oa, ob, h);
                    }
            }
        }
    }
}


#define XB_TMO      128
#define XB_XCNT(j)  (256  + 64 * (j))
#define XB_XSUB(j)  (1280 + 64 * (j))
#define XB_XGEN(j)  (2304 + 64 * (j))
#define XB_TOP      3328
#define XB_TOPGEN   3392
#define XCD_BAR_WORDS 3456
#define XB_SPIN_CAP (1u << 18)

__device__ __forceinline__ unsigned xb_ld(unsigned* p)              { return __hip_atomic_load(p, __ATOMIC_RELAXED, __HIP_MEMORY_SCOPE_AGENT); }
__device__ __forceinline__ unsigned xb_add(unsigned* p, unsigned v) { return __hip_atomic_fetch_add(p, v, __ATOMIC_RELAXED, __HIP_MEMORY_SCOPE_AGENT); }
__device__ __forceinline__ unsigned xb_xcc_id() { return (unsigned)__builtin_amdgcn_s_getreg((3 << 11) | 20) & 0xFu; }
#define XB_SPIN(cond, bar) do { unsigned _sp = 0; while (cond) { __builtin_amdgcn_s_sleep(1); \
    if ((++_sp & 255u) == 0u) { if (xb_ld(&(bar)[XB_TMO])) break; if (_sp > XB_SPIN_CAP) { atomicAdd(&(bar)[XB_TMO], 1u); break; } } } } while (0)

struct XcdBarrier {
    unsigned* bar; unsigned x;
    volatile LAS unsigned* st;
};

__device__ __forceinline__ XcdBarrier xcd_barrier_post(unsigned* bar, volatile LAS unsigned* st) {
    XcdBarrier b; b.bar = bar; b.x = xb_xcc_id(); b.st = st;
    if (threadIdx.x == 0) (void)xb_add(&bar[XB_XCNT(b.x)], 1u);
    return b;
}
__device__ __forceinline__ void xcd_barrier_complete(unsigned* bar, unsigned x, unsigned& nloc, unsigned& nx) {
    const unsigned G = gridDim.x * gridDim.y * gridDim.z;
    unsigned sum, cnt, mine, sp = 0u;
    for (;;) {
        sum = 0u; cnt = 0u; mine = 0u;
#pragma unroll
        for (unsigned j = 0; j < 16; ++j) { const unsigned c = xb_ld(&bar[XB_XCNT(j)]); sum += c; cnt += (c > 0u) ? 1u : 0u; mine = (j == x) ? c : mine; }
        if (sum == G) break;
        __builtin_amdgcn_s_sleep(1);
        if ((++sp & 255u) == 0u) { if (xb_ld(&bar[XB_TMO])) break; if (sp > XB_SPIN_CAP) { atomicAdd(&bar[XB_TMO], 1u); break; } }
    }
    nloc = mine > 0u ? mine : 1u; nx = cnt > 0u ? cnt : 1u;
}

__device__ __forceinline__ void xcd_barrier(const XcdBarrier& b) {
    asm volatile("s_waitcnt vmcnt(0)" ::: "memory");
    __syncthreads();
    if (threadIdx.x == 0) {
        unsigned* bar = b.bar; asm volatile("" : "+s"(bar)); unsigned bx = b.x; asm volatile("" : "+s"(bx));
        __builtin_amdgcn_s_waitcnt(0);
        unsigned nloc = b.st[0], nx = b.st[1];
        if (nloc == 0u) { xcd_barrier_complete(bar, bx, nloc, nx); b.st[0] = nloc; b.st[1] = nx; }
        const unsigned old = xb_add(&bar[XB_XSUB(bx)], 1u);
        const unsigned gen = old / nloc;
        if (old + 1u == (gen + 1u) * nloc) {
            __builtin_amdgcn_fence(__ATOMIC_RELEASE, "agent");
            asm volatile("s_waitcnt vmcnt(0)" ::: "memory");
            const unsigned og = xb_add(&bar[XB_TOP], 1u);
            const unsigned tg = og / nx;
            if (og + 1u == (tg + 1u) * nx) xb_add(&bar[XB_TOPGEN], 1u);
            else XB_SPIN(xb_ld(&bar[XB_TOPGEN]) == tg, bar);
            __builtin_amdgcn_fence(__ATOMIC_ACQUIRE, "agent");
            xb_add(&bar[XB_XGEN(bx)], 1u);
            asm volatile("s_waitcnt vmcnt(0)" ::: "memory");
        } else {
            XB_SPIN(xb_ld(&bar[XB_XGEN(bx)]) == gen, bar);
            __builtin_amdgcn_fence(__ATOMIC_ACQUIRE, "agent");
            asm volatile("s_waitcnt vmcnt(0)" ::: "memory");
        }
    }
    __syncthreads();
}

enum { PH_PRO = 0, PH_W, PH_PROJ, PH_PREP1, PH_PREP2, PH_ATTN, PH_GATE, PH_OUT, PH_LN1, PH_MUP, PH_MDN, PH_LN2, PH_SEL, PH_ATTNB };
template <int PH> DI void run_phase(const Ctx& c0) {
    Ctx c = c0; { const __attribute__((address_space(4))) char* k = (const __attribute__((address_space(4))) char*)__builtin_amdgcn_kernarg_segment_ptr(); asm volatile("" : "+s"(k)); c.ka = k;
                  __attribute__((address_space(1))) unsigned char* w = *(__attribute__((address_space(1))) unsigned char* const __attribute__((address_space(4)))*)(k + 224); asm volatile("" : "+s"(w)); c.wsp = (unsigned char*)w; }
    if (PH == PH_PRO) phase_prologue(c);
    else if (PH == PH_W) phase_weights(c);
    else if (PH == PH_PROJ) phase_proj(c);
    else if (PH == PH_PREP1) phase_prep1(c);
    else if (PH == PH_PREP2) phase_prep2(c);
    else if (PH == PH_ATTN) phase_attn(c);
    else if (PH == PH_GATE) phase_gate(c);
    else if (PH == PH_OUT) phase_out(c);
    else if (PH == PH_LN1) phase_ln<true>(c);
    else if (PH == PH_MUP) phase_moe_up(c);
    else if (PH == PH_MDN) phase_moe_down(c);
    else if (PH == PH_LN2) phase_ln<false>(c);
    else if (PH == PH_ATTNB) phase_attn_b(c);
}
extern __shared__ __attribute__((aligned(16))) char dyn_lds[];
template <int PH> __global__ void __launch_bounds__(NTHR, 2) k_phase(Params p, int layer) {
    Ctx c; c.p = &p; c.layer = layer & 255; c.qslot = layer >> 8; c.lds = dyn_lds; c.wsp = p.ws; c.ka = (const __attribute__((address_space(4))) char*)__builtin_amdgcn_kernarg_segment_ptr();
    run_phase<PH>(c);
}

__global__ void __launch_bounds__(NTHR, 2) k_mega(Params p) {
    Ctx c; c.p = &p; c.layer = 0; c.qslot = 0; c.lds = dyn_lds; c.wsp = p.ws; c.ka = (const __attribute__((address_space(4))) char*)__builtin_amdgcn_kernarg_segment_ptr();
    volatile LAS unsigned* st = (volatile LAS unsigned*)(LAS char*)(dyn_lds + LDS_BYTES - 16);
    if (threadIdx.x == 0) { st[0] = 0u; st[1] = 0u; st[2] = 0u; st[3] = 0u; }
    __syncthreads();
    const XcdBarrier bar = xcd_barrier_post(c.CTL() + CW_BAR, st);
    run_phase<PH_PRO>(c);
    run_phase<PH_W>(c);
    xcd_barrier(bar);
    for (int l = 0; l < NL; ++l) {
        c.layer = l;
        run_phase<PH_PROJ>(c); xcd_barrier(bar);
        run_phase<PH_PREP1>(c); xcd_barrier(bar);
        run_phase<PH_ATTN>(c); xcd_barrier(bar);
        run_phase<PH_ATTNB>(c); xcd_barrier(bar);
        run_phase<PH_GATE>(c); xcd_barrier(bar);
        run_phase<PH_OUT>(c); xcd_barrier(bar);
        run_phase<PH_LN1>(c); xcd_barrier(bar);
        run_phase<PH_MUP>(c); xcd_barrier(bar);
        run_phase<PH_MDN>(c); xcd_barrier(bar);
        run_phase<PH_LN2>(c);
        if (l + 1 < NL) { c.layer = l + 1; run_phase<PH_W>(c); }
        xcd_barrier(bar);
    }
}

extern "C" void kernel_launch(void* const* d_in, const int* in_sizes, int n_in, void* d_out, int out_size, void* d_ws, size_t ws_size, hipStream_t stream) {
    Params p{};
    for (int i = 0; i < 27; ++i) p.in[i] = (const float*)d_in[i];
    p.out = (float*)d_out; p.ws = (unsigned char*)d_ws;
    (void)hipMemsetAsync(d_ws, 0, 786432, stream);
#if N_LAUNCH_MODE == 1
    static int grid = 0;
    if (!grid) {
        int dev = 0, cus = 0, per_cu = 0;
        (void)hipGetDevice(&dev);
        (void)hipDeviceGetAttribute(&cus, hipDeviceAttributeMultiprocessorCount, dev);
        (void)hipFuncSetAttribute((const void*)k_mega, hipFuncAttributeMaxDynamicSharedMemorySize, LDS_BYTES);
        (void)hipOccupancyMaxActiveBlocksPerMultiprocessor(&per_cu, k_mega, NTHR, LDS_BYTES);
        if (per_cu > 2) per_cu = 2;
        if (per_cu < 1) per_cu = 1;
        grid = cus * per_cu;
        if (grid > 512) grid = 512;
    }
    hipLaunchKernelGGL(k_mega, dim3(grid), dim3(NTHR), LDS_BYTES, stream, p);
#else
    const int grid = 512;
#define LAUNCH(PH, L) hipLaunchKernelGGL((k_phase<PH>), dim3(grid), dim3(NTHR), LDS_BYTES, stream, p, (L))
    LAUNCH(PH_PRO, 0);
    for (int l = 0; l < NL; ++l) {
#ifndef PROBE_DUP
#define PROBE_DUP -1
#endif
#define LAUNCH2(PH, L) do { LAUNCH(PH, L); if (PROBE_DUP == PH) LAUNCH(PH, (L) | 256); } while (0)
        LAUNCH2(PH_W, l); LAUNCH2(PH_PROJ, l); LAUNCH2(PH_PREP1, l); LAUNCH2(PH_ATTN, l); LAUNCH(PH_ATTNB, l); LAUNCH2(PH_GATE, l);
        LAUNCH(PH_OUT, l); LAUNCH(PH_LN1, l); LAUNCH2(PH_MUP, l); LAUNCH(PH_MDN, l); LAUNCH(PH_LN2, l);
    }
#endif
}
```

```cpp
#include <hip/hip_runtime.h>
#include <stdint.h>

#ifndef N_LAUNCH_MODE
#define N_LAUNCH_MODE 1
#endif

typedef unsigned short bf16_t;
typedef short bf16x8 __attribute__((ext_vector_type(8)));
typedef short s16x4 __attribute__((ext_vector_type(4)));
typedef short v4i16_t __attribute__((ext_vector_type(4)));
typedef float f32x16 __attribute__((ext_vector_type(16)));
typedef float f32x4 __attribute__((ext_vector_type(4)));
typedef float f32x2 __attribute__((ext_vector_type(2)));
typedef unsigned u32x4 __attribute__((ext_vector_type(4)));
typedef unsigned u32x2 __attribute__((ext_vector_type(2)));
typedef __bf16 bf16x2_t __attribute__((ext_vector_type(2)));
#define LAS __attribute__((address_space(3)))
#define DI __device__ __forceinline__

constexpr int NB = 4, S = 8192, DM = 1024, NL = 4, T = NB * S;
constexpr int PW = 2944;
constexpr int C_SBQ = 0, C_SBK = 256, C_SBV = 512, C_MBQ = 768, C_MBK = 1024, C_MBV = 1280, C_CQ = 1536, C_CKV = 1792, C_KR = 1920,
              C_NQ = 1952, C_NKV = 2208, C_QM = 2592, C_GN = 2848;
constexpr int OBW = 1280;
constexpr int QMW = 384, MKW = 640;
constexpr float LOG2E = 1.4426950408889634f, LN2 = 0.6931471805599453f;
constexpr float ALPHA = 1.681792830507429f;
constexpr int NTHR = 256;
constexpr int LDS_BYTES = 69632;
constexpr int LDS_MISC = 65536;

constexpr size_t W_IN = 0, W_UQ = W_IN + (size_t)PW * 1024, W_UKV = W_UQ + 384 * 256, W_PHI1 = W_UKV + 512 * 128, W_PHI2 = W_PHI1 + 2 * 128 * 2048,
                 W_MEM = W_PHI2 + 2 * 128 * 128, W_BR = W_MEM + 512 * 1024, W_G = W_BR + 5 * 1024 * 256, W_OUT = W_G + 5 * 1024 * 1024,
                 W_UP = W_OUT + 1024 * 1024, W_DN = W_UP + 16 * 512 * 1024, W_END = W_DN + 16 * 1024 * 256;

constexpr size_t MiB = 1u << 20;
constexpr size_t WS_CTL = 0;
constexpr size_t WS_HB = 1 * MiB;
constexpr size_t WS_P = WS_HB + 64 * MiB;
constexpr size_t WS_MG = WS_P;
constexpr size_t WS_ACT = WS_P + 64 * MiB;
constexpr size_t WS_OB = WS_P + 184 * MiB;
constexpr size_t WS_QM = WS_OB + 80 * MiB;
constexpr size_t WS_MK = WS_QM + 24 * MiB;
constexpr size_t WS_W = WS_MK + 40 * MiB;
constexpr size_t WS_MEMB = WS_W + 47 * MiB;
constexpr size_t WS_MEMKV = WS_MEMB + 2 * MiB;
constexpr size_t WS_HC = WS_MEMKV + 1 * MiB;
constexpr size_t WS_KC = WS_HC + 1 * MiB;
constexpr size_t WS_KMEAN = WS_KC + 1 * MiB;
constexpr size_t WS_CPART = WS_KMEAN + 1 * MiB;
constexpr size_t WS_LTOK = WS_CPART + 1 * MiB;
constexpr size_t WS_LW = WS_LTOK + 3 * MiB;
constexpr size_t WS_STASH = WS_LW + 6 * MiB;
constexpr size_t WS_HB8 = WS_STASH + 16 * MiB;
constexpr size_t WS_END = WS_HB8 + 32 * MiB;
static_assert(WS_END <= 508 * MiB, "workspace map");
static_assert(W_END * 2 <= 47 * MiB, "weights");
constexpr int CW_Q = 64;
constexpr int CW_CNT = 20480;
constexpr int CW_BAR = 1024;
constexpr int CW_MB = 32768;

struct Params { const float* in[27]; float* out; unsigned char* ws; };

DI unsigned cvtpk(float lo, float hi) { f32x2 v = {lo, hi}; bf16x2_t b = __builtin_convertvector(v, bf16x2_t); return __builtin_bit_cast(unsigned, b); }
DI float bf2f(unsigned short x) { return __builtin_bit_cast(float, (unsigned)x << 16); }
DI float bflo(unsigned u) { return __builtin_bit_cast(float, u << 16); }
DI float bfhi(unsigned u) { return __builtin_bit_cast(float, u & 0xffff0000u); }
DI unsigned pk4_fp8(float a, float b, float c, float d) { int v = 0;
    a = __builtin_amdgcn_fmed3f(a, -448.f, 448.f); b = __builtin_amdgcn_fmed3f(b, -448.f, 448.f); c = __builtin_amdgcn_fmed3f(c, -448.f, 448.f); d = __builtin_amdgcn_fmed3f(d, -448.f, 448.f); v = __builtin_amdgcn_cvt_pk_fp8_f32(a, b, v, false); v = __builtin_amdgcn_cvt_pk_fp8_f32(c, d, v, true); return (unsigned)v; }
DI f32x16 mfma(bf16x8 a, bf16x8 b, f32x16 c) { return __builtin_amdgcn_mfma_f32_32x32x16_bf16(a, b, c, 0, 0, 0); }
DI float ex2(float x) { return __builtin_amdgcn_exp2f(x); }
DI float rcpf_(float x) { return __builtin_amdgcn_rcpf(x); }
DI float lg2(float x) { return __builtin_amdgcn_logf(x); }
DI float wave_sum(float v) {
#pragma unroll
    for (int o = 32; o >= 1; o >>= 1) v += __shfl_xor(v, o);
    return v;
}
DI s16x4 vtr(const bf16_t* p) { return __builtin_bit_cast(s16x4, __builtin_amdgcn_ds_read_tr16_b64_v4i16((LAS v4i16_t*)(LAS char*)(p))); }
DI int opaque_tid() { int t = threadIdx.x; asm volatile("" : "+v"(t)); return t; }
DI f32x16 zero16() { f32x16 z;
#pragma unroll
    for (int i = 0; i < 16; ++i) z[i] = 0.f; return z; }

constexpr int NST = 2, STAGE_B = 32768;
DI void glds16(const void* gsrc, unsigned lds_dst) { unsigned keep;
    asm volatile("s_mov_b32 %0, m0\n\ts_mov_b32 m0, %2\n\ts_nop 0\n\tglobal_load_lds_dwordx4 %1, off\n\ts_mov_b32 m0, %0" : "=&s"(keep) : "v"(gsrc), "s"(lds_dst) : "memory"); }
#define WAIT_V(n) asm volatile("s_waitcnt vmcnt(" #n ")" ::: "memory")
DI void dma_lane(int tid, int& rowE, int& cbE, int& cbO) { const int lane = tid & 63, w = tid >> 6; rowE = 32 * w + (lane >> 3);
    cbE = 16 * ((lane & 7) ^ (lane >> 4)); cbO = 16 * ((lane & 7) ^ (4 + (lane >> 4))); }
struct NoNext { static constexpr bool ON = false; DI void operator()(unsigned, unsigned) const {} };
struct NextSt { static constexpr bool ON = true; const char *aE, *aO, *aE2, *aO2, *bE, *bO; size_t b16; bool on;
    DI void operator()(unsigned dstA, unsigned dstB) const;
};
template <int F8, bool AREG, class NX = NoNext, int SCA = 127, int SCB = 127>
DI void gemm_dma(f32x16 (&acc)[2][2], const char* aE, const char* aO, const char* aE2, const char* aO2, size_t a16, size_t astride,
                 const char* bE, const char* bO, size_t b16, int nst, char* lds, int pv = 0, NX nx = NX()) {
    const int tid = opaque_tid(), lane = tid & 63, w = tid >> 6, r = lane & 31, h = lane >> 5, wr = w >> 1, wc = w & 1;
    const unsigned lbase = (unsigned)(size_t)(LAS char*)lds;
    const unsigned dstA = (unsigned)__builtin_amdgcn_readfirstlane((int)(lbase + 4096u * (unsigned)w));
    const unsigned dstB = dstA + 16384u;
    if (AREG) { aE2 = aE + a16; aO2 = aO + a16; }
    const char* bE2 = bE + b16; const char* bO2 = bO + b16;
#define GD_STAGE(t) do { const int t_ = (t); const size_t ao_ = (size_t)t_ * astride, bo_ = (size_t)t_ * 128; \
        const unsigned so_ = (unsigned)(t_ & (NST - 1)) * (unsigned)STAGE_B; \
        if (!(pv & 2)) { glds16(aE + ao_, dstA + so_); glds16(aO + ao_, dstA + so_ + 1024u); glds16(aE2 + ao_, dstA + so_ + 2048u); glds16(aO2 + ao_, dstA + so_ + 3072u); \
                         glds16(bE + bo_, dstB + so_); glds16(bO + bo_, dstB + so_ + 1024u); glds16(bE2 + bo_, dstB + so_ + 2048u); glds16(bO2 + bo_, dstB + so_ + 3072u); } } while (0)
    if (!(pv & 8)) {
    WAIT_V(0);
    __builtin_amdgcn_s_barrier();
    GD_STAGE(0);
    }
    const int sw = (r >> 1) & 7;
    const char* fa = lds + (64 * wr + r) * 128;
    const char* fb = lds + 16384 + (64 * wc + r) * 128;
    for (int t = 0; t < nst; ++t) {
        WAIT_V(0);
        __builtin_amdgcn_s_barrier();
        asm volatile("" ::: "memory");
        if (t + 1 < nst) GD_STAGE(t + 1);
        else if (NX::ON) nx(dstA, dstB);
        const char* sa = fa + (t & (NST - 1)) * STAGE_B; const char* sb = fb + (t & (NST - 1)) * STAGE_B;
        if (F8 == 1) {
#pragma unroll
            for (int ks = 0; ks < 8; ++ks) {
                const int co = ((ks ^ sw) << 4) + 8 * h;
                const long fa0 = *(const long*)(sa + co), fa1 = *(const long*)(sa + 32 * 128 + co);
                const long fb0 = *(const long*)(sb + co), fb1 = *(const long*)(sb + 32 * 128 + co);
                acc[0][0] = __builtin_amdgcn_mfma_f32_32x32x16_fp8_fp8(fb0, fa0, acc[0][0], 0, 0, 0); acc[0][1] = __builtin_amdgcn_mfma_f32_32x32x16_fp8_fp8(fb1, fa0, acc[0][1], 0, 0, 0);
                acc[1][0] = __builtin_amdgcn_mfma_f32_32x32x16_fp8_fp8(fb0, fa1, acc[1][0], 0, 0, 0); acc[1][1] = __builtin_amdgcn_mfma_f32_32x32x16_fp8_fp8(fb1, fa1, acc[1][1], 0, 0, 0);
            }
        } else if (F8 == 2) {
#pragma unroll
            for (int ks = 0; ks < 2; ++ks) {
                const int c0 = ((4 * ks + 2 * h) ^ sw) << 4, c1 = ((4 * ks + 2 * h + 1) ^ sw) << 4;
                typedef int i32x4 __attribute__((ext_vector_type(4))); typedef int i32x8 __attribute__((ext_vector_type(8)));
                const i32x4 a0l = *(const i32x4*)(sa + c0), a0h = *(const i32x4*)(sa + c1), a1l = *(const i32x4*)(sa + 32 * 128 + c0), a1h = *(const i32x4*)(sa + 32 * 128 + c1);
                const i32x4 b0l = *(const i32x4*)(sb + c0), b0h = *(const i32x4*)(sb + c1), b1l = *(const i32x4*)(sb + 32 * 128 + c0), b1h = *(const i32x4*)(sb + 32 * 128 + c1);
                const i32x8 fa0 = __builtin_shufflevector(a0l, a0h, 0, 1, 2, 3, 4, 5, 6, 7), fa1 = __builtin_shufflevector(a1l, a1h, 0, 1, 2, 3, 4, 5, 6, 7);
                const i32x8 fb0 = __builtin_shufflevector(b0l, b0h, 0, 1, 2, 3, 4, 5, 6, 7), fb1 = __builtin_shufflevector(b1l, b1h, 0, 1, 2, 3, 4, 5, 6, 7);
                acc[0][0] = __builtin_amdgcn_mfma_scale_f32_32x32x64_f8f6f4(fb0, fa0, acc[0][0], 0, 0, 0, SCA, 0, SCB); acc[0][1] = __builtin_amdgcn_mfma_scale_f32_32x32x64_f8f6f4(fb1, fa0, acc[0][1], 0, 0, 0, SCA, 0, SCB);
                acc[1][0] = __builtin_amdgcn_mfma_scale_f32_32x32x64_f8f6f4(fb0, fa1, acc[1][0], 0, 0, 0, SCA, 0, SCB); acc[1][1] = __builtin_amdgcn_mfma_scale_f32_32x32x64_f8f6f4(fb1, fa1, acc[1][1], 0, 0, 0, SCA, 0, SCB);
            }
        } else {
#pragma unroll
            for (int ks = 0; ks < 4; ++ks) {
                const int co = ((2 * ks + h) ^ sw) << 4;
                if (pv & 4) continue;
                const bf16x8 fa0 = *(const bf16x8*)(sa + co), fa1 = *(const bf16x8*)(sa + 32 * 128 + co);
                const bf16x8 fb0 = *(const bf16x8*)(sb + co), fb1 = *(const bf16x8*)(sb + 32 * 128 + co);
                if (pv & 1) { asm volatile("" :: "v"(fa0), "v"(fa1), "v"(fb0), "v"(fb1)); continue; }
                acc[0][0] = mfma(fb0, fa0, acc[0][0]); acc[0][1] = mfma(fb1, fa0, acc[0][1]);
                acc[1][0] = mfma(fb0, fa1, acc[1][0]); acc[1][1] = mfma(fb1, fa1, acc[1][1]);
            }
        }
    }
#undef GD_STAGE
}
DI void NextSt::operator()(unsigned dstA, unsigned dstB) const {
    if (on) { glds16(aE, dstA); glds16(aO, dstA + 1024u); glds16(aE2, dstA + 2048u); glds16(aO2, dstA + 3072u);
              glds16(bE, dstB); glds16(bO, dstB + 1024u); glds16(bE + b16, dstB + 2048u); glds16(bO + b16, dstB + 3072u); }
}
DI NextSt next_reg(const void* A0, size_t pa, const void* B0, size_t pb, bool on, int tid) {
    int rowE, cbE, cbO; dma_lane(tid, rowE, cbE, cbO);
    const char* aE = (const char*)A0 + (size_t)rowE * pa; const char* bE = (const char*)B0 + (size_t)rowE * pb;
    NextSt n; n.aE = aE + cbE; n.aO = aE + 8 * pa + cbO; n.aE2 = n.aE + 16 * pa; n.aO2 = n.aO + 16 * pa; n.bE = bE + cbE; n.bO = bE + 8 * pb + cbO; n.b16 = 16 * pb; n.on = on;
    return n;
}
template <class NX = NoNext>
DI void gemm_reg(f32x16 (&acc)[2][2], const bf16_t* A, size_t lda, const bf16_t* B, size_t ldb, int K, char* lds, int pv = 0, NX nx = NX()) {
    int rowE, cbE, cbO; dma_lane(opaque_tid(), rowE, cbE, cbO);
    const char* aE = (const char*)(A + (size_t)rowE * lda); const char* bE = (const char*)(B + (size_t)rowE * ldb);
    gemm_dma<0, true, NX>(acc, aE + cbE, aE + 16 * lda + cbO, nullptr, nullptr, 32 * lda, 128, bE + cbE, bE + 16 * ldb + cbO, 32 * ldb, K / 64, lds, pv, nx);
}
DI float bf_lo(unsigned u) { return __uint_as_float(u << 16); }
DI float bf_hi(unsigned u) { return __uint_as_float(u & 0xffff0000u); }
DI void zero_acc(f32x16 (&acc)[2][2]) { acc[0][0] = zero16(); acc[0][1] = zero16(); acc[1][0] = zero16(); acc[1][1] = zero16(); }

constexpr int VP = 72;
#ifndef NSA_PRE
#define NSA_PRE false
#endif
#ifndef MLA_PRE
#define MLA_PRE false
#endif
#ifndef MOBA_PRE
#define MOBA_PRE false
#endif
DI u32x4 ldg16(const void* p) { return *(const __attribute__((address_space(1))) u32x4*)p; }
template <int DQK> struct KVRegs { u32x4 k[DQK / 32]; u32x4 v[2]; };
template <int DQK> DI void kv_load(KVRegs<DQK>& R, const bf16_t* kbase, size_t kpitch, const bf16_t* vbase, size_t vpitch, int t, int keymax, int tid) {
    int key = 64 * t + (tid >> 2); key = key > keymax ? keymax : key;
    const __amdgpu_buffer_rsrc_t rk = __builtin_amdgcn_make_buffer_rsrc((void*)kbase, 0, 0x7fffffff, 0x00020000);
    const __amdgpu_buffer_rsrc_t rv = __builtin_amdgcn_make_buffer_rsrc((void*)vbase, 0, 0x7fffffff, 0x00020000);
    const int vk = key * (int)(kpitch * 2) + (tid & 3) * (DQK / 2);
#pragma unroll
    for (int i = 0; i < DQK / 32; ++i) R.k[i] = __builtin_bit_cast(u32x4, __builtin_amdgcn_raw_buffer_load_b128(rk, vk + 16 * i, 0, 0));
    const int vv = key * (int)(vpitch * 2) + (tid & 3) * 32;
    R.v[0] = __builtin_bit_cast(u32x4, __builtin_amdgcn_raw_buffer_load_b128(rv, vv, 0, 0)); R.v[1] = __builtin_bit_cast(u32x4, __builtin_amdgcn_raw_buffer_load_b128(rv, vv + 16, 0, 0));
}
template <int DQK> DI void kv_store(const KVRegs<DQK>& R, char* lds, int tid) {
    constexpr int KP = DQK + 8;
    bf16_t* Ks = (bf16_t*)lds; bf16_t* Vs = (bf16_t*)(lds + 64 * KP * 2);
    bf16_t* kp = Ks + (tid >> 2) * KP + (tid & 3) * (DQK / 4);
#pragma unroll
    for (int i = 0; i < DQK / 32; ++i) *(u32x4*)(kp + 8 * i) = R.k[i];
    bf16_t* vp = Vs + (tid >> 2) * VP + (tid & 3) * 16;
    *(u32x4*)vp = R.v[0]; *(u32x4*)(vp + 8) = R.v[1];
}
template <int DQK> DI void qk_tile(f32x16 (&s)[2], const bf16x8 (&qf)[DQK / 16], const char* lds, int tid) {
    constexpr int KP = DQK + 8; const int lane = tid & 63, r = lane & 31, h = lane >> 5;
    const bf16_t* Ks = (const bf16_t*)lds;
#pragma unroll
    for (int kh = 0; kh < 2; ++kh) {
        s[kh] = zero16();
#pragma unroll
        for (int ks = 0; ks < DQK / 16; ++ks) {
            const bf16x8 kf = *(const bf16x8*)(Ks + (32 * kh + r) * KP + 16 * ks + 8 * h);
            s[kh] = mfma(kf, qf[ks], s[kh]);
        }
    }
}
template <int DQK> DI void load_v(bf16x8 (&vf)[2][2][2], const char* lds, int tid) {
    constexpr int KP = DQK + 8; const int lane = tid & 63, h = lane >> 5;
    const bf16_t* Vs = (const bf16_t*)(lds + 64 * KP * 2);
    const int q4 = (lane & 15) >> 2, p4 = lane & 3, blk = (lane >> 4) & 1;
    const bf16_t* vb = Vs + (4 * h + q4) * VP + 16 * blk + 4 * p4;
#pragma unroll
    for (int kh = 0; kh < 2; ++kh)
#pragma unroll
        for (int st = 0; st < 2; ++st)
#pragma unroll
            for (int db = 0; db < 2; ++db) {
                const bf16_t* vp = vb + (32 * kh + 16 * st) * VP + 32 * db;
                const s16x4 lo = vtr(vp), hi = vtr(vp + 8 * VP);
                vf[kh][st][db] = __builtin_shufflevector(lo, hi, 0, 1, 2, 3, 4, 5, 6, 7);
            }
}
DI void pv_mma(f32x16 (&o)[2], const f32x16 (&p)[2], const bf16x8 (&vf)[2][2][2]) {
#pragma unroll
    for (int kh = 0; kh < 2; ++kh)
#pragma unroll
        for (int st = 0; st < 2; ++st) {
            u32x4 pk;
            pk[0] = cvtpk(p[kh][8 * st + 0], p[kh][8 * st + 1]); pk[1] = cvtpk(p[kh][8 * st + 2], p[kh][8 * st + 3]);
            pk[2] = cvtpk(p[kh][8 * st + 4], p[kh][8 * st + 5]); pk[3] = cvtpk(p[kh][8 * st + 6], p[kh][8 * st + 7]);
            const bf16x8 pf = __builtin_bit_cast(bf16x8, pk);
            o[0] = mfma(vf[kh][st][0], pf, o[0]); o[1] = mfma(vf[kh][st][1], pf, o[1]);
        }
}
template <int DQK> DI void pv_tile(f32x16 (&o)[2], const f32x16 (&p)[2], const char* lds, int tid) { bf16x8 vf[2][2][2]; load_v<DQK>(vf, lds, tid); pv_mma(o, p, vf); }
template <int DQK, class Pol, bool FULL, bool PRE> DI void flash_tile(const bf16x8 (&qf)[DQK / 16], const char* lds, int t, const Pol& pol, float& m, float& l, f32x16 (&o)[2], int tid) {
    f32x16 s[2];
    qk_tile<DQK>(s, qf, lds, tid);
    bf16x8 vf[2][2][2]; if (PRE) load_v<DQK>(vf, lds, tid);
    float mx = -1e30f;
    if (Pol::HAS_BIAS) {
#pragma unroll
        for (int kh = 0; kh < 2; ++kh)
#pragma unroll
            for (int i = 0; i < 16; ++i) {
                const int koff = 32 * kh + 8 * (i >> 2) + (i & 3);
                const float v = FULL ? pol.score_full(s[kh][i], koff) : pol.score(s[kh][i], koff);
                s[kh][i] = v; mx = fmaxf(mx, v);
            }
    } else {
#pragma unroll
        for (int kh = 0; kh < 2; ++kh)
#pragma unroll
            for (int i = 0; i < 16; ++i) {
                const int koff = 32 * kh + 8 * (i >> 2) + (i & 3);
                const float v = (FULL || pol.valid(koff)) ? s[kh][i] : -1e30f;
                s[kh][i] = v; mx = fmaxf(mx, v);
            }
        mx *= pol.sc2;
    }
    if (__any(mx > m + 8.f)) {
        mx = fmaxf(mx, __shfl_xor(mx, 32));
        const float mn = fmaxf(m, mx);
        const float alpha = ex2(m - mn);
        m = mn; l *= alpha;
#pragma unroll
        for (int i = 0; i < 16; ++i) { o[0][i] *= alpha; o[1][i] *= alpha; }
    }
    f32x2 rs2 = {0.f, 0.f};
    const float negm = -m, sc = Pol::HAS_BIAS ? 1.f : pol.sc2;
#pragma unroll
    for (int kh = 0; kh < 2; ++kh)
#pragma unroll
        for (int i = 0; i < 16; i += 2) {
            const float p0 = ex2(Pol::HAS_BIAS ? s[kh][i] + negm : fmaf(s[kh][i], sc, negm)), p1 = ex2(Pol::HAS_BIAS ? s[kh][i + 1] + negm : fmaf(s[kh][i + 1], sc, negm));
            s[kh][i] = p0; s[kh][i + 1] = p1; rs2 += (f32x2){p0, p1};
        }
    l += rs2[0] + rs2[1];
    if (!PRE) load_v<DQK>(vf, lds, tid);
    pv_mma(o, s, vf);
}
template <int DQK, bool USE_FULL, bool PRE, class Pol, class Need>
DI void flash_pass(const bf16x8 (&qf)[DQK / 16], const bf16_t* kbase, size_t kpitch, const bf16_t* vbase, size_t vpitch, int keymax,
                   int t_lo, int t_hi, Need need, int wave_tmax, Pol& pol, float& m, float& l, f32x16 (&o)[2], char* lds, int tid) {
    KVRegs<DQK> R;
    int t = t_hi - 1; while (t >= t_lo && !need(t)) --t;
    if (t >= t_lo) kv_load<DQK>(R, kbase, kpitch, vbase, vpitch, t, keymax, tid);
    while (t >= t_lo) {
        int tn = t - 1; while (tn >= t_lo && !need(tn)) --tn;
        __syncthreads();
        kv_store<DQK>(R, lds, tid);
        __syncthreads();
        if (tn >= t_lo) kv_load<DQK>(R, kbase, kpitch, vbase, vpitch, tn, keymax, tid);
        if (t <= wave_tmax) {
            pol.prep(t);
            if (USE_FULL && __all(pol.lane_full())) flash_tile<DQK, Pol, true, PRE>(qf, lds, t, pol, m, l, o, tid);
            else flash_tile<DQK, Pol, false, PRE>(qf, lds, t, pol, m, l, o, tid);
        }
        t = tn;
    }
}
struct NeedAll { DI bool operator()(int) const { return true; } };
struct NeedBits128 { unsigned long long lo, hi; DI bool operator()(int t) const { const unsigned long long w = t < 64 ? lo : hi; return (w >> (t & 63)) & 1ull; } };
struct NeedBlk4 { unsigned u; DI bool operator()(int t) const { return (u >> (t >> 2)) & 1u; } };

struct PolCausal { static constexpr bool HAS_BIAS = false; int qpos; float sc2; int lim, h4; DI void prep(int t) { lim = qpos - 64 * t - h4; }
    DI bool valid(int koff) const { return koff <= lim; }
    DI bool lane_full() const { return lim >= 59; }
    DI float score(float d, int koff) const { return koff <= lim ? d * sc2 : -1e30f; }
    DI float score_full(float d, int) const { return d * sc2; } };
struct PolMem { static constexpr bool HAS_BIAS = false; float sc2; DI bool valid(int) const { return true; } DI void prep(int) {} DI bool lane_full() const { return true; } DI float score(float d, int) const { return d * sc2; } DI float score_full(float d, int) const { return d * sc2; } };
struct PolMoba { static constexpr bool HAS_BIAS = true; DI bool valid(int) const { return true; } int qpos; float sc2, sl2; unsigned mask; int lim, h4; float base;
    DI void prep(int t) { const int kb = 64 * t + h4; lim = ((mask >> (t >> 2)) & 1u) ? qpos - kb : -1; base = sl2 * (float)(kb - qpos); }
    DI bool lane_full() const { return lim >= 59; }
    DI float score(float d, int koff) const { return koff <= lim ? fmaf(d, sc2, fmaf(sl2, (float)koff, base)) : -1e30f; }
    DI float score_full(float d, int koff) const { return fmaf(d, sc2, fmaf(sl2, (float)koff, base)); } };
struct PolRoute { static constexpr bool HAS_BIAS = true; DI bool valid(int) const { return true; } int qpos; float sc2, sl2; int h4; float base;
    DI void prep(int t) { const int kb = 64 * t + h4; base = sl2 * (float)(kb - qpos); }
    DI bool lane_full() const { return true; }
    DI float score(float d, int koff) const { return fmaf(d, sc2, fmaf(sl2, (float)koff, base)); }
    DI float score_full(float d, int koff) const { return fmaf(d, sc2, fmaf(sl2, (float)koff, base)); } };
struct PolCmp { static constexpr bool HAS_BIAS = true; DI bool valid(int) const { return true; } int qpos; float sc2, sl2; int lim, h4; float base;
    DI void prep(int t) { const int kb = 64 * t + h4; const int klim = (qpos - 31) >> 4; const int l1 = klim - kb, l2 = 510 - kb; lim = l1 < l2 ? l1 : l2; base = sl2 * (float)(16 * kb + 31 - qpos); }
    DI bool lane_full() const { return lim >= 59; }
    DI float score(float d, int koff) const { return koff <= lim ? fmaf(d, sc2, fmaf(16.f * sl2, (float)koff, base)) : -1e30f; }
    DI float score_full(float d, int koff) const { return fmaf(d, sc2, fmaf(16.f * sl2, (float)koff, base)); } };
struct PolSel { static constexpr bool HAS_BIAS = true; DI bool valid(int) const { return true; } int qpos; float sc2, sl2; unsigned long long mlo, mhi; int lim, h4; float base;
    DI void prep(int t) { const int kb = 64 * t + h4; const unsigned long long w = t < 64 ? mlo : mhi; const bool on = (w >> (t & 63)) & 1ull; lim = on ? qpos - kb : -1;
        base = on ? sl2 * (float)(kb - qpos) : -1e30f; }
    DI bool lane_full() const { return lim >= 59 || lim < 0; }
    DI float score(float d, int koff) const { return koff <= lim ? fmaf(d, sc2, fmaf(sl2, (float)koff, base)) : -1e30f; }
    DI float score_full(float d, int koff) const { return fmaf(d, sc2, fmaf(sl2, (float)koff, base)); } };
struct PolWin { static constexpr bool HAS_BIAS = true; DI bool valid(int) const { return true; } int qpos; float sc2, sl2; int lim, h4; float base;
    DI void prep(int t) { const int kb = 64 * t + h4; lim = qpos - kb; base = sl2 * (float)(kb - qpos); }
    DI bool lane_full() const { return lim >= 59 && lim < 512; }
    DI float score(float d, int koff) const { return (koff <= lim && koff > lim - 512) ? fmaf(d, sc2, fmaf(sl2, (float)koff, base)) : -1e30f; }
    DI float score_full(float d, int koff) const { return fmaf(d, sc2, fmaf(sl2, (float)koff, base)); } };

DI void store_pair16(bf16_t* rowp, u32x2 a, u32x2 b, int h) {
    const auto r0 = __builtin_amdgcn_permlane32_swap(a[0], b[0], false, false);
    const auto r1 = __builtin_amdgcn_permlane32_swap(a[1], b[1], false, false);
    u32x4 v; v[0] = r0[0]; v[1] = r1[0]; v[2] = r0[1]; v[3] = r1[1];
    *(u32x4*)(rowp + 8 * h) = v;
}
DI void store_pair8(unsigned char* rowp, unsigned a, unsigned b, int h) {
    const auto r0 = __builtin_amdgcn_permlane32_swap(a, b, false, false);
    u32x2 v; v[0] = r0[0]; v[1] = r0[1];
    *(u32x2*)(rowp + 8 * h) = v;
}
DI void write_o_bf16(bf16_t* orow, const f32x16 (&o)[2], int tid) {
    const int h = (tid & 63) >> 5;
#pragma unroll
    for (int db = 0; db < 2; ++db)
#pragma unroll
        for (int g = 0; g < 4; g += 2) {
            u32x2 wa, wb; wa[0] = cvtpk(o[db][4 * g], o[db][4 * g + 1]); wa[1] = cvtpk(o[db][4 * g + 2], o[db][4 * g + 3]);
            wb[0] = cvtpk(o[db][4 * g + 4], o[db][4 * g + 5]); wb[1] = cvtpk(o[db][4 * g + 6], o[db][4 * g + 7]);
            store_pair16(orow + 32 * db + 8 * g, wa, wb, h);
        }
}
DI void write_o(unsigned char* orow, const f32x16 (&o)[2], int tid) {
    const int h = (tid & 63) >> 5;
#pragma unroll
    for (int db = 0; db < 2; ++db)
#pragma unroll
        for (int g = 0; g < 4; ++g)
            *(unsigned*)(orow + 32 * db + 8 * g + 4 * h) = pk4_fp8(16.f * o[db][4 * g], 16.f * o[db][4 * g + 1], 16.f * o[db][4 * g + 2], 16.f * o[db][4 * g + 3]);
}
DI void load_q64(bf16x8 (&qf)[4], const bf16_t* qrow, int tid) { const int h = (tid & 63) >> 5;
#pragma unroll
    for (int ks = 0; ks < 4; ++ks) qf[ks] = *(const bf16x8*)(qrow + 16 * ks + 8 * h); }

struct Ctx {
    const Params* p; int layer; char* lds; unsigned char* wsp; int qslot;
    const __attribute__((address_space(4))) char* ka;
    DI const float* in(int i) const { return (const float*)*(const __attribute__((address_space(1))) float* const __attribute__((address_space(4)))*)(ka + 8 * i); }
    DI float* outp() const { return (float*)*(__attribute__((address_space(1))) float* const __attribute__((address_space(4)))*)(ka + 216); }
    DI unsigned char* ws() const { return wsp; }
    DI bf16_t* HB() const { return (bf16_t*)(wsp + WS_HB); }
    DI unsigned char* HB8() const { return wsp + WS_HB8; }
    DI bf16_t* P() const { return (bf16_t*)(wsp + WS_P); }
    DI bf16_t* MG() const { return (bf16_t*)(wsp + WS_MG); }
    DI bf16_t* ACT() const { return (bf16_t*)(wsp + WS_ACT); }
    DI unsigned char* OB() const { return wsp + WS_OB; }
    DI bf16_t* QM() const { return (bf16_t*)(wsp + WS_QM); }
    DI bf16_t* MK() const { return (bf16_t*)(wsp + WS_MK); }
    DI bf16_t* W() const { return (bf16_t*)(wsp + WS_W); }
    DI bf16_t* MEMB() const { return (bf16_t*)(wsp + WS_MEMB); }
    DI bf16_t* MEMKV() const { return (bf16_t*)(wsp + WS_MEMKV); }
    DI bf16_t* HC() const { return (bf16_t*)(wsp + WS_HC); }
    DI bf16_t* KC() const { return (bf16_t*)(wsp + WS_KC); }
    DI float* KMEAN() const { return (float*)(wsp + WS_KMEAN); }
    DI float* CPART() const { return (float*)(wsp + WS_CPART); }
    DI float* CBIAS() const { return (float*)(wsp + WS_CPART + 32768); }
    DI int* LTOK() const { return (int*)(wsp + WS_LTOK); }
    DI unsigned short* MBLIST() const { return (unsigned short*)(wsp + WS_LTOK); }
    DI unsigned* MBSEL() const { return (unsigned*)(wsp + WS_LTOK + 8 * MiB); }
    DI unsigned char* MBPART() const { return wsp + WS_HB; }
    DI float* LW() const { return (float*)(wsp + WS_LW); }
    DI unsigned* CTL() const { return (unsigned*)(wsp + WS_CTL); }
    DI const float* hsrc() const { return layer == 0 ? in(0) : outp(); }
    DI bf16_t* YB() const { return (bf16_t*)(wsp + WS_OB); }
};

DI bool xcd_item(int k, int NM, int NN, int& mt, int& nt) {
    const int x = blockIdx.x & 7, j = blockIdx.x >> 3, g8 = gridDim.x >> 3;
    const int per = (NM + 7) >> 3;
    const int i = j + k * g8;
    if (i >= per * NN) return false;
    mt = x * per + i / NN; nt = i % NN;
    return true;
}
DI void phase_prologue(const Ctx& c) {
    const size_t gt = (size_t)blockIdx.x * NTHR + opaque_tid(), gs = (size_t)gridDim.x * NTHR;
    const float* x = c.in(0);
    for (size_t i = gt; i < (size_t)T * DM / 8; i += gs) {
        const f32x4 a = *(const f32x4*)(x + i * 8), b = *(const f32x4*)(x + i * 8 + 4);
        u32x2 o8; o8[0] = pk4_fp8(a[0], a[1], a[2], a[3]); o8[1] = pk4_fp8(b[0], b[1], b[2], b[3]);
        *(u32x2*)(c.HB8() + i * 8) = o8;
    }
    const float* mem = c.in(1); bf16_t* mb = c.MEMB();
    for (size_t i = gt; i < (size_t)1024 * 1024 / 8; i += gs) {
        const f32x4 a = *(const f32x4*)(mem + i * 8), b = *(const f32x4*)(mem + i * 8 + 4);
        u32x4 o; o[0] = cvtpk(a[0], a[1]); o[1] = cvtpk(a[2], a[3]); o[2] = cvtpk(b[0], b[1]); o[3] = cvtpk(b[2], b[3]);
        *(u32x4*)(mb + i * 8) = o;
    }
}

DI void conv_tile(const float* src, int ld_src, bf16_t* dst, int K, int kt, int nt, int kind, const float* gain, char* lds) {
    float* tile = (float*)lds; const int tid = opaque_tid();
    const int k0 = kt * 64, n0 = nt * 64;
    __syncthreads();
    {
        const int nl = tid & 63; const int np = n0 + nl; int ns = np; bool valid = true;
        if (kind == 1) { if (np < 2592) ns = np; else if (np < 2848) ns = np + 12; else if (np < 2860) ns = np - 256; else valid = false; }
        else if (kind == 2) { const int j = np >> 6, cc = np & 63; ns = cc < 32 ? 32 * j + cc : 256 + 32 * j + cc - 32; }
        else if (kind == 3) { valid = np < 64; }
#pragma unroll
        for (int i = 0; i < 16; ++i) {
            const int kl = (tid >> 6) + 4 * i;
            float v = valid ? src[(size_t)(k0 + kl) * ld_src + ns] : 0.f;
            if (gain) v *= gain[k0 + kl];
            tile[kl * 65 + nl] = v;
        }
    }
    __syncthreads();
    {
        const int kl = tid & 63;
#pragma unroll
        for (int i = 0; i < 16; ++i) {
            const int nl = (tid >> 6) + 4 * i;
            const float v = tile[kl * 65 + nl];
            dst[(size_t)(n0 + nl) * K + k0 + kl] = (bf16_t)(cvtpk(v, v) & 0xffffu);
        }
    }
}
DI void conv_tile_f8(const float* src, int ld_src, unsigned char* dst8, int K, int kt, int nt, int kind, float scale, char* lds) {
    float* tile = (float*)lds; const int tid = opaque_tid();
    const int k0 = kt * 64, n0 = nt * 64;
    __syncthreads();
    {
        const int nl = tid & 63; const int np = n0 + nl; int ns = np; bool valid = true;
        if (kind == 1) { if (np < 2592) ns = np; else if (np < 2848) ns = np + 12; else if (np < 2860) ns = np - 256; else valid = false; }
        else if (kind == 2) { const int j = np >> 6, cc = np & 63; ns = cc < 32 ? 32 * j + cc : 256 + 32 * j + cc - 32; }
#pragma unroll
        for (int i = 0; i < 16; ++i) { const int kl = (tid >> 6) + 4 * i; tile[kl * 65 + nl] = valid ? src[(size_t)(k0 + kl) * ld_src + ns] * scale : 0.f; }
    }
    __syncthreads();
#pragma unroll
    for (int q = 0; q < 4; ++q) { const int kq = tid & 15, nl = (tid >> 4) + 16 * q;
        *(unsigned*)(dst8 + (size_t)(n0 + nl) * K + k0 + 4 * kq) = pk4_fp8(tile[(4 * kq) * 65 + nl], tile[(4 * kq + 1) * 65 + nl], tile[(4 * kq + 2) * 65 + nl], tile[(4 * kq + 3) * 65 + nl]); }
}
DI bool conv_job_f8(int& t, const float* src, int ld_src, unsigned char* dst8, int K, int N, int kind, float scale, char* lds) {
    const int nkt = K / 64, cnt = nkt * (N / 64);
    if (t < cnt) { conv_tile_f8(src, ld_src, dst8, K, t % nkt, t / nkt, kind, scale, lds); return true; }
    t -= cnt; return false;
}
DI bool conv_job(int& t, const float* src, int ld_src, bf16_t* dst, int K, int N, int kind, const float* gain, char* lds) {
    const int nkt = K / 64, cnt = nkt * (N / 64);
    if (t < cnt) { conv_tile(src, ld_src, dst, K, t % nkt, t / nkt, kind, gain, lds); return true; }
    t -= cnt; return false;
}
struct WJob { const __attribute__((address_space(1))) float* src; const __attribute__((address_space(1))) float* gain; __attribute__((address_space(1))) unsigned char* dst; float scale; int ld, K, k0, n0, kind, f8; };
DI bool w_decode(const Ctx& c, int item, WJob& j) {
    const int l = c.layer; unsigned char* W = (unsigned char*)c.W(); int t = item;
    j.gain = (const __attribute__((address_space(1))) float*)nullptr; j.scale = 1.f; j.kind = 0; j.f8 = 0;
    int N = 0; size_t dsto = 0;
#define WJ_ENT(CNT, SRC, LD, DSTE, DST8ADD, KK, NN, KIND, GAIN, SCALE, F8) \
    if (t < (CNT)) { j.src = (const __attribute__((address_space(1))) float*)(SRC); j.ld = (LD); dsto = (DSTE); j.K = (KK); N = (NN); j.kind = (KIND); j.gain = (const __attribute__((address_space(1))) float*)(GAIN); j.scale = (SCALE); j.f8 = (F8); j.dst = (__attribute__((address_space(1))) unsigned char*)(W + 2 * dsto + (DST8ADD)); \
                     const int nkt = (KK) / 64; j.k0 = 64 * (t % nkt); j.n0 = 64 * (t / nkt); return true; } t -= (CNT);
    WJ_ENT(16 * 46, c.in(2) + (size_t)l * 1024 * 2860, 2860, W_IN, 0, 1024, PW, 1, nullptr, 32.f, 1)
    WJ_ENT(4 * 6, c.in(5) + (size_t)l * 256 * 384, 384, W_UQ, 0, 256, 384, 0, c.in(3) + l * 256, 1.f, 0)
    WJ_ENT(2 * 8, c.in(6) + (size_t)l * 128 * 512, 512, W_UKV, 0, 128, 512, 0, c.in(4) + l * 128, 1.f, 0)
    WJ_ENT(32 * 2, c.in(8) + (size_t)l * 2048 * 128, 128, W_PHI1, 0, 2048, 128, 0, nullptr, 1.f, 0)
    WJ_ENT(32 * 2, c.in(10) + (size_t)l * 2048 * 128, 128, W_PHI1 + 128 * 2048, 0, 2048, 128, 0, nullptr, 1.f, 0)
    WJ_ENT(2 * 2, c.in(9) + (size_t)l * 128 * 64, 64, W_PHI2, 0, 128, 128, 3, nullptr, 1.f, 0)
    WJ_ENT(2 * 2, c.in(11) + (size_t)l * 128 * 64, 64, W_PHI2 + 128 * 128, 0, 128, 128, 3, nullptr, 1.f, 0)
    WJ_ENT(16 * 8, c.in(12) + (size_t)l * 1024 * 512, 512, W_MEM, 0, 1024, 512, 0, nullptr, 1.f, 0)
    if (t < 5 * 64) { const int i = t / 64; t %= 64; WJ_ENT(64, c.in(13) + ((size_t)l * 5 + i) * 256 * 1024, 1024, W_BR, (size_t)i * 1024 * 256, 256, 1024, 0, nullptr, 32.f, 1) } t -= 5 * 64;
    if (t < 5 * 256) { const int i = t / 256; t %= 256; WJ_ENT(256, c.in(14) + ((size_t)l * 5 + i) * 1024 * 1024, 1024, W_G, (size_t)i * 1024 * 1024, 1024, 1024, 0, nullptr, 32.f, 1) } t -= 5 * 256;
    WJ_ENT(256, c.in(16) + (size_t)l * 1024 * 1024, 1024, W_OUT, 0, 1024, 1024, 0, nullptr, 64.f, 1)
    if (t < 16 * 128) { const int e = t / 128; t %= 128; WJ_ENT(128, c.in(23) + ((size_t)l * 16 + e) * 1024 * 512, 512, W_UP, (size_t)e * 512 * 1024, 1024, 512, 2, nullptr, 32.f, 1) } t -= 16 * 128;
    if (t < 16 * 64) { const int e = t / 64; t %= 64; WJ_ENT(64, c.in(24) + ((size_t)l * 16 + e) * 256 * 1024, 1024, W_DN, (size_t)e * 1024 * 256, 256, 1024, 0, nullptr, 32.f, 1) } t -= 16 * 64;
#undef WJ_ENT
    j.k0 = t; (void)N;
    return false;
}
DI void w_load(const WJob& j, float (&v)[16], int tid) {
    const int nl = tid & 63, np = j.n0 + nl; int ns = np; bool valid = true;
    if (j.kind == 1) { if (np < 2592) ns = np; else if (np < 2848) ns = np + 12; else if (np < 2860) ns = np - 256; else valid = false; }
    else if (j.kind == 2) { const int jj = np >> 6, cc = np & 63; ns = cc < 32 ? 32 * jj + cc : 256 + 32 * jj + cc - 32; }
    else if (j.kind == 3) { valid = np < 64; }
    const __attribute__((address_space(1))) float* s = j.src + (size_t)(j.k0 + (tid >> 6)) * j.ld + ns;
#pragma unroll
    for (int i = 0; i < 16; ++i) v[i] = valid ? s[(size_t)(4 * i) * j.ld] : 0.f;
    if (j.gain) {
#pragma unroll
        for (int i = 0; i < 16; ++i) v[i] *= j.gain[j.k0 + (tid >> 6) + 4 * i];
    }
}
DI void w_finish(const WJob& j, const float (&v)[16], char* lds, int tid) {
    float* tile = (float*)lds;
    __syncthreads();
#pragma unroll
    for (int i = 0; i < 16; ++i) tile[((tid >> 6) + 4 * i) * 65 + (tid & 63)] = v[i] * j.scale;
    __syncthreads();
    if (j.f8) {
#pragma unroll
        for (int q = 0; q < 4; ++q) { const int kq = tid & 15, nl = (tid >> 4) + 16 * q;
            *(__attribute__((address_space(1))) unsigned*)(j.dst + (size_t)(j.n0 + nl) * j.K + j.k0 + 4 * kq) = pk4_fp8(tile[(4 * kq) * 65 + nl], tile[(4 * kq + 1) * 65 + nl], tile[(4 * kq + 2) * 65 + nl], tile[(4 * kq + 3) * 65 + nl]); }
    } else {
        __attribute__((address_space(1))) bf16_t* d = (__attribute__((address_space(1))) bf16_t*)j.dst;
#pragma unroll
        for (int q = 0; q < 8; ++q) { const int kp = tid & 31, nl = (tid >> 5) + 8 * q;
            *(__attribute__((address_space(1))) unsigned*)(d + (size_t)(j.n0 + nl) * j.K + j.k0 + 2 * kp) = cvtpk(tile[(2 * kp) * 65 + nl], tile[(2 * kp + 1) * 65 + nl]); }
    }
}
DI void w_cpart(const Ctx& c, int t) {
    const int l = c.layer; const int kv = t >> 5, pp = t & 31; const int tid = opaque_tid(), j = tid & 127, hh = tid >> 7;
    const float* w1 = c.in(kv ? 10 : 8) + (size_t)l * 2048 * 128; const float* pe = c.in(7) + (size_t)l * 2048;
    float s = 0.f;
    for (int k = pp * 64 + hh * 32; k < pp * 64 + hh * 32 + 32; ++k) s += pe[k] * w1[(size_t)k * 128 + j];
    float* red = (float*)c.lds;
    __syncthreads();
    if (hh) red[j] = s;
    __syncthreads();
    if (!hh) c.CPART()[(kv * 32 + pp) * 128 + j] = s + red[j];
}
DI void phase_weights(const Ctx& c) {
    constexpr int TOTAL = 16 * 46 + 4 * 6 + 2 * 8 + 2 * 64 + 2 * 4 + 128 + 5 * 64 + 5 * 256 + 256 + 16 * 128 + 16 * 64 + 64;
    const int tid = opaque_tid(); const int G = gridDim.x;
    int item = blockIdx.x;
    WJob cur; cur.src = (const __attribute__((address_space(1))) float*)nullptr; cur.gain = (const __attribute__((address_space(1))) float*)nullptr; cur.dst = (__attribute__((address_space(1))) unsigned char*)nullptr; cur.scale = 1.f; cur.ld = 0; cur.K = 0; cur.k0 = 0; cur.n0 = 0; cur.kind = 0; cur.f8 = 0;
    float v[16]; bool is_tile = false;
#pragma unroll
    for (int i = 0; i < 16; ++i) v[i] = 0.f;
    if (item < TOTAL) { is_tile = w_decode(c, item, cur); if (is_tile) w_load(cur, v, tid); }
    while (item < TOTAL) {
        const int nitem = item + G;
        WJob nxt = cur; float vn[16]; bool ntile = false;
#pragma unroll
        for (int i = 0; i < 16; ++i) vn[i] = 0.f;
        if (nitem < TOTAL) { ntile = w_decode(c, nitem, nxt); if (ntile) w_load(nxt, vn, tid); }
        if (is_tile) w_finish(cur, v, c.lds, tid); else w_cpart(c, cur.k0);
        cur = nxt; is_tile = ntile; item = nitem;
#pragma unroll
        for (int i = 0; i < 16; ++i) v[i] = vn[i];
    }
}

DI void store_bf16_tile(const f32x16 (&acc)[2][2], bf16_t* dst  , size_t ldc) {
    const int tid = opaque_tid(), lane = tid & 63, w = tid >> 6, r = lane & 31, h = lane >> 5, wr = w >> 1, wc = w & 1;
#pragma unroll
    for (int mi = 0; mi < 2; ++mi)
#pragma unroll
        for (int ni = 0; ni < 2; ++ni)
#pragma unroll
            for (int g = 0; g < 4; g += 2) {
                u32x2 wa, wb; wa[0] = cvtpk(acc[mi][ni][4 * g], acc[mi][ni][4 * g + 1]); wa[1] = cvtpk(acc[mi][ni][4 * g + 2], acc[mi][ni][4 * g + 3]);
                wb[0] = cvtpk(acc[mi][ni][4 * g + 4], acc[mi][ni][4 * g + 5]); wb[1] = cvtpk(acc[mi][ni][4 * g + 6], acc[mi][ni][4 * g + 7]);
                store_pair16(dst + (size_t)(64 * wr + 32 * mi + r) * ldc + 64 * wc + 32 * ni + 8 * g, wa, wb, h);
            }
}
DI void phase_proj(const Ctx& c) {
    const int tid = opaque_tid(), srow = tid >> 3, scol = (tid & 7) * 8;
    if (blockIdx.x == 0) {
        const float* cp = c.CPART(); float s = 0.f; const int kv = tid >> 7, j = tid & 127;
        for (int pp = 0; pp < 32; ++pp) s += cp[(kv * 32 + pp) * 128 + j];
        c.CBIAS()[tid] = s;
    }
    constexpr int NTN = PW / 128;
    int mt, nt; bool have = xcd_item(0, T / 128, NTN, mt, nt);
    for (int k = 0; have; ++k) {
        int mt2 = 0, nt2 = 0; const bool have2 = xcd_item(k + 1, T / 128, NTN, mt2, nt2);
        f32x16 acc[2][2]; zero_acc(acc);
        { int rowE, cbE, cbO; dma_lane(tid, rowE, cbE, cbO);
          const char* a8 = (const char*)(c.HB8() + (size_t)(128 * mt + rowE) * 1024);
          const char* b8 = (const char*)(c.W() + W_IN) + (size_t)(128 * nt + rowE) * 1024;
          const NextSt nx = next_reg(c.HB8() + (size_t)(128 * mt2) * 1024, 1024, (const char*)(c.W() + W_IN) + (size_t)(128 * nt2) * 1024, 1024, have2, tid);
          gemm_dma<2, true, NextSt, 122, 127>(acc, a8 + cbE, a8 + 8 * 1024 + cbO, nullptr, nullptr, 16 * 1024, 128, b8 + cbE, b8 + 8 * 1024 + cbO, 16 * 1024, 8, c.lds, k ? 8 : 0, nx); }
        store_bf16_tile(acc, c.P() + (size_t)(128 * mt) * PW + 128 * nt, PW);
        if (nt == 8 || nt == 9) {
            const int lane_ = tid & 63, w_ = tid >> 6, r_ = lane_ & 31, h_ = lane_ >> 5, wr_ = w_ >> 1, wc_ = w_ & 1;
            float* red = (float*)(c.lds + LDS_MISC + 2048);
#pragma unroll
            for (int ni = 0; ni < 2; ++ni)
#pragma unroll
                for (int i = 0; i < 16; ++i) {
                    float v = acc[0][ni][i] + acc[1][ni][i];
#pragma unroll
                    for (int o = 1; o <= 16; o <<= 1) v += __shfl_xor(v, o);
                    if (r_ == 0) red[wr_ * 128 + 64 * wc_ + 32 * ni + 8 * (i >> 2) + 4 * h_ + (i & 3)] = v;
                }
            __syncthreads();
            if (tid < 128) c.KMEAN()[(size_t)mt * 256 + (nt - 8) * 128 + tid] = red[tid] + red[128 + tid];
            __syncthreads();
        }
        mt = mt2; nt = nt2; have = have2;
    }
    {
        const int first = gridDim.x >= 512 ? 256 : 0;
        for (int item = (int)blockIdx.x - first; item >= 0 && item < 32; item += gridDim.x) {
            f32x16 acc[2][2]; zero_acc(acc);
            const int mt = item >> 2, nt = item & 3;
            gemm_reg(acc, c.MEMB() + (size_t)(128 * mt) * 1024, 1024, c.W() + W_MEM + (size_t)(128 * nt) * 1024, 1024, 1024, c.lds);
            store_bf16_tile(acc, c.MEMKV() + (size_t)(128 * mt) * 512 + 128 * nt, 512);
        }
    }
}

DI void sel_item(const Ctx& c, int item) {
    const int tid = opaque_tid(), lane = tid & 63, w = tid >> 6, r = lane & 31, h = lane >> 5;
    float* km = (float*)(c.lds + 24576);
    {
        const int qt = item >> 4, b = (item >> 2) & 3, head = item & 3, bh = b * 4 + head;
        const int q0 = 128 * qt, own = q0 >> 8, qpos = q0 + 32 * w + r; const size_t tok = (size_t)b * S + qpos;
        const bf16_t* qrow = c.P() + tok * PW + C_MBQ + head * 64;
        __syncthreads();
        { const float* kp = c.KMEAN() + (size_t)(b * 64) * 256 + head * 64;
          for (int i = tid; i < own * 64; i += NTHR) { const int n = i >> 6, d = i & 63; km[i] = (kp[(size_t)(2 * n) * 256 + d] + kp[(size_t)(2 * n + 1) * 256 + d]) * (1.f / 256.f); } }
        __syncthreads();
        u32x4 qq[8];
#pragma unroll
        for (int i = 0; i < 8; ++i) qq[i] = *(const u32x4*)(qrow + 8 * i);
        float v1 = -3e38f, v2 = -3e38f, v3 = -3e38f; int i1 = 255, i2 = 255, i3 = 255;
        for (int n = 0; n < own; ++n) {
            float gsc = 0.f; const float* kr = km + n * 64;
#pragma unroll
            for (int i = 0; i < 8; ++i)
#pragma unroll
                for (int e = 0; e < 4; ++e) { gsc += bflo(qq[i][e]) * kr[8 * i + 2 * e]; gsc += bfhi(qq[i][e]) * kr[8 * i + 2 * e + 1]; }
            if (gsc > v1) { v3 = v2; i3 = i2; v2 = v1; i2 = i1; v1 = gsc; i1 = n; }
            else if (gsc > v2) { v3 = v2; i3 = i2; v2 = gsc; i2 = n; }
            else if (gsc > v3) { v3 = gsc; i3 = n; }
        }
        if (h == 0) {
            c.MBSEL()[(size_t)bh * S + qpos] = (unsigned)i1 | ((unsigned)i2 << 8) | ((unsigned)i3 << 16);
            unsigned* cnt = c.CTL() + CW_MB + (512 * c.layer + bh * 32) * 64;
            unsigned short* lst = c.MBLIST() + (size_t)(bh * 32) * 8192;
            if (i1 < 255) { const unsigned pos = __hip_atomic_fetch_add(cnt + 64 * i1, 1u, __ATOMIC_RELAXED, __HIP_MEMORY_SCOPE_AGENT); lst[(size_t)i1 * 8192 + pos] = (unsigned short)(qpos | (0 << 13)); }
            if (i2 < 255) { const unsigned pos = __hip_atomic_fetch_add(cnt + 64 * i2, 1u, __ATOMIC_RELAXED, __HIP_MEMORY_SCOPE_AGENT); lst[(size_t)i2 * 8192 + pos] = (unsigned short)(qpos | (1 << 13)); }
            if (i3 < 255) { const unsigned pos = __hip_atomic_fetch_add(cnt + 64 * i3, 1u, __ATOMIC_RELAXED, __HIP_MEMORY_SCOPE_AGENT); lst[(size_t)i3 * 8192 + pos] = (unsigned short)(qpos | (2 << 13)); }
        }
    }
}
DI void phase_prep1(const Ctx& c) {
    const int tid = opaque_tid(), lane = tid & 63, w = tid >> 6, r = lane & 31, h = lane >> 5, wr = w >> 1, wc = w & 1;
    const int srow = tid >> 3, scol = (tid & 7) * 8;
    float* rstd = (float*)(c.lds + LDS_MISC);
    constexpr int N_C = 32, N_KM = 1024, N_Q = 256 * 3, N_KV = 256 * 4, TOTAL = N_C + N_KM + N_Q + N_KV;
    unsigned* qh = c.CTL() + 512 + 16 * c.layer;
    volatile int* qslot = (volatile int*)(c.lds + LDS_MISC + 3584);
    for (;;) {
        __syncthreads();
        if (threadIdx.x == 0) *qslot = (int)__hip_atomic_fetch_add(qh, 1u, __ATOMIC_RELAXED, __HIP_MEMORY_SCOPE_AGENT);
        __syncthreads();
        const int item = __builtin_amdgcn_readfirstlane(*qslot);
        if (item >= TOTAL) break;
        int t = item;
        if (t < N_C) {
            const int kv = t >> 4, mt = t & 15;
            f32x16 acc[2][2]; zero_acc(acc);
            int rowE, cbE, cbO; dma_lane(tid, rowE, cbE, cbO);
            const char* ap[4];
#pragma unroll
            for (int i = 0; i < 4; ++i) { const int gr = 128 * mt + rowE + 8 * i, b = gr >> 9; int n = gr & 511; n = n > 510 ? 510 : n;
                ap[i] = (const char*)(c.P() + (size_t)(b * S + 16 * n) * PW + C_NKV + 64 * kv) + ((i & 1) ? cbO : cbE); }
            const char* bp = (const char*)(c.W() + W_PHI1 + (size_t)kv * 128 * 2048 + (size_t)rowE * 2048);
            gemm_dma<0, false>(acc, ap[0], ap[1], ap[2], ap[3], 0, (size_t)PW * 2, bp + cbE, bp + 8 * 2048 * 2 + cbO, 16 * 2048 * 2, 32, c.lds);
            const float* cbias = c.CBIAS() + kv * 128; bf16_t* hc = c.HC() + (size_t)kv * 2048 * 128 + (size_t)(128 * mt) * 128;
#pragma unroll
            for (int mi = 0; mi < 2; ++mi)
#pragma unroll
                for (int ni = 0; ni < 2; ++ni)
#pragma unroll
                    for (int g = 0; g < 4; ++g) {
                        const int col = 64 * wc + 32 * ni + 8 * g + 4 * h; const f32x4 bv = *(const f32x4*)(cbias + col);
                        float o4[4];
#pragma unroll
                        for (int e = 0; e < 4; ++e) { const float x = acc[mi][ni][4 * g + e] + bv[e]; const float y = 0.7978845608028654f * (x + 0.044715f * x * x * x);
                            o4[e] = x * rcpf_(1.f + ex2(-2.f * LOG2E * y)); }
                        u32x2 wv; wv[0] = cvtpk(o4[0], o4[1]); wv[1] = cvtpk(o4[2], o4[3]);
                        *(u32x2*)(hc + (size_t)(64 * wr + 32 * mi + r) * 128 + col) = wv;
                    }
            f32x16 acc2[2][2]; zero_acc(acc2);
            gemm_reg(acc2, hc, 128, c.W() + W_PHI2 + (size_t)kv * 128 * 128, 128, 128, c.lds);
            if (wc == 0) {
                bf16_t* dst = c.KC() + (size_t)kv * 2048 * 64 + (size_t)(128 * mt) * 64;
#pragma unroll
                for (int mi = 0; mi < 2; ++mi)
#pragma unroll
                    for (int ni = 0; ni < 2; ++ni)
#pragma unroll
                        for (int g = 0; g < 4; ++g) {
                            u32x2 wv; wv[0] = cvtpk(acc2[mi][ni][4 * g], acc2[mi][ni][4 * g + 1]); wv[1] = cvtpk(acc2[mi][ni][4 * g + 2], acc2[mi][ni][4 * g + 3]);
                            *(u32x2*)(dst + (size_t)(64 * wr + 32 * mi + r) * 64 + 32 * ni + 8 * g + 4 * h) = wv;
                        }
            }
            continue;
        }
        t -= N_C;
        if (t < N_KM) { sel_item(c, t); continue; }
        t -= N_KM;
        if (t < N_Q) {
            const int mt = t / 3, ct = t % 3;
            __syncthreads();
            { const int row = tid >> 1, half = tid & 1; const bf16_t* src = c.P() + (size_t)(128 * mt + row) * PW + C_CQ + half * 128; float ss = 0.f;
#pragma unroll
              for (int i = 0; i < 16; ++i) { const u32x4 v = *(const u32x4*)(src + 8 * i);
#pragma unroll
                  for (int e = 0; e < 4; ++e) { const float a = bflo(v[e]), bq = bfhi(v[e]); ss += a * a + bq * bq; } }
              ss += __shfl_xor(ss, 1);
              if (!half) rstd[row] = __builtin_amdgcn_rsqf(ss * (1.f / 256.f) + 1e-6f); }
            f32x16 acc[2][2]; zero_acc(acc);
            gemm_reg(acc, c.P() + (size_t)(128 * mt) * PW + C_CQ, PW, c.W() + W_UQ + (size_t)(128 * ct) * 256, 256, 256, c.lds);
            bf16_t* dst = c.QM() + (size_t)(128 * mt) * QMW + 128 * ct;
#pragma unroll
            for (int mi = 0; mi < 2; ++mi) { const float sc = rstd[64 * wr + 32 * mi + r];
#pragma unroll
                for (int ni = 0; ni < 2; ++ni)
#pragma unroll
                    for (int g = 0; g < 4; g += 2) {
                        u32x2 wa, wb; wa[0] = cvtpk(acc[mi][ni][4 * g] * sc, acc[mi][ni][4 * g + 1] * sc); wa[1] = cvtpk(acc[mi][ni][4 * g + 2] * sc, acc[mi][ni][4 * g + 3] * sc);
                        wb[0] = cvtpk(acc[mi][ni][4 * g + 4] * sc, acc[mi][ni][4 * g + 5] * sc); wb[1] = cvtpk(acc[mi][ni][4 * g + 6] * sc, acc[mi][ni][4 * g + 7] * sc);
                        store_pair16(dst + (size_t)(64 * wr + 32 * mi + r) * QMW + 64 * wc + 32 * ni + 8 * g, wa, wb, h);
                    } }
            continue;
        }
        t -= N_Q;
        {
            const int mt = t >> 2, ct = t & 3;
            __syncthreads();
            { const int row = tid >> 1, half = tid & 1; const bf16_t* src = c.P() + (size_t)(128 * mt + row) * PW + C_CKV + half * 64; float ss = 0.f;
#pragma unroll
              for (int i = 0; i < 8; ++i) { const u32x4 v = *(const u32x4*)(src + 8 * i);
#pragma unroll
                  for (int e = 0; e < 4; ++e) { const float a = bflo(v[e]), bq = bfhi(v[e]); ss += a * a + bq * bq; } }
              ss += __shfl_xor(ss, 1);
              if (!half) rstd[row] = __builtin_amdgcn_rsqf(ss * (1.f / 128.f) + 1e-6f);
              if (ct == 0) {
                  const int tok = 128 * mt + row; const float pos = (float)(tok & (S - 1));
                  const bf16_t* kr = c.P() + (size_t)tok * PW + C_KR + 8 * half;
                  const u32x4 x1 = *(const u32x4*)kr, x2 = *(const u32x4*)(kr + 16);
                  float o1[8], o2[8];
#pragma unroll
                  for (int j = 0; j < 8; ++j) { const int i = 8 * half + j; const float fr = ex2(-(float)i * (13.287712379549449f / 16.f)) * 0.15915494309189535f;
                      const float tt = pos * fr; const float ph = tt - floorf(tt); const float sn = __builtin_amdgcn_sinf(ph), cs = __builtin_amdgcn_cosf(ph);
                      const float a = (j & 1) ? bfhi(x1[j >> 1]) : bflo(x1[j >> 1]), bq = (j & 1) ? bfhi(x2[j >> 1]) : bflo(x2[j >> 1]);
                      o1[j] = a * cs - bq * sn; o2[j] = a * sn + bq * cs; }
                  u32x4 w1v, w2v;
#pragma unroll
                  for (int j = 0; j < 4; ++j) { w1v[j] = cvtpk(o1[2 * j], o1[2 * j + 1]); w2v[j] = cvtpk(o2[2 * j], o2[2 * j + 1]); }
                  bf16_t* d = c.MK() + (size_t)tok * MKW + 64 + 8 * half;
#pragma unroll
                  for (int hd = 0; hd < 4; ++hd) { *(u32x4*)(d + hd * 160) = w1v; *(u32x4*)(d + hd * 160 + 16) = w2v; }
              } }
            f32x16 acc[2][2]; zero_acc(acc);
            gemm_reg(acc, c.P() + (size_t)(128 * mt) * PW + C_CKV, PW, c.W() + W_UKV + (size_t)(128 * ct) * 128, 128, 128, c.lds);
            bf16_t* dst = c.MK() + (size_t)(128 * mt) * MKW + ct * 160 + (wc ? 96 : 0);
#pragma unroll
            for (int mi = 0; mi < 2; ++mi) { const float sc = rstd[64 * wr + 32 * mi + r];
#pragma unroll
                for (int ni = 0; ni < 2; ++ni)
#pragma unroll
                    for (int g = 0; g < 4; g += 2) {
                        u32x2 wa, wb; wa[0] = cvtpk(acc[mi][ni][4 * g] * sc, acc[mi][ni][4 * g + 1] * sc); wa[1] = cvtpk(acc[mi][ni][4 * g + 2] * sc, acc[mi][ni][4 * g + 3] * sc);
                        wb[0] = cvtpk(acc[mi][ni][4 * g + 4] * sc, acc[mi][ni][4 * g + 5] * sc); wb[1] = cvtpk(acc[mi][ni][4 * g + 6] * sc, acc[mi][ni][4 * g + 7] * sc);
                        store_pair16(dst + (size_t)(64 * wr + 32 * mi + r) * MKW + 32 * ni + 8 * g, wa, wb, h);
                    } }
        }
    }
}

DI void phase_prep2(const Ctx& c) {
    const int tid = opaque_tid(), lane = tid & 63, w = tid >> 6, r = lane & 31, h = lane >> 5, wr = w >> 1, wc = w & 1;
    const int srow = tid >> 3, scol = (tid & 7) * 8;
    for (int item = blockIdx.x; item < 32; item += gridDim.x) {
        const int kv = item >> 4, mt = item & 15;
        f32x16 acc[2][2]; zero_acc(acc);
        gemm_reg(acc, c.HC() + (size_t)kv * 2048 * 128 + (size_t)(128 * mt) * 128, 128, c.W() + W_PHI2 + (size_t)kv * 128 * 128, 128, 128, c.lds);
        if (wc == 0) {
            bf16_t* dst = c.KC() + (size_t)kv * 2048 * 64 + (size_t)(128 * mt) * 64;
#pragma unroll
            for (int mi = 0; mi < 2; ++mi)
#pragma unroll
                for (int ni = 0; ni < 2; ++ni)
#pragma unroll
                    for (int g = 0; g < 4; ++g) {
                        u32x2 wv; wv[0] = cvtpk(acc[mi][ni][4 * g], acc[mi][ni][4 * g + 1]); wv[1] = cvtpk(acc[mi][ni][4 * g + 2], acc[mi][ni][4 * g + 3]);
                        *(u32x2*)(dst + (size_t)(64 * wr + 32 * mi + r) * 64 + 32 * ni + 8 * g + 4 * h) = wv;
                    }
        }
    }
}

DI void sb_item(const Ctx& c, int b, int head, int qt) {
    const int tid = opaque_tid(), lane = tid & 63, w = tid >> 6, r = lane & 31, h = lane >> 5;
    const int q0 = 128 * qt, qpos = q0 + 32 * w + r; const size_t tok = (size_t)b * S + qpos;
    bf16x8 qf[4]; load_q64(qf, c.P() + tok * PW + C_SBQ + head * 64, tid);
    const bf16_t* kbase = c.P() + (size_t)b * S * PW + C_SBK + head * 64; const bf16_t* vbase = c.P() + (size_t)b * S * PW + C_SBV + head * 64;
    volatile int* flags = (volatile int*)(c.lds + 40960);
    f32x16 o[2]; o[0] = zero16(); o[1] = zero16();
    float carry = 0.f;
    const int t_top = 2 * qt + 1;
    KVRegs<64> R; kv_load<64>(R, kbase, PW, vbase, PW, t_top, S - 1, tid);
    for (int t = t_top; t >= 0; --t) {
        __syncthreads();
        if (t != t_top) { const int any = flags[0] | flags[1] | flags[2] | flags[3]; if (!any) break; }
        kv_store<64>(R, c.lds, tid);
        __syncthreads();
        if (t > 0) kv_load<64>(R, kbase, PW, vbase, PW, t - 1, S - 1, tid);
        f32x16 s[2];
        qk_tile<64>(s, qf, c.lds, tid);
        const int lim = qpos - 64 * t - 4 * h;
#pragma unroll
        for (int kh = 1; kh >= 0; --kh) {
            float G[4], Go[4], lkv[16];
#pragma unroll
            for (int g = 0; g < 4; ++g) { G[g] = 0.f;
#pragma unroll
                for (int e = 0; e < 4; ++e) { const int i = 4 * g + e; const int koff = 32 * kh + 8 * g + e;
                    const float z = s[kh][i] * 0.125f; const float az = fabsf(z);
                    const float sp = fmaxf(z, 0.f) + LN2 * lg2(1.f + ex2(-az * LOG2E));
                    const float lk = koff < lim ? -sp : 0.f;
                    lkv[i] = lk; s[kh][i] = z; G[g] += lk; } }
#pragma unroll
            for (int g = 0; g < 4; ++g) Go[g] = __shfl_xor(G[g], 32);
            float tot = 0.f, gs[4];
#pragma unroll
            for (int g = 3; g >= 0; --g) { gs[g] = tot + (h == 0 ? Go[g] : 0.f); tot += G[g] + Go[g]; }
#pragma unroll
            for (int g = 0; g < 4; ++g) { float insuf = 0.f;
#pragma unroll
                for (int e = 3; e >= 0; --e) { const int i = 4 * g + e; const int koff = 32 * kh + 8 * g + e;
                    const bool valid = koff < lim;
                    const float a = valid ? ex2((s[kh][i] + lkv[i] + carry + gs[g] + insuf) * LOG2E) : 0.f;
                    insuf += lkv[i]; s[kh][i] = a; } }
            carry += tot;
        }
        pv_tile<64>(o, s, c.lds, tid);
        const int act = __any(carry >= -104.f);
        if (lane == 0) flags[w] = act;
    }
    write_o(c.OB() + tok * OBW + 0 + head * 64, o, tid);
}

DI void moba_sel_item(const Ctx& c, int bhblk, int chunk) {
    const int tid = opaque_tid(), lane = tid & 63, w = tid >> 6, r = lane & 31, h = lane >> 5;
    const int bh = bhblk >> 5, blk = bhblk & 31, b = bh >> 2, head = bh & 3;
    const int cnt = (int)c.CTL()[CW_MB + (512 * c.layer + bhblk) * 64];
    int e = chunk * 128 + 32 * w + r; const bool live = e < cnt; e = live ? e : cnt - 1;
    const unsigned ent = c.MBLIST()[(size_t)bhblk * 8192 + e];
    const int qpos = ent & 0x1FFF, slot = ent >> 13;
    const bf16_t* qrow = c.P() + ((size_t)b * S + qpos) * PW + C_MBQ + head * 64;
    bf16x8 qf[4]; load_q64(qf, qrow, tid);
    PolRoute pol; pol.qpos = qpos; pol.sc2 = 0.125f * LOG2E; pol.sl2 = exp2f(-2.f * (float)(head + 1)) * LOG2E; pol.h4 = 4 * h; pol.base = 0.f;
    float m = -1e30f, l = 0.f; f32x16 o[2]; o[0] = zero16(); o[1] = zero16();
    const bf16_t* kbase = c.P() + (size_t)b * S * PW + C_MBK + head * 64; const bf16_t* vbase = c.P() + (size_t)b * S * PW + C_MBV + head * 64;
    flash_pass<64, true, false>(qf, kbase, PW, vbase, PW, S - 1, 4 * blk, 4 * blk + 4, NeedAll(), 1 << 30, pol, m, l, o, c.lds, tid);
    l += __shfl_xor(l, 32);
    const float inv = 1.f / l;
#pragma unroll
    for (int i = 0; i < 16; ++i) { o[0][i] *= inv; o[1][i] *= inv; }
    if (live) {
        unsigned char* rec = c.MBPART() + ((size_t)(bh * S + qpos) * 3 + slot) * 144;
        if (h == 0) { f32x2 ml = {m, l}; *(f32x2*)rec = ml; }
        write_o_bf16((bf16_t*)(rec + 16), o, tid);
    }
}
DI void moba_own_item(const Ctx& c, int b, int head, int qt) {
    const int tid = opaque_tid(), lane = tid & 63, w = tid >> 6, r = lane & 31, h = lane >> 5;
    const int q0 = 128 * qt, own = q0 >> 8, qpos = q0 + 32 * w + r, bh = b * 4 + head; const size_t tok = (size_t)b * S + qpos;
    const bf16_t* qrow = c.P() + tok * PW + C_MBQ + head * 64;
    bf16x8 qf[4]; load_q64(qf, qrow, tid);
    PolMoba pol; pol.qpos = qpos; pol.sc2 = 0.125f * LOG2E; pol.sl2 = exp2f(-2.f * (float)(head + 1)) * LOG2E; pol.mask = 1u << own; pol.lim = -1; pol.h4 = 4 * h; pol.base = 0.f;
    float m = -1e30f, l = 0.f; f32x16 o[2]; o[0] = zero16(); o[1] = zero16();
    const bf16_t* kbase = c.P() + (size_t)b * S * PW + C_MBK + head * 64; const bf16_t* vbase = c.P() + (size_t)b * S * PW + C_MBV + head * 64;
    flash_pass<64, true, false>(qf, kbase, PW, vbase, PW, S - 1, 4 * own, 2 * qt + 2, NeedAll(), (q0 + 32 * w + 31) >> 6, pol, m, l, o, c.lds, tid);
    l += __shfl_xor(l, 32);
    const unsigned sel = c.MBSEL()[(size_t)bh * S + qpos];
    const unsigned char* rec0 = c.MBPART() + (size_t)(bh * S + qpos) * 3 * 144;
    float mk[3], lk[3]; float M = m;
#pragma unroll
    for (int k = 0; k < 3; ++k) { const bool on = ((sel >> (8 * k)) & 255u) != 255u; const f32x2 ml = on ? *(const f32x2*)(rec0 + k * 144) : (f32x2){-1e30f, 0.f}; mk[k] = ml[0]; lk[k] = ml[1]; M = fmaxf(M, mk[k]); }
    const float wown = ex2(m - M); float den = l * wown;
#pragma unroll
    for (int i = 0; i < 16; ++i) { o[0][i] *= wown; o[1][i] *= wown; }
#pragma unroll
    for (int k = 0; k < 3; ++k) {
        const float wk = lk[k] * ex2(mk[k] - M); den += wk;
        if (((sel >> (8 * k)) & 255u) != 255u) {
            const bf16_t* ok = (const bf16_t*)(rec0 + k * 144 + 16);
#pragma unroll
            for (int db = 0; db < 2; ++db)
#pragma unroll
                for (int g = 0; g < 4; ++g) { const u32x2 v = *(const u32x2*)(ok + 32 * db + 8 * g + 4 * h);
                    o[db][4 * g] += wk * bflo(v[0]); o[db][4 * g + 1] += wk * bfhi(v[0]); o[db][4 * g + 2] += wk * bflo(v[1]); o[db][4 * g + 3] += wk * bfhi(v[1]); }
        }
    }
    const float inv = 1.f / den;
#pragma unroll
    for (int i = 0; i < 16; ++i) { o[0][i] *= inv; o[1][i] *= inv; }
    write_o(c.OB() + tok * OBW + 256 + head * 64, o, tid);
}
DI void phase_attn_b(const Ctx& c) {
    for (int item = blockIdx.x; item < 1024; item += gridDim.x) { __syncthreads(); moba_own_item(c, (item >> 2) & 3, item & 3, item >> 4); }
}

DI void mla_item(const Ctx& c, int b, int head, int qt) {
    const int tid = opaque_tid(), lane = tid & 63, w = tid >> 6, r = lane & 31, h = lane >> 5;
    const int q0 = 128 * qt, qpos = q0 + 32 * w + r; const size_t tok = (size_t)b * S + qpos;
    const bf16_t* qrow = c.QM() + tok * QMW + head * 96;
    bf16x8 qf[6];
#pragma unroll
    for (int ks = 0; ks < 6; ++ks) qf[ks] = *(const bf16x8*)(qrow + 16 * ks + 8 * h);
    {
        float o1[8], o2[8];
#pragma unroll
        for (int j = 0; j < 8; ++j) { const int i = 8 * h + j; const float fr = ex2(-(float)i * (13.287712379549449f / 16.f)) * 0.15915494309189535f;
            const float tt = (float)qpos * fr; const float ph = tt - floorf(tt); const float sn = __builtin_amdgcn_sinf(ph), cs = __builtin_amdgcn_cosf(ph);
            const float a = bf2f((unsigned short)qf[4][j]), bq = bf2f((unsigned short)qf[5][j]);
            o1[j] = a * cs - bq * sn; o2[j] = a * sn + bq * cs; }
        u32x4 w1v, w2v;
#pragma unroll
        for (int j = 0; j < 4; ++j) { w1v[j] = cvtpk(o1[2 * j], o1[2 * j + 1]); w2v[j] = cvtpk(o2[2 * j], o2[2 * j + 1]); }
        qf[4] = __builtin_bit_cast(bf16x8, w1v); qf[5] = __builtin_bit_cast(bf16x8, w2v);
    }
    PolCausal pol; pol.qpos = qpos; pol.lim = -1; pol.h4 = 4 * h; pol.sc2 = 0.10206207261596577f * LOG2E;
    float m = -1e30f, l = 0.f; f32x16 o[2]; o[0] = zero16(); o[1] = zero16();
    const bf16_t* kbase = c.MK() + (size_t)b * S * MKW + head * 160; const bf16_t* vbase = kbase + 96;
    flash_pass<96, true, MLA_PRE>(qf, kbase, MKW, vbase, MKW, S - 1, 0, 2 * qt + 2, NeedAll(), (q0 + 32 * w + 31) >> 6, pol, m, l, o, c.lds, tid);
    l += __shfl_xor(l, 32);
    const float inv = 1.f / l;
#pragma unroll
    for (int i = 0; i < 16; ++i) { o[0][i] *= inv; o[1][i] *= inv; }
    write_o(c.OB() + tok * OBW + 512 + head * 64, o, tid);
}

DI void mem_item(const Ctx& c, int b, int head, int qt) {
    const int tid = opaque_tid(), lane = tid & 63, w = tid >> 6, r = lane & 31;
    const int q0 = 128 * qt, qpos = q0 + 32 * w + r; const size_t tok = (size_t)b * S + qpos;
    bf16x8 qf[4]; load_q64(qf, c.P() + tok * PW + C_QM + head * 64, tid);
    PolMem pol; pol.sc2 = 0.125f * LOG2E;
    float m = -1e30f, l = 0.f; f32x16 o[2]; o[0] = zero16(); o[1] = zero16();
    const bf16_t* kbase = c.MEMKV() + (size_t)b * 256 * 512 + head * 64; const bf16_t* vbase = kbase + 256;
    flash_pass<64, true, true>(qf, kbase, 512, vbase, 512, 255, 0, 4, NeedAll(), 1 << 30, pol, m, l, o, c.lds, tid);
    l += __shfl_xor(l, 32);
    const float inv = 1.f / l;
#pragma unroll
    for (int i = 0; i < 16; ++i) { o[0][i] *= inv; o[1][i] *= inv; }
    write_o(c.OB() + tok * OBW + 1024 + head * 64, o, tid);
}

DI void nsa_item(const Ctx& c, int b, int qg) {
    const int tid = opaque_tid(), lane = tid & 63, w = tid >> 6, r = lane & 31, h = lane >> 5;
    const int head = w, q0 = 32 * qg, qpos = q0 + r; const size_t tok = (size_t)b * S + qpos;
    constexpr int IP = 130;
    unsigned* imp = (unsigned*)(c.lds + 24576);
    unsigned* selm = (unsigned*)(c.lds + 41216);
    unsigned* uni = (unsigned*)(c.lds + 41728);
    __syncthreads();
    for (int i = tid; i < 32 * IP; i += NTHR) imp[i] = 0u;
    if (tid < 128) selm[tid] = 0u;
    if (tid < 4) uni[tid] = 0u;
    bf16x8 qf[4]; load_q64(qf, c.P() + tok * PW + C_NQ + head * 64, tid);
    const float sc2 = 0.125f * LOG2E, sl2 = exp2f(-2.f * (float)(head + 1)) * LOG2E;
    const bf16_t* grow = c.P() + tok * PW + C_GN + head * 3;
    const float g0 = 1.f / (1.f + ex2(-bf2f(grow[0]) * LOG2E)), g1 = 1.f / (1.f + ex2(-bf2f(grow[1]) * LOG2E)), g2 = 1.f / (1.f + ex2(-bf2f(grow[2]) * LOG2E));
    float* stash0 = (float*)(c.ws() + WS_STASH) + (size_t)blockIdx.x * 8192 + tid * 32;
    const bf16_t* Pb = c.P() + (size_t)b * S * PW;
    const int nct = ((2 * qg) >> 6) + 1;
    const bf16_t* kc = c.KC() + (size_t)b * 512 * 64; const bf16_t* vc = c.KC() + (size_t)2048 * 64 + (size_t)b * 512 * 64;
    float m_c, inv_c;
    {
        PolCmp pol; pol.qpos = qpos; pol.sc2 = sc2; pol.sl2 = sl2; pol.lim = -1; pol.h4 = 4 * h; pol.base = 0.f;
        float m = -1e30f, l = 0.f; f32x16 o[2]; o[0] = zero16(); o[1] = zero16();
        flash_pass<64, false, NSA_PRE>(qf, kc, 64, vc, 64, 510, 0, nct, NeedAll(), 1 << 30, pol, m, l, o, c.lds, tid);
        l += __shfl_xor(l, 32);
        const bool has = m > -0.5e30f;
        inv_c = has ? 1.f / l : 0.f; m_c = m;
        const float f = inv_c * g0;
        __attribute__((address_space(1))) float* stash = (__attribute__((address_space(1))) float*)stash0; asm volatile("" : "+v"(stash));
#pragma unroll
        for (int i = 0; i < 16; ++i) { stash[i] = o[0][i] * f; stash[16 + i] = o[1][i] * f; }
        KVRegs<64> R; kv_load<64>(R, kc, 64, vc, 64, 0, 510, tid);
        for (int t = 0; t < nct; ++t) {
            __syncthreads();
            kv_store<64>(R, c.lds, tid);
            __syncthreads();
            if (t + 1 < nct) kv_load<64>(R, kc, 64, vc, 64, t + 1, 510, tid);
            f32x16 s[2]; qk_tile<64>(s, qf, c.lds, tid); pol.prep(t);
#pragma unroll
            for (int kh = 0; kh < 2; ++kh)
#pragma unroll
                for (int g = 0; g < 4; ++g) {
                    float p4[4];
#pragma unroll
                    for (int e = 0; e < 4; ++e) p4[e] = ex2(pol.score(s[kh][4 * g + e], 32 * kh + 8 * g + e) - m_c) * inv_c;
                    const int sb = 16 * t + 8 * kh + 2 * g + h;
                    const float sum4 = (p4[0] + p4[1]) + (p4[2] + p4[3]);
                    atomicAdd(&imp[r * IP + sb], (unsigned)(sum4 * 268435456.f + 0.5f));
                    if (sb + 1 < 128) atomicAdd(&imp[r * IP + sb + 1], (unsigned)(p4[3] * 268435456.f + 0.5f));
                }
        }
    }
    __syncthreads();
    {
        const int qi = tid >> 3, sub = tid & 7; const int cur = (q0 + qi) >> 6;
        for (int half = 0; half < 2; ++half) {
            unsigned cs[8]; int rank[8];
#pragma unroll
            for (int k = 0; k < 8; ++k) { const int sidx = sub + 8 * (8 * half + k); cs[k] = (sidx == 0 || sidx == cur) ? 0xffffffffu : imp[qi * IP + (sidx & 127)]; rank[k] = 0; }
            if (sub + 64 * half > cur) break;
            for (int sp = 0; sp <= cur; ++sp) {
                const unsigned v = (sp == 0 || sp == cur) ? 0xffffffffu : imp[qi * IP + sp];
#pragma unroll
                for (int k = 0; k < 8; ++k) { const int sidx = sub + 8 * (8 * half + k); rank[k] += (v > cs[k] || (v == cs[k] && sp < sidx)) ? 1 : 0; }
            }
#pragma unroll
            for (int k = 0; k < 8; ++k) { const int sidx = sub + 8 * (8 * half + k);
                if (sidx <= cur && rank[k] < 16) { atomicOr(&selm[qi * 4 + (sidx >> 5)], 1u << (sidx & 31)); atomicOr(&uni[sidx >> 5], 1u << (sidx & 31)); } }
        }
    }
    __syncthreads();
    {
        PolSel pol; pol.qpos = qpos; pol.sc2 = sc2; pol.sl2 = sl2; pol.mlo = (unsigned long long)selm[r * 4] | ((unsigned long long)selm[r * 4 + 1] << 32); pol.mhi = (unsigned long long)selm[r * 4 + 2] | ((unsigned long long)selm[r * 4 + 3] << 32); pol.lim = -1; pol.h4 = 4 * h; pol.base = 0.f;
        NeedBits128 need; need.lo = (unsigned long long)uni[0] | ((unsigned long long)uni[1] << 32); need.hi = (unsigned long long)uni[2] | ((unsigned long long)uni[3] << 32);
        float m = -1e30f, l = 0.f; f32x16 o[2]; o[0] = zero16(); o[1] = zero16();
        flash_pass<64, true, NSA_PRE>(qf, Pb + C_NKV + 128, PW, Pb + C_NKV + 192, PW, S - 1, 0, (q0 >> 6) + 1, need, 1 << 30, pol, m, l, o, c.lds, tid);
        l += __shfl_xor(l, 32);
        const float f = g1 / l;
        __attribute__((address_space(1))) float* stash = (__attribute__((address_space(1))) float*)stash0; asm volatile("" : "+v"(stash));
#pragma unroll
        for (int i = 0; i < 16; ++i) { stash[i] += o[0][i] * f; stash[16 + i] += o[1][i] * f; }
    }
    {
        PolWin pol; pol.qpos = qpos; pol.sc2 = sc2; pol.sl2 = sl2; pol.lim = -1; pol.h4 = 4 * h; pol.base = 0.f;
        const int lo = q0 - 511; const int t_lo = lo > 0 ? (lo >> 6) : 0;
        float m = -1e30f, l = 0.f; f32x16 o[2]; o[0] = zero16(); o[1] = zero16();
        flash_pass<64, true, NSA_PRE>(qf, Pb + C_NKV + 256, PW, Pb + C_NKV + 320, PW, S - 1, t_lo, (q0 >> 6) + 1, NeedAll(), 1 << 30, pol, m, l, o, c.lds, tid);
        l += __shfl_xor(l, 32);
        const float f = g2 / l;
        __attribute__((address_space(1))) float* stash = (__attribute__((address_space(1))) float*)stash0; asm volatile("" : "+v"(stash));
#pragma unroll
        for (int i = 0; i < 16; ++i) { o[0][i] = stash[i] + o[0][i] * f; o[1][i] = stash[16 + i] + o[1][i] * f; }
        write_o(c.OB() + tok * OBW + 768 + head * 64, o, tid);
    }
}

DI void phase_attn(const Ctx& c) {
    unsigned* qhead = c.CTL() + CW_Q + 16 * c.layer + c.qslot;
    volatile int* slot = (volatile int*)(c.lds + 41984);
    int* pre = (int*)(c.lds + LDS_MISC);
    {
        const int tid = opaque_tid();
        __syncthreads();
        if (tid < 64) {
            const unsigned* cnt = c.CTL() + CW_MB + (512 * c.layer + 8 * tid) * 64;
            int loc[8], s = 0;
#pragma unroll
            for (int i = 0; i < 8; ++i) { loc[i] = s; s += ((int)cnt[64 * i] + 127) >> 7; }
            int incl = s;
#pragma unroll
            for (int o = 1; o < 64; o <<= 1) { const int v = __shfl_up(incl, o); if (tid >= o) incl += v; }
            const int excl = incl - s;
#pragma unroll
            for (int i = 0; i < 8; ++i) pre[8 * tid + i] = excl + loc[i];
            if (tid == 63) pre[512] = incl;
        }
        __syncthreads();
    }
    const int nsel = pre[512];
    for (;;) {
        __syncthreads();
        if (threadIdx.x == 0) *slot = (int)__hip_atomic_fetch_add(qhead, 1u, __ATOMIC_RELAXED, __HIP_MEMORY_SCOPE_AGENT);
        __syncthreads();
        const int item = __builtin_amdgcn_readfirstlane(*slot);
        if (item >= 4096 + nsel) break;
        if (item < 1024) { nsa_item(c, item & 3, 255 - (item >> 2)); }
        else if (item < 2048) { const int j = item - 1024; mla_item(c, (j >> 2) & 3, j & 3, 63 - (j >> 4)); }
        else if (item < 2048 + nsel) {
            const int idx = item - 2048; int lo = 0, hi = 511;
            while (lo < hi) { const int mid = (lo + hi + 1) >> 1; if (pre[mid] <= idx) lo = mid; else hi = mid - 1; }
            moba_sel_item(c, lo, idx - pre[lo]);
        }
        else if (item < 3072 + nsel) { const int j = item - 2048 - nsel; mem_item(c, (j >> 2) & 3, j & 3, j >> 4); }
        else { const int j = item - 3072 - nsel; sb_item(c, (j >> 2) & 3, j & 3, j >> 4); }
    }
}

DI void phase_gate(const Ctx& c) {
    const int tid = opaque_tid(), lane = tid & 63, w = tid >> 6, r = lane & 31, h = lane >> 5, wr = w >> 1, wc = w & 1;
    const int srow = tid >> 3, scol = (tid & 7) * 8; const int l = c.layer;
    for (int k = 0;; ++k) {
        int mt, nt; if (!xcd_item(k, 256, 8, mt, nt)) break;
        unsigned mgp[2][2][8];
#pragma unroll
        for (int mi = 0; mi < 2; ++mi)
#pragma unroll
            for (int ni = 0; ni < 2; ++ni)
#pragma unroll
                for (int k = 0; k < 8; ++k) mgp[mi][ni][k] = 0u;
        for (int i = 0; i < 5; ++i) {
            unsigned brp[2][2][8];
            {
                f32x16 br[2][2]; zero_acc(br);
                { int rowE, cbE, cbO; dma_lane(tid, rowE, cbE, cbO);
                  const char* a8 = (const char*)c.OB() + (size_t)(128 * mt + rowE) * OBW + 256 * i;
                  const char* b8 = (const char*)(c.W() + W_BR) + (size_t)i * 1024 * 256 + (size_t)(128 * nt + rowE) * 256;
                  gemm_dma<2, true, NoNext, 122, 123>(br, a8 + cbE, a8 + 8 * OBW + cbO, nullptr, nullptr, 16 * OBW, 128, b8 + cbE, b8 + 8 * 256 + cbO, 16 * 256, 2, c.lds); }
#pragma unroll
                for (int mi = 0; mi < 2; ++mi)
#pragma unroll
                    for (int ni = 0; ni < 2; ++ni)
#pragma unroll
                        for (int k = 0; k < 8; ++k) brp[mi][ni][k] = cvtpk(br[mi][ni][2 * k], br[mi][ni][2 * k + 1]);
            }
            f32x16 ga[2][2]; zero_acc(ga);
            { int rowE, cbE, cbO; dma_lane(tid, rowE, cbE, cbO);
              const char* a8 = (const char*)(c.HB8() + (size_t)(128 * mt + rowE) * 1024);
              const char* b8 = (const char*)(c.W() + W_G) + (size_t)i * 1024 * 1024 + (size_t)(128 * nt + rowE) * 1024;
              gemm_dma<2, true, NoNext, 122, 127>(ga, a8 + cbE, a8 + 8 * 1024 + cbO, nullptr, nullptr, 16 * 1024, 128, b8 + cbE, b8 + 8 * 1024 + cbO, 16 * 1024, 8, c.lds); }
            const float* bg = c.in(15) + ((size_t)l * 5 + i) * 1024 + 128 * nt + 64 * wc + 4 * h;
#pragma unroll
            for (int ni = 0; ni < 2; ++ni)
#pragma unroll
                for (int g = 0; g < 4; ++g) {
                    f32x4 bv = *(const f32x4*)(bg + 32 * ni + 8 * g);
#pragma unroll
                    for (int e = 0; e < 4; ++e) bv[e] *= -LOG2E;
#pragma unroll
                    for (int mi = 0; mi < 2; ++mi)
#pragma unroll
                        for (int e2 = 0; e2 < 2; ++e2) {
                            const float g0 = rcpf_(1.f + ex2(fmaf(ga[mi][ni][4 * g + 2 * e2], -LOG2E, bv[2 * e2])));
                            const float g1 = rcpf_(1.f + ex2(fmaf(ga[mi][ni][4 * g + 2 * e2 + 1], -LOG2E, bv[2 * e2 + 1])));
                            const unsigned pb = brp[mi][ni][2 * g + e2], pm = mgp[mi][ni][2 * g + e2];
                            mgp[mi][ni][2 * g + e2] = cvtpk(bflo(pm) + g0 * bflo(pb), bfhi(pm) + g1 * bfhi(pb));
                        }
                }
        }
        unsigned char* dst = (unsigned char*)c.MG() + (size_t)(128 * mt) * 1024 + 128 * nt;
#pragma unroll
        for (int mi = 0; mi < 2; ++mi)
#pragma unroll
            for (int ni = 0; ni < 2; ++ni)
#pragma unroll
                for (int g = 0; g < 4; g += 2) {
                    const unsigned p0 = mgp[mi][ni][2 * g], p1 = mgp[mi][ni][2 * g + 1], p2 = mgp[mi][ni][2 * g + 2], p3 = mgp[mi][ni][2 * g + 3];
                    store_pair8(dst + (size_t)(64 * wr + 32 * mi + r) * 1024 + 64 * wc + 32 * ni + 8 * g, pk4_fp8(8.f * bflo(p0), 8.f * bfhi(p0), 8.f * bflo(p1), 8.f * bfhi(p1)),
                                pk4_fp8(8.f * bflo(p2), 8.f * bfhi(p2), 8.f * bflo(p3), 8.f * bfhi(p3)), h);
                }
    }
}

DI void phase_out(const Ctx& c) {
    const int tid = opaque_tid(), lane = tid & 63, w = tid >> 6, r = lane & 31, h = lane >> 5, wr = w >> 1, wc = w & 1;
    const int srow = tid >> 3, scol = (tid & 7) * 8;
    bf16_t* yb = c.YB();
    int mt, nt; bool have = xcd_item(0, 256, 8, mt, nt);
    for (int k = 0; have; ++k) {
        int mt2 = 0, nt2 = 0; const bool have2 = xcd_item(k + 1, 256, 8, mt2, nt2);
        f32x16 acc[2][2]; zero_acc(acc);
        { int rowE, cbE, cbO; dma_lane(tid, rowE, cbE, cbO);
          const char* a8 = (const char*)c.MG() + (size_t)(128 * mt + rowE) * 1024;
          const char* b8 = (const char*)(c.W() + W_OUT) + (size_t)(128 * nt + rowE) * 1024;
          const NextSt nx = next_reg((const char*)c.MG() + (size_t)(128 * mt2) * 1024, 1024, (const char*)(c.W() + W_OUT) + (size_t)(128 * nt2) * 1024, 1024, have2, tid);
          gemm_dma<2, true, NextSt, 121, 124>(acc, a8 + cbE, a8 + 8 * 1024 + cbO, nullptr, nullptr, 16 * 1024, 128, b8 + cbE, b8 + 8 * 1024 + cbO, 16 * 1024, 8, c.lds, k ? 8 : 0, nx); }
#pragma unroll
        for (int mi = 0; mi < 2; ++mi)
#pragma unroll
            for (int ni = 0; ni < 2; ++ni)
#pragma unroll
                for (int g = 0; g < 4; g += 2) {
                    const size_t off = (size_t)(128 * mt + 64 * wr + 32 * mi + r) * 1024 + 128 * nt + 64 * wc + 32 * ni + 8 * g;
                    u32x2 oa, ob; oa[0] = cvtpk(acc[mi][ni][4 * g], acc[mi][ni][4 * g + 1]); oa[1] = cvtpk(acc[mi][ni][4 * g + 2], acc[mi][ni][4 * g + 3]);
                    ob[0] = cvtpk(acc[mi][ni][4 * g + 4], acc[mi][ni][4 * g + 5]); ob[1] = cvtpk(acc[mi][ni][4 * g + 6], acc[mi][ni][4 * g + 7]);
                    store_pair16(yb + off, oa, ob, h);
                }
        mt = mt2; nt = nt2; have = have2;
    }
}

template <bool ROUTE> DI void phase_ln(const Ctx& c) {
    const int tid = opaque_tid(), lane = tid & 63, w = tid >> 6; const int l = c.layer;
    float* out = c.outp(); const bf16_t* yb = c.YB();
    const float* hs = (ROUTE && l == 0) ? c.in(0) : out;
    const float* gam = c.in(ROUTE ? 17 : 25) + l * 1024; const float* bet = c.in(ROUTE ? 18 : 26) + l * 1024;
#define LNCOL(j) (4 * lane + 256 * (j))
    f32x4 gv[4], bv[4];
#pragma unroll
    for (int j = 0; j < 4; ++j) { gv[j] = *(const f32x4*)(gam + LNCOL(j)); bv[j] = *(const f32x4*)(bet + LNCOL(j)); }
    constexpr int RB = 4;
    const int gw = blockIdx.x * 4 + w, nw = gridDim.x * 4;
    for (int row0 = gw * RB; row0 < T; row0 += nw * RB) {
        f32x4 x[RB][4];
#pragma unroll
        for (int q = 0; q < RB; ++q)
#pragma unroll
            for (int j = 0; j < 4; ++j) { const size_t o_ = (size_t)(row0 + q) * 1024 + LNCOL(j);
                const u32x2 raw = *(const u32x2*)(yb + o_); const f32x4 h0 = *(const f32x4*)(hs + o_);
                x[q][j][0] = ALPHA * h0[0] + bf_lo(raw[0]); x[q][j][1] = ALPHA * h0[1] + bf_hi(raw[0]); x[q][j][2] = ALPHA * h0[2] + bf_lo(raw[1]); x[q][j][3] = ALPHA * h0[3] + bf_hi(raw[1]); }
        float mean[RB], rs[RB];
#pragma unroll
        for (int q = 0; q < RB; ++q) { float s = 0.f;
#pragma unroll
            for (int j = 0; j < 4; ++j) s += (x[q][j][0] + x[q][j][1]) + (x[q][j][2] + x[q][j][3]);
            mean[q] = s; }
#pragma unroll
        for (int o = 32; o >= 1; o >>= 1)
#pragma unroll
            for (int q = 0; q < RB; ++q) mean[q] += __shfl_xor(mean[q], o);
#pragma unroll
        for (int q = 0; q < RB; ++q) { mean[q] *= (1.f / 1024.f); float v = 0.f;
#pragma unroll
            for (int j = 0; j < 4; ++j)
#pragma unroll
                for (int e = 0; e < 4; ++e) { const float d = x[q][j][e] - mean[q]; v += d * d; }
            rs[q] = v; }
#pragma unroll
        for (int o = 32; o >= 1; o >>= 1)
#pragma unroll
            for (int q = 0; q < RB; ++q) rs[q] += __shfl_xor(rs[q], o);
#pragma unroll
        for (int q = 0; q < RB; ++q) {
            const float r = __builtin_amdgcn_rsqf(rs[q] * (1.f / 1024.f) + 1e-5f); const size_t ro = (size_t)(row0 + q) * 1024;
#pragma unroll
            for (int j = 0; j < 4; ++j) {
#pragma unroll
                for (int e = 0; e < 4; ++e) x[q][j][e] = (x[q][j][e] - mean[q]) * r * gv[j][e] + bv[j][e];
                *(f32x4*)(out + ro + LNCOL(j)) = x[q][j];
                *(unsigned*)(c.HB8() + ro + LNCOL(j)) = pk4_fp8(x[q][j][0], x[q][j][1], x[q][j][2], x[q][j][3]);
            }
        }
        if (ROUTE) {
            const float* wrg = c.in(19) + (size_t)l * 1024 * 4;
            float gl[RB][4];
#pragma unroll
            for (int q = 0; q < RB; ++q)
#pragma unroll
                for (int g = 0; g < 4; ++g) gl[q][g] = 0.f;
#pragma unroll
            for (int j = 0; j < 4; ++j)
#pragma unroll
                for (int e = 0; e < 4; ++e) { const f32x4 wv = *(const f32x4*)(wrg + (size_t)(LNCOL(j) + e) * 4);
#pragma unroll
                    for (int q = 0; q < RB; ++q)
#pragma unroll
                        for (int g = 0; g < 4; ++g) gl[q][g] += x[q][j][e] * wv[g]; }
#pragma unroll
            for (int o = 32; o >= 1; o >>= 1)
#pragma unroll
                for (int q = 0; q < RB; ++q)
#pragma unroll
                    for (int g = 0; g < 4; ++g) gl[q][g] += __shfl_xor(gl[q][g], o);
            int gsel[RB]; float pg_sel[RB];
            const f32x4 brg = *(const f32x4*)(c.in(20) + l * 4);
#pragma unroll
            for (int q = 0; q < RB; ++q) {
#pragma unroll
                for (int g = 0; g < 4; ++g) gl[q][g] += brg[g];
                int gs = 0; float gmax = gl[q][0];
#pragma unroll
                for (int g = 1; g < 4; ++g) if (gl[q][g] > gmax) { gmax = gl[q][g]; gs = g; }
                float gsum = 0.f;
#pragma unroll
                for (int g = 0; g < 4; ++g) gsum += ex2((gl[q][g] - gmax) * LOG2E);
                gsel[q] = gs; pg_sel[q] = rcpf_(gsum);
            }
            float el[RB][4];
#pragma unroll
            for (int q = 0; q < RB; ++q) {
                const float* wre = c.in(21) + ((size_t)l * 4 + gsel[q]) * 1024 * 4;
#pragma unroll
                for (int g = 0; g < 4; ++g) el[q][g] = 0.f;
#pragma unroll
                for (int j = 0; j < 4; ++j)
#pragma unroll
                    for (int e = 0; e < 4; ++e) { const f32x4 wv = *(const f32x4*)(wre + (size_t)(LNCOL(j) + e) * 4);
#pragma unroll
                        for (int g = 0; g < 4; ++g) el[q][g] += x[q][j][e] * wv[g]; }
            }
#pragma unroll
            for (int o = 32; o >= 1; o >>= 1)
#pragma unroll
                for (int q = 0; q < RB; ++q)
#pragma unroll
                    for (int g = 0; g < 4; ++g) el[q][g] += __shfl_xor(el[q][g], o);
            int mybucket = 0; float mywlo = 0.f, mywhi = 0.f;
#pragma unroll
            for (int q = 0; q < RB; ++q) {
                const f32x4 bre = *(const f32x4*)(c.in(22) + (l * 4 + gsel[q]) * 4);
#pragma unroll
                for (int g = 0; g < 4; ++g) el[q][g] += bre[g];
                int e1 = 0; float m1 = el[q][0];
#pragma unroll
                for (int g = 1; g < 4; ++g) if (el[q][g] > m1) { m1 = el[q][g]; e1 = g; }
                int e2 = -1; float m2 = -3e38f;
#pragma unroll
                for (int g = 0; g < 4; ++g) if (g != e1 && el[q][g] > m2) { m2 = el[q][g]; e2 = g; }
                const float p2 = ex2((m2 - m1) * LOG2E);
                const float w1 = pg_sel[q] * rcpf_(1.f + p2), w2 = w1 * p2;
                const int lo = e1 < e2 ? e1 : e2, hi = e1 < e2 ? e2 : e1;
                const float wlo = e1 < e2 ? w1 : w2, whi = e1 < e2 ? w2 : w1;
                const int pidx = lo == 0 ? hi - 1 : (lo == 1 ? hi + 1 : 5);
                if (lane == q) { mybucket = gsel[q] * 6 + pidx; mywlo = wlo; mywhi = whi; }
            }
            if (lane < RB) {
                const unsigned pos = __hip_atomic_fetch_add(c.CTL() + CW_CNT + (32 * l + mybucket) * 64, 1u, __ATOMIC_RELAXED, __HIP_MEMORY_SCOPE_AGENT);
                c.LTOK()[(size_t)mybucket * T + pos] = row0 + lane;
                c.LW()[((size_t)mybucket * T + pos) * 2] = mywlo; c.LW()[((size_t)mybucket * T + pos) * 2 + 1] = mywhi;
            }
        }
    }
}

DI int moe_table(const Ctx& c, int* tab) {
    __syncthreads();
    if (threadIdx.x == 0) { int acc = 0;
        for (int bkt = 0; bkt < 24; ++bkt) { const int n = (int)c.CTL()[CW_CNT + (32 * c.layer + bkt) * 64]; tab[32 + bkt] = n; tab[bkt] = acc; acc += (n + 127) >> 7; }
        tab[24] = acc; }
    __syncthreads();
    return tab[24];
}
DI void moe_decode(const int* tab, int rt, int& bkt, int& r0, int& nvalid, int& elo, int& ehi) {
    int bk = 0;
    for (int i = 0; i < 24; ++i) if (tab[i] <= rt && rt < tab[i + 1]) bk = i;
    bkt = bk; r0 = 128 * (rt - tab[bk]); const int n = tab[32 + bk] - r0; nvalid = n < 128 ? n : 128;
    const int g = bk / 6, pidx = bk % 6;
    const int lo = pidx < 3 ? 0 : (pidx < 5 ? 1 : 2), hi = pidx < 3 ? pidx + 1 : (pidx < 5 ? pidx - 1 : 3);
    elo = g * 4 + lo; ehi = g * 4 + hi;
}
DI void phase_moe_up(const Ctx& c) {
    const int tid = opaque_tid(), lane = tid & 63, w = tid >> 6, r = lane & 31, h = lane >> 5, wr = w >> 1, wc = w & 1;
    const int srow = tid >> 3, scol = (tid & 7) * 8;
    int* tab = (int*)(c.lds + LDS_MISC + 1024);
    const int RT = moe_table(c, tab);
    for (int k = 0;; ++k) {
        int rt, ct; if (!xcd_item(k, RT, 8, rt, ct)) break;
        if (rt >= RT) continue;
        const int es = ct >> 2, q4 = ct & 3;
        int bkt, r0, nvalid, elo, ehi; moe_decode(tab, rt, bkt, r0, nvalid, elo, ehi);
        const int* ltok = c.LTOK() + (size_t)bkt * T + r0;
        int rowE, cbE, cbO; dma_lane(tid, rowE, cbE, cbO);
        const char* ap[4];
#pragma unroll
        for (int i = 0; i < 4; ++i) { int lr = rowE + 8 * i; lr = lr < nvalid ? lr : nvalid - 1; ap[i] = (const char*)(c.HB8() + (size_t)ltok[lr] * 1024) + ((i & 1) ? cbO : cbE); }
        const int e = es ? ehi : elo;
        f32x16 acc[2][2]; zero_acc(acc);
        const char* bp = (const char*)(c.W() + W_UP) + (size_t)e * 512 * 1024 + (size_t)(128 * q4 + rowE) * 1024;
        gemm_dma<2, false, NoNext, 122, 127>(acc, ap[0], ap[1], ap[2], ap[3], 0, 128, bp + cbE, bp + 8 * 1024 + cbO, 16 * 1024, 8, c.lds);
        const float* lw = c.LW() + ((size_t)bkt * T + r0) * 2 + es;
#pragma unroll
        for (int mi = 0; mi < 2; ++mi) {
            int lr = 64 * wr + 32 * mi + r; const int lrc = lr < nvalid ? lr : nvalid - 1;
            const float wt = lw[(size_t)lrc * 2];
            unsigned char* dst = (unsigned char*)c.ACT() + (size_t)(128 * rt + lr) * 512 + es * 256 + 32 * (2 * q4 + wc);
#pragma unroll
            for (int g = 0; g < 4; g += 2) { unsigned pk[2];
#pragma unroll
                for (int gg = 0; gg < 2; ++gg) { float o4[4];
#pragma unroll
                    for (int e4 = 0; e4 < 4; ++e4) { const float a = acc[mi][0][4 * (g + gg) + e4], u = acc[mi][1][4 * (g + gg) + e4]; o4[e4] = a * rcpf_(1.f + ex2(a * -LOG2E)) * u * wt; }
                    pk[gg] = pk4_fp8(16.f * o4[0], 16.f * o4[1], 16.f * o4[2], 16.f * o4[3]); }
                store_pair8(dst + 8 * g, pk[0], pk[1], h); }
        }
    }
}
DI void phase_moe_down(const Ctx& c) {
    const int tid = opaque_tid(), lane = tid & 63, w = tid >> 6, r = lane & 31, h = lane >> 5, wr = w >> 1, wc = w & 1;
    const int srow = tid >> 3, scol = (tid & 7) * 8;
    int* tab = (int*)(c.lds + LDS_MISC + 1024);
    const int RT = moe_table(c, tab);
    bf16_t* yb = c.YB();
    for (int k = 0;; ++k) {
        int rt, nt; if (!xcd_item(k, RT, 8, rt, nt)) break;
        if (rt >= RT) continue;
        int bkt, r0, nvalid, elo, ehi; moe_decode(tab, rt, bkt, r0, nvalid, elo, ehi);
        const int* ltok = c.LTOK() + (size_t)bkt * T + r0;
        f32x16 acc[2][2]; zero_acc(acc);
        for (int es = 0; es < 2; ++es) {
          int rowE, cbE, cbO; dma_lane(opaque_tid(), rowE, cbE, cbO);
          const char* a8 = (const char*)c.ACT() + (size_t)(128 * rt + rowE) * 512 + 256 * es;
          const char* b8 = (const char*)(c.W() + W_DN) + (size_t)(es ? ehi : elo) * 1024 * 256 + (size_t)(128 * nt + rowE) * 256;
          gemm_dma<2, true, NoNext, 122, 123>(acc, a8 + cbE, a8 + 8 * 512 + cbO, nullptr, nullptr, 16 * 512, 128, b8 + cbE, b8 + 8 * 256 + cbO, 16 * 256, 2, c.lds); }
#pragma unroll
        for (int mi = 0; mi < 2; ++mi) {
            const int lr = 64 * wr + 32 * mi + r;
            if (lr < nvalid) {
                const size_t tok = (size_t)ltok[lr];
#pragma unroll
                for (int ni = 0; ni < 2; ++ni)
#pragma unroll
                    for (int g = 0; g < 4; g += 2) {
                        const size_t off = tok * 1024 + 128 * nt + 64 * wc + 32 * ni + 8 * g;
                        u32x2 oa, ob; oa[0] = cvtpk(acc[mi][ni][4 * g], acc[mi][ni][4 * g + 1]); oa[1] = cvtpk(acc[mi][ni][4 * g + 2], acc[mi][ni][4 * g + 3]);
                        ob[0] = cvtpk(acc[mi][ni][4 * g + 4], acc[mi][ni][4 * g + 5]); ob[1] = cvtpk(acc[mi][ni][4 * g + 6], acc[mi][ni][4 * g + 7]);
                        store_pair16(yb + off, oa, ob, h);
                    }
            }
        }
    }
}


#define XB_TMO      128
#define XB_XCNT(j)  (256  + 64 * (j))
#define XB_XSUB(j)  (1280 + 64 * (j))
#define XB_XGEN(j)  (2304 + 64 * (j))
#define XB_TOP      3328
#define XB_TOPGEN   3392
#define XCD_BAR_WORDS 3456
#define XB_SPIN_CAP (1u << 18)

__device__ __forceinline__ unsigned xb_ld(unsigned* p)              { return __hip_atomic_load(p, __ATOMIC_RELAXED, __HIP_MEMORY_SCOPE_AGENT); }
__device__ __forceinline__ unsigned xb_add(unsigned* p, unsigned v) { return __hip_atomic_fetch_add(p, v, __ATOMIC_RELAXED, __HIP_MEMORY_SCOPE_AGENT); }
__device__ __forceinline__ unsigned xb_xcc_id() { return (unsigned)__builtin_amdgcn_s_getreg((3 << 11) | 20) & 0xFu; }
#define XB_SPIN(cond, bar) do { unsigned _sp = 0; while (cond) { __builtin_amdgcn_s_sleep(1); \
    if ((++_sp & 255u) == 0u) { if (xb_ld(&(bar)[XB_TMO])) break; if (_sp > XB_SPIN_CAP) { atomicAdd(&(bar)[XB_TMO], 1u); break; } } } } while (0)

struct XcdBarrier {
    unsigned* bar; unsigned x;
    volatile LAS unsigned* st;
};

__device__ __forceinline__ XcdBarrier xcd_barrier_post(unsigned* bar, volatile LAS unsigned* st) {
    XcdBarrier b; b.bar = bar; b.x = xb_xcc_id(); b.st = st;
    if (threadIdx.x == 0) (void)xb_add(&bar[XB_XCNT(b.x)], 1u);
    return b;
}
__device__ __forceinline__ void xcd_barrier_complete(unsigned* bar, unsigned x, unsigned& nloc, unsigned& nx) {
    const unsigned G = gridDim.x * gridDim.y * gridDim.z;
    unsigned sum, cnt, mine, sp = 0u;
    for (;;) {
        sum = 0u; cnt = 0u; mine = 0u;
#pragma unroll
        for (unsigned j = 0; j < 16; ++j) { const unsigned c = xb_ld(&bar[XB_XCNT(j)]); sum += c; cnt += (c > 0u) ? 1u : 0u; mine = (j == x) ? c : mine; }
        if (sum == G) break;
        __builtin_amdgcn_s_sleep(1);
        if ((++sp & 255u) == 0u) { if (xb_ld(&bar[XB_TMO])) break; if (sp > XB_SPIN_CAP) { atomicAdd(&bar[XB_TMO], 1u); break; } }
    }
    nloc = mine > 0u ? mine : 1u; nx = cnt > 0u ? cnt : 1u;
}

__device__ __forceinline__ void xcd_barrier(const XcdBarrier& b) {
    asm volatile("s_waitcnt vmcnt(0)" ::: "memory");
    __syncthreads();
    if (threadIdx.x == 0) {
        unsigned* bar = b.bar; asm volatile("" : "+s"(bar)); unsigned bx = b.x; asm volatile("" : "+s"(bx));
        __builtin_amdgcn_s_waitcnt(0);
        unsigned nloc = b.st[0], nx = b.st[1];
        if (nloc == 0u) { xcd_barrier_complete(bar, bx, nloc, nx); b.st[0] = nloc; b.st[1] = nx; }
        const unsigned old = xb_add(&bar[XB_XSUB(bx)], 1u);
        const unsigned gen = old / nloc;
        if (old + 1u == (gen + 1u) * nloc) {
            __builtin_amdgcn_fence(__ATOMIC_RELEASE, "agent");
            asm volatile("s_waitcnt vmcnt(0)" ::: "memory");
            const unsigned og = xb_add(&bar[XB_TOP], 1u);
            const unsigned tg = og / nx;
            if (og + 1u == (tg + 1u) * nx) xb_add(&bar[XB_TOPGEN], 1u);
            else XB_SPIN(xb_ld(&bar[XB_TOPGEN]) == tg, bar);
            __builtin_amdgcn_fence(__ATOMIC_ACQUIRE, "agent");
            xb_add(&bar[XB_XGEN(bx)], 1u);
            asm volatile("s_waitcnt vmcnt(0)" ::: "memory");
        } else {
            XB_SPIN(xb_ld(&bar[XB_XGEN(bx)]) == gen, bar);
            __builtin_amdgcn_fence(__ATOMIC_ACQUIRE, "agent");
            asm volatile("s_waitcnt vmcnt(0)" ::: "memory");
        }
    }
    __syncthreads();
}

enum { PH_PRO = 0, PH_W, PH_PROJ, PH_PREP1, PH_PREP2, PH_ATTN, PH_GATE, PH_OUT, PH_LN1, PH_MUP, PH_MDN, PH_LN2, PH_SEL, PH_ATTNB };
template <int PH> DI void run_phase(const Ctx& c0) {
    Ctx c = c0; { const __attribute__((address_space(4))) char* k = (const __attribute__((address_space(4))) char*)__builtin_amdgcn_kernarg_segment_ptr(); asm volatile("" : "+s"(k)); c.ka = k;
                  __attribute__((address_space(1))) unsigned char* w = *(__attribute__((address_space(1))) unsigned char* const __attribute__((address_space(4)))*)(k + 224); asm volatile("" : "+s"(w)); c.wsp = (unsigned char*)w; }
    if (PH == PH_PRO) phase_prologue(c);
    else if (PH == PH_W) phase_weights(c);
    else if (PH == PH_PROJ) phase_proj(c);
    else if (PH == PH_PREP1) phase_prep1(c);
    else if (PH == PH_PREP2) phase_prep2(c);
    else if (PH == PH_ATTN) phase_attn(c);
    else if (PH == PH_GATE) phase_gate(c);
    else if (PH == PH_OUT) phase_out(c);
    else if (PH == PH_LN1) phase_ln<true>(c);
    else if (PH == PH_MUP) phase_moe_up(c);
    else if (PH == PH_MDN) phase_moe_down(c);
    else if (PH == PH_LN2) phase_ln<false>(c);
    else if (PH == PH_ATTNB) phase_attn_b(c);
}
extern __shared__ __attribute__((aligned(16))) char dyn_lds[];
template <int PH> __global__ void __launch_bounds__(NTHR, 2) k_phase(Params p, int layer) {
    Ctx c; c.p = &p; c.layer = layer & 255; c.qslot = layer >> 8; c.lds = dyn_lds; c.wsp = p.ws; c.ka = (const __attribute__((address_space(4))) char*)__builtin_amdgcn_kernarg_segment_ptr();
    run_phase<PH>(c);
}

__global__ void __launch_bounds__(NTHR, 2) k_mega(Params p) {
    Ctx c; c.p = &p; c.layer = 0; c.qslot = 0; c.lds = dyn_lds; c.wsp = p.ws; c.ka = (const __attribute__((address_space(4))) char*)__builtin_amdgcn_kernarg_segment_ptr();
    volatile LAS unsigned* st = (volatile LAS unsigned*)(LAS char*)(dyn_lds + LDS_BYTES - 16);
    if (threadIdx.x == 0) { st[0] = 0u; st[1] = 0u; st[2] = 0u; st[3] = 0u; }
    __syncthreads();
    const XcdBarrier bar = xcd_barrier_post(c.CTL() + CW_BAR, st);
    run_phase<PH_PRO>(c);
    run_phase<PH_W>(c);
    xcd_barrier(bar);
    for (int l = 0; l < NL; ++l) {
        c.layer = l;
        run_phase<PH_PROJ>(c); xcd_barrier(bar);
        run_phase<PH_PREP1>(c); xcd_barrier(bar);
        run_phase<PH_ATTN>(c); xcd_barrier(bar);
        run_phase<PH_ATTNB>(c); xcd_barrier(bar);
        run_phase<PH_GATE>(c); xcd_barrier(bar);
        run_phase<PH_OUT>(c); xcd_barrier(bar);
        run_phase<PH_LN1>(c); xcd_barrier(bar);
        run_phase<PH_MUP>(c); xcd_barrier(bar);
        run_phase<PH_MDN>(c); xcd_barrier(bar);
        run_phase<PH_LN2>(c);
        if (l + 1 < NL) { c.layer = l + 1; run_phase<PH_W>(c); }
        xcd_barrier(bar);
    }
}

extern "C" void kernel_launch(void* const* d_in, const int* in_sizes, int n_in, void* d_out, int out_size, void* d_ws, size_t ws_size, hipStream_t stream) {
    Params p{};
    for (int i = 0; i < 27; ++i) p.in[i] = (const float*)d_in[i];
    p.out = (float*)d_out; p.ws = (unsigned char*)d_ws;
    (void)hipMemsetAsync(d_ws, 0, 786432, stream);
#if N_LAUNCH_MODE == 1
    static int grid = 0;
    if (!grid) {
        int dev = 0, cus = 0, per_cu = 0;
        (void)hipGetDevice(&dev);
        (void)hipDeviceGetAttribute(&cus, hipDeviceAttributeMultiprocessorCount, dev);
        (void)hipFuncSetAttribute((const void*)k_mega, hipFuncAttributeMaxDynamicSharedMemorySize, LDS_BYTES);
        (void)hipOccupancyMaxActiveBlocksPerMultiprocessor(&per_cu, k_mega, NTHR, LDS_BYTES);
        if (per_cu > 2) per_cu = 2;
        if (per_cu < 1) per_cu = 1;
        grid = cus * per_cu;
        if (grid > 512) grid = 512;
    }
    hipLaunchKernelGGL(k_mega, dim3(grid), dim3(NTHR), LDS_BYTES, stream, p);
#else
    const int grid = 512;
#define LAUNCH(PH, L) hipLaunchKernelGGL((k_phase<PH>), dim3(grid), dim3(NTHR), LDS_BYTES, stream, p, (L))
    LAUNCH(PH_PRO, 0);
    for (int l = 0; l < NL; ++l) {
#ifndef PROBE_DUP
#define PROBE_DUP -1
#endif
#define LAUNCH2(PH, L) do { LAUNCH(PH, L); if (PROBE_DUP == PH) LAUNCH(PH, (L) | 256); } while (0)
        LAUNCH2(PH_W, l); LAUNCH2(PH_PROJ, l); LAUNCH2(PH_PREP1, l); LAUNCH2(PH_ATTN, l); LAUNCH(PH_ATTNB, l); LAUNCH2(PH_GATE, l);
        LAUNCH(PH_OUT, l); LAUNCH(PH_LN1, l); LAUNCH2(PH_MUP, l); LAUNCH(PH_MDN, l); LAUNCH(PH_LN2, l);
    }
#endif
}
```

```cpp
#include <hip/hip_runtime.h>
#include <stdint.h>

#ifndef N_LAUNCH_MODE
#define N_LAUNCH_MODE 1
#endif

typedef unsigned short bf16_t;
typedef short bf16x8 __attribute__((ext_vector_type(8)));
typedef short s16x4 __attribute__((ext_vector_type(4)));
typedef short v4i16_t __attribute__((ext_vector_type(4)));
typedef float f32x16 __attribute__((ext_vector_type(16)));
typedef float f32x4 __attribute__((ext_vector_type(4)));
typedef float f32x2 __attribute__((ext_vector_type(2)));
typedef unsigned u32x4 __attribute__((ext_vector_type(4)));
typedef unsigned u32x2 __attribute__((ext_vector_type(2)));
typedef __bf16 bf16x2_t __attribute__((ext_vector_type(2)));
#define LAS __attribute__((address_space(3)))
#define DI __device__ __forceinline__

constexpr int NB = 4, S = 8192, DM = 1024, NL = 4, T = NB * S;
constexpr int PW = 2944;
constexpr int C_SBQ = 0, C_SBK = 256, C_SBV = 512, C_MBQ = 768, C_MBK = 1024, C_MBV = 1280, C_CQ = 1536, C_CKV = 1792, C_KR = 1920,
              C_NQ = 1952, C_NKV = 2208, C_QM = 2592, C_GN = 2848;
constexpr int OBW = 1280;
constexpr int QMW = 384, MKW = 640;
constexpr float LOG2E = 1.4426950408889634f, LN2 = 0.6931471805599453f;
constexpr float ALPHA = 1.681792830507429f;
constexpr int NTHR = 256;
constexpr int LDS_BYTES = 69632;
constexpr int LDS_MISC = 65536;

constexpr size_t W_IN = 0, W_UQ = W_IN + (size_t)PW * 1024, W_UKV = W_UQ + 384 * 256, W_PHI1 = W_UKV + 512 * 128, W_PHI2 = W_PHI1 + 2 * 128 * 2048,
                 W_MEM = W_PHI2 + 2 * 128 * 128, W_BR = W_MEM + 512 * 1024, W_G = W_BR + 5 * 1024 * 256, W_OUT = W_G + 5 * 1024 * 1024,
                 W_UP = W_OUT + 1024 * 1024, W_DN = W_UP + 16 * 512 * 1024, W_END = W_DN + 16 * 1024 * 256;

constexpr size_t MiB = 1u << 20;
constexpr size_t WS_CTL = 0;
constexpr size_t WS_HB = 1 * MiB;
constexpr size_t WS_P = WS_HB + 64 * MiB;
constexpr size_t WS_MG = WS_P;
constexpr size_t WS_ACT = WS_P + 64 * MiB;
constexpr size_t WS_OB = WS_P + 184 * MiB;
constexpr size_t WS_QM = WS_OB + 80 * MiB;
constexpr size_t WS_MK = WS_QM + 24 * MiB;
constexpr size_t WS_W = WS_MK + 40 * MiB;
constexpr size_t WS_MEMB = WS_W + 47 * MiB;
constexpr size_t WS_MEMKV = WS_MEMB + 2 * MiB;
constexpr size_t WS_HC = WS_MEMKV + 1 * MiB;
constexpr size_t WS_KC = WS_HC + 1 * MiB;
constexpr size_t WS_KMEAN = WS_KC + 1 * MiB;
constexpr size_t WS_CPART = WS_KMEAN + 1 * MiB;
constexpr size_t WS_LTOK = WS_CPART + 1 * MiB;
constexpr size_t WS_LW = WS_LTOK + 3 * MiB;
constexpr size_t WS_STASH = WS_LW + 6 * MiB;
constexpr size_t WS_HB8 = WS_STASH + 16 * MiB;
constexpr size_t WS_END = WS_HB8 + 32 * MiB;
static_assert(WS_END <= 508 * MiB, "workspace map");
static_assert(W_END * 2 <= 47 * MiB, "weights");
constexpr int CW_Q = 64;
constexpr int CW_CNT = 20480;
constexpr int CW_BAR = 1024;
constexpr int CW_MB = 32768;

struct Params { const float* in[27]; float* out; unsigned char* ws; };

DI unsigned cvtpk(float lo, float hi) { f32x2 v = {lo, hi}; bf16x2_t b = __builtin_convertvector(v, bf16x2_t); return __builtin_bit_cast(unsigned, b); }
DI float bf2f(unsigned short x) { return __builtin_bit_cast(float, (unsigned)x << 16); }
DI float bflo(unsigned u) { return __builtin_bit_cast(float, u << 16); }
DI float bfhi(unsigned u) { return __builtin_bit_cast(float, u & 0xffff0000u); }
DI unsigned pk4_fp8(float a, float b, float c, float d) { int v = 0;
    a = __builtin_amdgcn_fmed3f(a, -448.f, 448.f); b = __builtin_amdgcn_fmed3f(b, -448.f, 448.f); c = __builtin_amdgcn_fmed3f(c, -448.f, 448.f); d = __builtin_amdgcn_fmed3f(d, -448.f, 448.f); v = __builtin_amdgcn_cvt_pk_fp8_f32(a, b, v, false); v = __builtin_amdgcn_cvt_pk_fp8_f32(c, d, v, true); return (unsigned)v; }
DI f32x16 mfma(bf16x8 a, bf16x8 b, f32x16 c) { return __builtin_amdgcn_mfma_f32_32x32x16_bf16(a, b, c, 0, 0, 0); }
DI float ex2(float x) { return __builtin_amdgcn_exp2f(x); }
DI float rcpf_(float x) { return __builtin_amdgcn_rcpf(x); }
DI float lg2(float x) { return __builtin_amdgcn_logf(x); }
DI float wave_sum(float v) {
#pragma unroll
    for (int o = 32; o >= 1; o >>= 1) v += __shfl_xor(v, o);
    return v;
}
DI s16x4 vtr(const bf16_t* p) { return __builtin_bit_cast(s16x4, __builtin_amdgcn_ds_read_tr16_b64_v4i16((LAS v4i16_t*)(LAS char*)(p))); }
DI int opaque_tid() { int t = threadIdx.x; asm volatile("" : "+v"(t)); return t; }
DI f32x16 zero16() { f32x16 z;
#pragma unroll
    for (int i = 0; i < 16; ++i) z[i] = 0.f; return z; }

constexpr int NST = 2, STAGE_B = 32768;
DI void glds16(const void* gsrc, unsigned lds_dst) { unsigned keep;
    asm volatile("s_mov_b32 %0, m0\n\ts_mov_b32 m0, %2\n\ts_nop 0\n\tglobal_load_lds_dwordx4 %1, off\n\ts_mov_b32 m0, %0" : "=&s"(keep) : "v"(gsrc), "s"(lds_dst) : "memory"); }
#define WAIT_V(n) asm volatile("s_waitcnt vmcnt(" #n ")" ::: "memory")
DI void dma_lane(int tid, int& rowE, int& cbE, int& cbO) { const int lane = tid & 63, w = tid >> 6; rowE = 32 * w + (lane >> 3);
    cbE = 16 * ((lane & 7) ^ (lane >> 4)); cbO = 16 * ((lane & 7) ^ (4 + (lane >> 4))); }
struct NoNext { static constexpr bool ON = false; DI void operator()(unsigned, unsigned) const {} };
struct NextSt { static constexpr bool ON = true; const char *aE, *aO, *aE2, *aO2, *bE, *bO; size_t b16; bool on;
    DI void operator()(unsigned dstA, unsigned dstB) const;
};
template <int F8, bool AREG, class NX = NoNext, int SCA = 127, int SCB = 127>
DI void gemm_dma(f32x16 (&acc)[2][2], const char* aE, const char* aO, const char* aE2, const char* aO2, size_t a16, size_t astride,
                 const char* bE, const char* bO, size_t b16, int nst, char* lds, int pv = 0, NX nx = NX()) {
    const int tid = opaque_tid(), lane = tid & 63, w = tid >> 6, r = lane & 31, h = lane >> 5, wr = w >> 1, wc = w & 1;
    const unsigned lbase = (unsigned)(size_t)(LAS char*)lds;
    const unsigned dstA = (unsigned)__builtin_amdgcn_readfirstlane((int)(lbase + 4096u * (unsigned)w));
    const unsigned dstB = dstA + 16384u;
    if (AREG) { aE2 = aE + a16; aO2 = aO + a16; }
    const char* bE2 = bE + b16; const char* bO2 = bO + b16;
#define GD_STAGE(t) do { const int t_ = (t); const size_t ao_ = (size_t)t_ * astride, bo_ = (size_t)t_ * 128; \
        const unsigned so_ = (unsigned)(t_ & (NST - 1)) * (unsigned)STAGE_B; \
        if (!(pv & 2)) { glds16(aE + ao_, dstA + so_); glds16(aO + ao_, dstA + so_ + 1024u); glds16(aE2 + ao_, dstA + so_ + 2048u); glds16(aO2 + ao_, dstA + so_ + 3072u); \
                         glds16(bE + bo_, dstB + so_); glds16(bO + bo_, dstB + so_ + 1024u); glds16(bE2 + bo_, dstB + so_ + 2048u); glds16(bO2 + bo_, dstB + so_ + 3072u); } } while (0)
    if (!(pv & 8)) {
    WAIT_V(0);
    __builtin_amdgcn_s_barrier();
    GD_STAGE(0);
    }
    const int sw = (r >> 1) & 7;
    const char* fa = lds + (64 * wr + r) * 128;
    const char* fb = lds + 16384 + (64 * wc + r) * 128;
    for (int t = 0; t < nst; ++t) {
        WAIT_V(0);
        __builtin_amdgcn_s_barrier();
        asm volatile("" ::: "memory");
        __builtin_amdgcn_s_setprio(2);
        if (t + 1 < nst) GD_STAGE(t + 1);
        else if (NX::ON) nx(dstA, dstB);
        __builtin_amdgcn_s_setprio(0);
        const char* sa = fa + (t & (NST - 1)) * STAGE_B; const char* sb = fb + (t & (NST - 1)) * STAGE_B;
        if (F8 == 1) {
#pragma unroll
            for (int ks = 0; ks < 8; ++ks) {
                const int co = ((ks ^ sw) << 4) + 8 * h;
                const long fa0 = *(const long*)(sa + co), fa1 = *(const long*)(sa + 32 * 128 + co);
                const long fb0 = *(const long*)(sb + co), fb1 = *(const long*)(sb + 32 * 128 + co);
                acc[0][0] = __builtin_amdgcn_mfma_f32_32x32x16_fp8_fp8(fb0, fa0, acc[0][0], 0, 0, 0); acc[0][1] = __builtin_amdgcn_mfma_f32_32x32x16_fp8_fp8(fb1, fa0, acc[0][1], 0, 0, 0);
                acc[1][0] = __builtin_amdgcn_mfma_f32_32x32x16_fp8_fp8(fb0, fa1, acc[1][0], 0, 0, 0); acc[1][1] = __builtin_amdgcn_mfma_f32_32x32x16_fp8_fp8(fb1, fa1, acc[1][1], 0, 0, 0);
            }
        } else if (F8 == 2) {
#pragma unroll
            for (int ks = 0; ks < 2; ++ks) {
                const int c0 = ((4 * ks + 2 * h) ^ sw) << 4, c1 = ((4 * ks + 2 * h + 1) ^ sw) << 4;
                typedef int i32x4 __attribute__((ext_vector_type(4))); typedef int i32x8 __attribute__((ext_vector_type(8)));
                const i32x4 a0l = *(const i32x4*)(sa + c0), a0h = *(const i32x4*)(sa + c1), a1l = *(const i32x4*)(sa + 32 * 128 + c0), a1h = *(const i32x4*)(sa + 32 * 128 + c1);
                const i32x4 b0l = *(const i32x4*)(sb + c0), b0h = *(const i32x4*)(sb + c1), b1l = *(const i32x4*)(sb + 32 * 128 + c0), b1h = *(const i32x4*)(sb + 32 * 128 + c1);
                const i32x8 fa0 = __builtin_shufflevector(a0l, a0h, 0, 1, 2, 3, 4, 5, 6, 7), fa1 = __builtin_shufflevector(a1l, a1h, 0, 1, 2, 3, 4, 5, 6, 7);
                const i32x8 fb0 = __builtin_shufflevector(b0l, b0h, 0, 1, 2, 3, 4, 5, 6, 7), fb1 = __builtin_shufflevector(b1l, b1h, 0, 1, 2, 3, 4, 5, 6, 7);
                acc[0][0] = __builtin_amdgcn_mfma_scale_f32_32x32x64_f8f6f4(fb0, fa0, acc[0][0], 0, 0, 0, SCA, 0, SCB); acc[0][1] = __builtin_amdgcn_mfma_scale_f32_32x32x64_f8f6f4(fb1, fa0, acc[0][1], 0, 0, 0, SCA, 0, SCB);
                acc[1][0] = __builtin_amdgcn_mfma_scale_f32_32x32x64_f8f6f4(fb0, fa1, acc[1][0], 0, 0, 0, SCA, 0, SCB); acc[1][1] = __builtin_amdgcn_mfma_scale_f32_32x32x64_f8f6f4(fb1, fa1, acc[1][1], 0, 0, 0, SCA, 0, SCB);
            }
        } else {
#pragma unroll
            for (int ks = 0; ks < 4; ++ks) {
                const int co = ((2 * ks + h) ^ sw) << 4;
                if (pv & 4) continue;
                const bf16x8 fa0 = *(const bf16x8*)(sa + co), fa1 = *(const bf16x8*)(sa + 32 * 128 + co);
                const bf16x8 fb0 = *(const bf16x8*)(sb + co), fb1 = *(const bf16x8*)(sb + 32 * 128 + co);
                if (pv & 1) { asm volatile("" :: "v"(fa0), "v"(fa1), "v"(fb0), "v"(fb1)); continue; }
                acc[0][0] = mfma(fb0, fa0, acc[0][0]); acc[0][1] = mfma(fb1, fa0, acc[0][1]);
                acc[1][0] = mfma(fb0, fa1, acc[1][0]); acc[1][1] = mfma(fb1, fa1, acc[1][1]);
            }
        }
    }
#undef GD_STAGE
}
DI void NextSt::operator()(unsigned dstA, unsigned dstB) const {
    if (on) { glds16(aE, dstA); glds16(aO, dstA + 1024u); glds16(aE2, dstA + 2048u); glds16(aO2, dstA + 3072u);
              glds16(bE, dstB); glds16(bO, dstB + 1024u); glds16(bE + b16, dstB + 2048u); glds16(bO + b16, dstB + 3072u); }
}
DI NextSt next_reg(const void* A0, size_t pa, const void* B0, size_t pb, bool on, int tid) {
    int rowE, cbE, cbO; dma_lane(tid, rowE, cbE, cbO);
    const char* aE = (const char*)A0 + (size_t)rowE * pa; const char* bE = (const char*)B0 + (size_t)rowE * pb;
    NextSt n; n.aE = aE + cbE; n.aO = aE + 8 * pa + cbO; n.aE2 = n.aE + 16 * pa; n.aO2 = n.aO + 16 * pa; n.bE = bE + cbE; n.bO = bE + 8 * pb + cbO; n.b16 = 16 * pb; n.on = on;
    return n;
}
template <class NX = NoNext>
DI void gemm_reg(f32x16 (&acc)[2][2], const bf16_t* A, size_t lda, const bf16_t* B, size_t ldb, int K, char* lds, int pv = 0, NX nx = NX()) {
    int rowE, cbE, cbO; dma_lane(opaque_tid(), rowE, cbE, cbO);
    const char* aE = (const char*)(A + (size_t)rowE * lda); const char* bE = (const char*)(B + (size_t)rowE * ldb);
    gemm_dma<0, true, NX>(acc, aE + cbE, aE + 16 * lda + cbO, nullptr, nullptr, 32 * lda, 128, bE + cbE, bE + 16 * ldb + cbO, 32 * ldb, K / 64, lds, pv, nx);
}
DI float bf_lo(unsigned u) { return __uint_as_float(u << 16); }
DI float bf_hi(unsigned u) { return __uint_as_float(u & 0xffff0000u); }
DI void zero_acc(f32x16 (&acc)[2][2]) { acc[0][0] = zero16(); acc[0][1] = zero16(); acc[1][0] = zero16(); acc[1][1] = zero16(); }

constexpr int VP = 72;
#ifndef NSA_PRE
#define NSA_PRE false
#endif
#ifndef MLA_PRE
#define MLA_PRE false
#endif
#ifndef MOBA_PRE
#define MOBA_PRE false
#endif
DI u32x4 ldg16(const void* p) { return *(const __attribute__((address_space(1))) u32x4*)p; }
template <int DQK> struct KVRegs { u32x4 k[DQK / 32]; u32x4 v[2]; };
template <int DQK> DI void kv_load(KVRegs<DQK>& R, const bf16_t* kbase, size_t kpitch, const bf16_t* vbase, size_t vpitch, int t, int keymax, int tid) {
    int key = 64 * t + (tid >> 2); key = key > keymax ? keymax : key;
    const __amdgpu_buffer_rsrc_t rk = __builtin_amdgcn_make_buffer_rsrc((void*)kbase, 0, 0x7fffffff, 0x00020000);
    const __amdgpu_buffer_rsrc_t rv = __builtin_amdgcn_make_buffer_rsrc((void*)vbase, 0, 0x7fffffff, 0x00020000);
    const int vk = key * (int)(kpitch * 2) + (tid & 3) * (DQK / 2);
#pragma unroll
    for (int i = 0; i < DQK / 32; ++i) R.k[i] = __builtin_bit_cast(u32x4, __builtin_amdgcn_raw_buffer_load_b128(rk, vk + 16 * i, 0, 0));
    const int vv = key * (int)(vpitch * 2) + (tid & 3) * 32;
    R.v[0] = __builtin_bit_cast(u32x4, __builtin_amdgcn_raw_buffer_load_b128(rv, vv, 0, 0)); R.v[1] = __builtin_bit_cast(u32x4, __builtin_amdgcn_raw_buffer_load_b128(rv, vv + 16, 0, 0));
}
template <int DQK> DI void kv_store(const KVRegs<DQK>& R, char* lds, int tid) {
    constexpr int KP = DQK + 8;
    bf16_t* Ks = (bf16_t*)lds; bf16_t* Vs = (bf16_t*)(lds + 64 * KP * 2);
    bf16_t* kp = Ks + (tid >> 2) * KP + (tid & 3) * (DQK / 4);
#pragma unroll
    for (int i = 0; i < DQK / 32; ++i) *(u32x4*)(kp + 8 * i) = R.k[i];
    bf16_t* vp = Vs + (tid >> 2) * VP + (tid & 3) * 16;
    *(u32x4*)vp = R.v[0]; *(u32x4*)(vp + 8) = R.v[1];
}
template <int DQK> DI void qk_tile(f32x16 (&s)[2], const bf16x8 (&qf)[DQK / 16], const char* lds, int tid) {
    constexpr int KP = DQK + 8; const int lane = tid & 63, r = lane & 31, h = lane >> 5;
    const bf16_t* Ks = (const bf16_t*)lds;
#pragma unroll
    for (int kh = 0; kh < 2; ++kh) {
        s[kh] = zero16();
#pragma unroll
        for (int ks = 0; ks < DQK / 16; ++ks) {
            const bf16x8 kf = *(const bf16x8*)(Ks + (32 * kh + r) * KP + 16 * ks + 8 * h);
            s[kh] = mfma(kf, qf[ks], s[kh]);
        }
    }
}
template <int DQK> DI void load_v(bf16x8 (&vf)[2][2][2], const char* lds, int tid) {
    constexpr int KP = DQK + 8; const int lane = tid & 63, h = lane >> 5;
    const bf16_t* Vs = (const bf16_t*)(lds + 64 * KP * 2);
    const int q4 = (lane & 15) >> 2, p4 = lane & 3, blk = (lane >> 4) & 1;
    const bf16_t* vb = Vs + (4 * h + q4) * VP + 16 * blk + 4 * p4;
#pragma unroll
    for (int kh = 0; kh < 2; ++kh)
#pragma unroll
        for (int st = 0; st < 2; ++st)
#pragma unroll
            for (int db = 0; db < 2; ++db) {
                const bf16_t* vp = vb + (32 * kh + 16 * st) * VP + 32 * db;
                const s16x4 lo = vtr(vp), hi = vtr(vp + 8 * VP);
                vf[kh][st][db] = __builtin_shufflevector(lo, hi, 0, 1, 2, 3, 4, 5, 6, 7);
            }
}
DI void pv_mma(f32x16 (&o)[2], const f32x16 (&p)[2], const bf16x8 (&vf)[2][2][2]) {
#pragma unroll
    for (int kh = 0; kh < 2; ++kh)
#pragma unroll
        for (int st = 0; st < 2; ++st) {
            u32x4 pk;
            pk[0] = cvtpk(p[kh][8 * st + 0], p[kh][8 * st + 1]); pk[1] = cvtpk(p[kh][8 * st + 2], p[kh][8 * st + 3]);
            pk[2] = cvtpk(p[kh][8 * st + 4], p[kh][8 * st + 5]); pk[3] = cvtpk(p[kh][8 * st + 6], p[kh][8 * st + 7]);
            const bf16x8 pf = __builtin_bit_cast(bf16x8, pk);
            o[0] = mfma(vf[kh][st][0], pf, o[0]); o[1] = mfma(vf[kh][st][1], pf, o[1]);
        }
}
template <int DQK> DI void pv_tile(f32x16 (&o)[2], const f32x16 (&p)[2], const char* lds, int tid) { bf16x8 vf[2][2][2]; load_v<DQK>(vf, lds, tid); pv_mma(o, p, vf); }
template <int DQK, class Pol, bool FULL, bool PRE> DI void flash_tile(const bf16x8 (&qf)[DQK / 16], const char* lds, int t, const Pol& pol, float& m, float& l, f32x16 (&o)[2], int tid) {
    f32x16 s[2];
    qk_tile<DQK>(s, qf, lds, tid);
    bf16x8 vf[2][2][2]; if (PRE) load_v<DQK>(vf, lds, tid);
    float mx = -1e30f;
    if (Pol::HAS_BIAS) {
#pragma unroll
        for (int kh = 0; kh < 2; ++kh)
#pragma unroll
            for (int i = 0; i < 16; ++i) {
                const int koff = 32 * kh + 8 * (i >> 2) + (i & 3);
                const float v = FULL ? pol.score_full(s[kh][i], koff) : pol.score(s[kh][i], koff);
                s[kh][i] = v; mx = fmaxf(mx, v);
            }
    } else {
#pragma unroll
        for (int kh = 0; kh < 2; ++kh)
#pragma unroll
            for (int i = 0; i < 16; ++i) {
                const int koff = 32 * kh + 8 * (i >> 2) + (i & 3);
                const float v = (FULL || pol.valid(koff)) ? s[kh][i] : -1e30f;
                s[kh][i] = v; mx = fmaxf(mx, v);
            }
        mx *= pol.sc2;
    }
    if (__any(mx > m + 8.f)) {
        mx = fmaxf(mx, __shfl_xor(mx, 32));
        const float mn = fmaxf(m, mx);
        const float alpha = ex2(m - mn);
        m = mn; l *= alpha;
#pragma unroll
        for (int i = 0; i < 16; ++i) { o[0][i] *= alpha; o[1][i] *= alpha; }
    }
    f32x2 rs2 = {0.f, 0.f};
    const float negm = -m, sc = Pol::HAS_BIAS ? 1.f : pol.sc2;
#pragma unroll
    for (int kh = 0; kh < 2; ++kh)
#pragma unroll
        for (int i = 0; i < 16; i += 2) {
            const float p0 = ex2(Pol::HAS_BIAS ? s[kh][i] + negm : fmaf(s[kh][i], sc, negm)), p1 = ex2(Pol::HAS_BIAS ? s[kh][i + 1] + negm : fmaf(s[kh][i + 1], sc, negm));
            s[kh][i] = p0; s[kh][i + 1] = p1; rs2 += (f32x2){p0, p1};
        }
    l += rs2[0] + rs2[1];
    if (!PRE) load_v<DQK>(vf, lds, tid);
    pv_mma(o, s, vf);
}
template <int DQK, bool USE_FULL, bool PRE, class Pol, class Need>
DI void flash_pass(const bf16x8 (&qf)[DQK / 16], const bf16_t* kbase, size_t kpitch, const bf16_t* vbase, size_t vpitch, int keymax,
                   int t_lo, int t_hi, Need need, int wave_tmax, Pol& pol, float& m, float& l, f32x16 (&o)[2], char* lds, int tid) {
    KVRegs<DQK> R;
    int t = t_hi - 1; while (t >= t_lo && !need(t)) --t;
    if (t >= t_lo) kv_load<DQK>(R, kbase, kpitch, vbase, vpitch, t, keymax, tid);
    while (t >= t_lo) {
        int tn = t - 1; while (tn >= t_lo && !need(tn)) --tn;
        __syncthreads();
        kv_store<DQK>(R, lds, tid);
        __syncthreads();
        if (tn >= t_lo) kv_load<DQK>(R, kbase, kpitch, vbase, vpitch, tn, keymax, tid);
        if (t <= wave_tmax) {
            pol.prep(t);
            if (USE_FULL && __all(pol.lane_full())) flash_tile<DQK, Pol, true, PRE>(qf, lds, t, pol, m, l, o, tid);
            else flash_tile<DQK, Pol, false, PRE>(qf, lds, t, pol, m, l, o, tid);
        }
        t = tn;
    }
}
struct NeedAll { DI bool operator()(int) const { return true; } };
struct NeedBits128 { unsigned long long lo, hi; DI bool operator()(int t) const { const unsigned long long w = t < 64 ? lo : hi; return (w >> (t & 63)) & 1ull; } };
struct NeedBlk4 { unsigned u; DI bool operator()(int t) const { return (u >> (t >> 2)) & 1u; } };

struct PolCausal { static constexpr bool HAS_BIAS = false; int qpos; float sc2; int lim, h4; DI void prep(int t) { lim = qpos - 64 * t - h4; }
    DI bool valid(int koff) const { return koff <= lim; }
    DI bool lane_full() const { return lim >= 59; }
    DI float score(float d, int koff) const { return koff <= lim ? d * sc2 : -1e30f; }
    DI float score_full(float d, int) const { return d * sc2; } };
struct PolMem { static constexpr bool HAS_BIAS = false; float sc2; DI bool valid(int) const { return true; } DI void prep(int) {} DI bool lane_full() const { return true; } DI float score(float d, int) const { return d * sc2; } DI float score_full(float d, int) const { return d * sc2; } };
struct PolMoba { static constexpr bool HAS_BIAS = true; DI bool valid(int) const { return true; } int qpos; float sc2, sl2; unsigned mask; int lim, h4; float base;
    DI void prep(int t) { const int kb = 64 * t + h4; lim = ((mask >> (t >> 2)) & 1u) ? qpos - kb : -1; base = sl2 * (float)(kb - qpos); }
    DI bool lane_full() const { return lim >= 59; }
    DI float score(float d, int koff) const { return koff <= lim ? fmaf(d, sc2, fmaf(sl2, (float)koff, base)) : -1e30f; }
    DI float score_full(float d, int koff) const { return fmaf(d, sc2, fmaf(sl2, (float)koff, base)); } };
struct PolRoute { static constexpr bool HAS_BIAS = true; DI bool valid(int) const { return true; } int qpos; float sc2, sl2; int h4; float base;
    DI void prep(int t) { const int kb = 64 * t + h4; base = sl2 * (float)(kb - qpos); }
    DI bool lane_full() const { return true; }
    DI float score(float d, int koff) const { return fmaf(d, sc2, fmaf(sl2, (float)koff, base)); }
    DI float score_full(float d, int koff) const { return fmaf(d, sc2, fmaf(sl2, (float)koff, base)); } };
struct PolCmp { static constexpr bool HAS_BIAS = true; DI bool valid(int) const { return true; } int qpos; float sc2, sl2; int lim, h4; float base;
    DI void prep(int t) { const int kb = 64 * t + h4; const int klim = (qpos - 31) >> 4; const int l1 = klim - kb, l2 = 510 - kb; lim = l1 < l2 ? l1 : l2; base = sl2 * (float)(16 * kb + 31 - qpos); }
    DI bool lane_full() const { return lim >= 59; }
    DI float score(float d, int koff) const { return koff <= lim ? fmaf(d, sc2, fmaf(16.f * sl2, (float)koff, base)) : -1e30f; }
    DI float score_full(float d, int koff) const { return fmaf(d, sc2, fmaf(16.f * sl2, (float)koff, base)); } };
struct PolSel { static constexpr bool HAS_BIAS = true; DI bool valid(int) const { return true; } int qpos; float sc2, sl2; unsigned long long mlo, mhi; int lim, h4; float base;
    DI void prep(int t) { const int kb = 64 * t + h4; const unsigned long long w = t < 64 ? mlo : mhi; const bool on = (w >> (t & 63)) & 1ull; lim = on ? qpos - kb : -1;
        base = on ? sl2 * (float)(kb - qpos) : -1e30f; }
    DI bool lane_full() const { return lim >= 59 || lim < 0; }
    DI float score(float d, int koff) const { return koff <= lim ? fmaf(d, sc2, fmaf(sl2, (float)koff, base)) : -1e30f; }
    DI float score_full(float d, int koff) const { return fmaf(d, sc2, fmaf(sl2, (float)koff, base)); } };
struct PolWin { static constexpr bool HAS_BIAS = true; DI bool valid(int) const { return true; } int qpos; float sc2, sl2; int lim, h4; float base;
    DI void prep(int t) { const int kb = 64 * t + h4; lim = qpos - kb; base = sl2 * (float)(kb - qpos); }
    DI bool lane_full() const { return lim >= 59 && lim < 512; }
    DI float score(float d, int koff) const { return (koff <= lim && koff > lim - 512) ? fmaf(d, sc2, fmaf(sl2, (float)koff, base)) : -1e30f; }
    DI float score_full(float d, int koff) const { return fmaf(d, sc2, fmaf(sl2, (float)koff, base)); } };

DI void store_pair16(bf16_t* rowp, u32x2 a, u32x2 b, int h) {
    const auto r0 = __builtin_amdgcn_permlane32_swap(a[0], b[0], false, false);
    const auto r1 = __builtin_amdgcn_permlane32_swap(a[1], b[1], false, false);
    u32x4 v; v[0] = r0[0]; v[1] = r1[0]; v[2] = r0[1]; v[3] = r1[1];
    *(u32x4*)(rowp + 8 * h) = v;
}
DI void store_pair8(unsigned char* rowp, unsigned a, unsigned b, int h) {
    const auto r0 = __builtin_amdgcn_permlane32_swap(a, b, false, false);
    u32x2 v; v[0] = r0[0]; v[1] = r0[1];
    *(u32x2*)(rowp + 8 * h) = v;
}
DI void write_o_bf16(bf16_t* orow, const f32x16 (&o)[2], int tid) {
    const int h = (tid & 63) >> 5;
#pragma unroll
    for (int db = 0; db < 2; ++db)
#pragma unroll
        for (int g = 0; g < 4; g += 2) {
            u32x2 wa, wb; wa[0] = cvtpk(o[db][4 * g], o[db][4 * g + 1]); wa[1] = cvtpk(o[db][4 * g + 2], o[db][4 * g + 3]);
            wb[0] = cvtpk(o[db][4 * g + 4], o[db][4 * g + 5]); wb[1] = cvtpk(o[db][4 * g + 6], o[db][4 * g + 7]);
            store_pair16(orow + 32 * db + 8 * g, wa, wb, h);
        }
}
DI void write_o(unsigned char* orow, const f32x16 (&o)[2], int tid) {
    const int h = (tid & 63) >> 5;
#pragma unroll
    for (int db = 0; db < 2; ++db)
#pragma unroll
        for (int g = 0; g < 4; ++g)
            *(unsigned*)(orow + 32 * db + 8 * g + 4 * h) = pk4_fp8(16.f * o[db][4 * g], 16.f * o[db][4 * g + 1], 16.f * o[db][4 * g + 2], 16.f * o[db][4 * g + 3]);
}
DI void load_q64(bf16x8 (&qf)[4], const bf16_t* qrow, int tid) { const int h = (tid & 63) >> 5;
#pragma unroll
    for (int ks = 0; ks < 4; ++ks) qf[ks] = *(const bf16x8*)(qrow + 16 * ks + 8 * h); }

struct Ctx {
    const Params* p; int layer; char* lds; unsigned char* wsp; int qslot;
    const __attribute__((address_space(4))) char* ka;
    DI const float* in(int i) const { return (const float*)*(const __attribute__((address_space(1))) float* const __attribute__((address_space(4)))*)(ka + 8 * i); }
    DI float* outp() const { return (float*)*(__attribute__((address_space(1))) float* const __attribute__((address_space(4)))*)(ka + 216); }
    DI unsigned char* ws() const { return wsp; }
    DI bf16_t* HB() const { return (bf16_t*)(wsp + WS_HB); }
    DI unsigned char* HB8() const { return wsp + WS_HB8; }
    DI bf16_t* P() const { return (bf16_t*)(wsp + WS_P); }
    DI bf16_t* MG() const { return (bf16_t*)(wsp + WS_MG); }
    DI bf16_t* ACT() const { return (bf16_t*)(wsp + WS_ACT); }
    DI unsigned char* OB() const { return wsp + WS_OB; }
    DI bf16_t* QM() const { return (bf16_t*)(wsp + WS_QM); }
    DI bf16_t* MK() const { return (bf16_t*)(wsp + WS_MK); }
    DI bf16_t* W() const { return (bf16_t*)(wsp + WS_W); }
    DI bf16_t* MEMB() const { return (bf16_t*)(wsp + WS_MEMB); }
    DI bf16_t* MEMKV() const { return (bf16_t*)(wsp + WS_MEMKV); }
    DI bf16_t* HC() const { return (bf16_t*)(wsp + WS_HC); }
    DI bf16_t* KC() const { return (bf16_t*)(wsp + WS_KC); }
    DI float* KMEAN() const { return (float*)(wsp + WS_KMEAN); }
    DI float* CPART() const { return (float*)(wsp + WS_CPART); }
    DI float* CBIAS() const { return (float*)(wsp + WS_CPART + 32768); }
    DI int* LTOK() const { return (int*)(wsp + WS_LTOK); }
    DI unsigned short* MBLIST() const { return (unsigned short*)(wsp + WS_LTOK); }
    DI unsigned* MBSEL() const { return (unsigned*)(wsp + WS_LTOK + 8 * MiB); }
    DI unsigned char* MBPART() const { return wsp + WS_HB; }
    DI float* LW() const { return (float*)(wsp + WS_LW); }
    DI unsigned* CTL() const { return (unsigned*)(wsp + WS_CTL); }
    DI const float* hsrc() const { return layer == 0 ? in(0) : outp(); }
    DI bf16_t* YB() const { return (bf16_t*)(wsp + WS_OB); }
};

DI bool xcd_item(int k, int NM, int NN, int& mt, int& nt) {
    const int x = blockIdx.x & 7, j = blockIdx.x >> 3, g8 = gridDim.x >> 3;
    const int per = (NM + 7) >> 3;
    const int i = j + k * g8;
    if (i >= per * NN) return false;
    mt = x * per + i / NN; nt = i % NN;
    return true;
}
DI void phase_prologue(const Ctx& c) {
    const size_t gt = (size_t)blockIdx.x * NTHR + opaque_tid(), gs = (size_t)gridDim.x * NTHR;
    const float* x = c.in(0);
    for (size_t i = gt; i < (size_t)T * DM / 8; i += gs) {
        const f32x4 a = *(const f32x4*)(x + i * 8), b = *(const f32x4*)(x + i * 8 + 4);
        u32x2 o8; o8[0] = pk4_fp8(a[0], a[1], a[2], a[3]); o8[1] = pk4_fp8(b[0], b[1], b[2], b[3]);
        *(u32x2*)(c.HB8() + i * 8) = o8;
    }
    const float* mem = c.in(1); bf16_t* mb = c.MEMB();
    for (size_t i = gt; i < (size_t)1024 * 1024 / 8; i += gs) {
        const f32x4 a = *(const f32x4*)(mem + i * 8), b = *(const f32x4*)(mem + i * 8 + 4);
        u32x4 o; o[0] = cvtpk(a[0], a[1]); o[1] = cvtpk(a[2], a[3]); o[2] = cvtpk(b[0], b[1]); o[3] = cvtpk(b[2], b[3]);
        *(u32x4*)(mb + i * 8) = o;
    }
}

DI void conv_tile(const float* src, int ld_src, bf16_t* dst, int K, int kt, int nt, int kind, const float* gain, char* lds) {
    float* tile = (float*)lds; const int tid = opaque_tid();
    const int k0 = kt * 64, n0 = nt * 64;
    __syncthreads();
    {
        const int nl = tid & 63; const int np = n0 + nl; int ns = np; bool valid = true;
        if (kind == 1) { if (np < 2592) ns = np; else if (np < 2848) ns = np + 12; else if (np < 2860) ns = np - 256; else valid = false; }
        else if (kind == 2) { const int j = np >> 6, cc = np & 63; ns = cc < 32 ? 32 * j + cc : 256 + 32 * j + cc - 32; }
        else if (kind == 3) { valid = np < 64; }
#pragma unroll
        for (int i = 0; i < 16; ++i) {
            const int kl = (tid >> 6) + 4 * i;
            float v = valid ? src[(size_t)(k0 + kl) * ld_src + ns] : 0.f;
            if (gain) v *= gain[k0 + kl];
            tile[kl * 65 + nl] = v;
        }
    }
    __syncthreads();
    {
        const int kl = tid & 63;
#pragma unroll
        for (int i = 0; i < 16; ++i) {
            const int nl = (tid >> 6) + 4 * i;
            const float v = tile[kl * 65 + nl];
            dst[(size_t)(n0 + nl) * K + k0 + kl] = (bf16_t)(cvtpk(v, v) & 0xffffu);
        }
    }
}
DI void conv_tile_f8(const float* src, int ld_src, unsigned char* dst8, int K, int kt, int nt, int kind, float scale, char* lds) {
    float* tile = (float*)lds; const int tid = opaque_tid();
    const int k0 = kt * 64, n0 = nt * 64;
    __syncthreads();
    {
        const int nl = tid & 63; const int np = n0 + nl; int ns = np; bool valid = true;
        if (kind == 1) { if (np < 2592) ns = np; else if (np < 2848) ns = np + 12; else if (np < 2860) ns = np - 256; else valid = false; }
        else if (kind == 2) { const int j = np >> 6, cc = np & 63; ns = cc < 32 ? 32 * j + cc : 256 + 32 * j + cc - 32; }
#pragma unroll
        for (int i = 0; i < 16; ++i) { const int kl = (tid >> 6) + 4 * i; tile[kl * 65 + nl] = valid ? src[(size_t)(k0 + kl) * ld_src + ns] * scale : 0.f; }
    }
    __syncthreads();
#pragma unroll
    for (int q = 0; q < 4; ++q) { const int kq = tid & 15, nl = (tid >> 4) + 16 * q;
        *(unsigned*)(dst8 + (size_t)(n0 + nl) * K + k0 + 4 * kq) = pk4_fp8(tile[(4 * kq) * 65 + nl], tile[(4 * kq + 1) * 65 + nl], tile[(4 * kq + 2) * 65 + nl], tile[(4 * kq + 3) * 65 + nl]); }
}
DI bool conv_job_f8(int& t, const float* src, int ld_src, unsigned char* dst8, int K, int N, int kind, float scale, char* lds) {
    const int nkt = K / 64, cnt = nkt * (N / 64);
    if (t < cnt) { conv_tile_f8(src, ld_src, dst8, K, t % nkt, t / nkt, kind, scale, lds); return true; }
    t -= cnt; return false;
}
DI bool conv_job(int& t, const float* src, int ld_src, bf16_t* dst, int K, int N, int kind, const float* gain, char* lds) {
    const int nkt = K / 64, cnt = nkt * (N / 64);
    if (t < cnt) { conv_tile(src, ld_src, dst, K, t % nkt, t / nkt, kind, gain, lds); return true; }
    t -= cnt; return false;
}
struct WJob { const __attribute__((address_space(1))) float* src; const __attribute__((address_space(1))) float* gain; __attribute__((address_space(1))) unsigned char* dst; float scale; int ld, K, k0, n0, kind, f8; };
DI bool w_decode(const Ctx& c, int item, WJob& j) {
    const int l = c.layer; unsigned char* W = (unsigned char*)c.W(); int t = item;
    j.gain = (const __attribute__((address_space(1))) float*)nullptr; j.scale = 1.f; j.kind = 0; j.f8 = 0;
    int N = 0; size_t dsto = 0;
#define WJ_ENT(CNT, SRC, LD, DSTE, DST8ADD, KK, NN, KIND, GAIN, SCALE, F8) \
    if (t < (CNT)) { j.src = (const __attribute__((address_space(1))) float*)(SRC); j.ld = (LD); dsto = (DSTE); j.K = (KK); N = (NN); j.kind = (KIND); j.gain = (const __attribute__((address_space(1))) float*)(GAIN); j.scale = (SCALE); j.f8 = (F8); j.dst = (__attribute__((address_space(1))) unsigned char*)(W + 2 * dsto + (DST8ADD)); \
                     const int nkt = (KK) / 64; j.k0 = 64 * (t % nkt); j.n0 = 64 * (t / nkt); return true; } t -= (CNT);
    WJ_ENT(16 * 46, c.in(2) + (size_t)l * 1024 * 2860, 2860, W_IN, 0, 1024, PW, 1, nullptr, 32.f, 1)
    WJ_ENT(4 * 6, c.in(5) + (size_t)l * 256 * 384, 384, W_UQ, 0, 256, 384, 0, c.in(3) + l * 256, 1.f, 0)
    WJ_ENT(2 * 8, c.in(6) + (size_t)l * 128 * 512, 512, W_UKV, 0, 128, 512, 0, c.in(4) + l * 128, 1.f, 0)
    WJ_ENT(32 * 2, c.in(8) + (size_t)l * 2048 * 128, 128, W_PHI1, 0, 2048, 128, 0, nullptr, 1.f, 0)
    WJ_ENT(32 * 2, c.in(10) + (size_t)l * 2048 * 128, 128, W_PHI1 + 128 * 2048, 0, 2048, 128, 0, nullptr, 1.f, 0)
    WJ_ENT(2 * 2, c.in(9) + (size_t)l * 128 * 64, 64, W_PHI2, 0, 128, 128, 3, nullptr, 1.f, 0)
    WJ_ENT(2 * 2, c.in(11) + (size_t)l * 128 * 64, 64, W_PHI2 + 128 * 128, 0, 128, 128, 3, nullptr, 1.f, 0)
    WJ_ENT(16 * 8, c.in(12) + (size_t)l * 1024 * 512, 512, W_MEM, 0, 1024, 512, 0, nullptr, 1.f, 0)
    if (t < 5 * 64) { const int i = t / 64; t %= 64; WJ_ENT(64, c.in(13) + ((size_t)l * 5 + i) * 256 * 1024, 1024, W_BR, (size_t)i * 1024 * 256, 256, 1024, 0, nullptr, 32.f, 1) } t -= 5 * 64;
    if (t < 5 * 256) { const int i = t / 256; t %= 256; WJ_ENT(256, c.in(14) + ((size_t)l * 5 + i) * 1024 * 1024, 1024, W_G, (size_t)i * 1024 * 1024, 1024, 1024, 0, nullptr, 32.f, 1) } t -= 5 * 256;
    WJ_ENT(256, c.in(16) + (size_t)l * 1024 * 1024, 1024, W_OUT, 0, 1024, 1024, 0, nullptr, 64.f, 1)
    if (t < 16 * 128) { const int e = t / 128; t %= 128; WJ_ENT(128, c.in(23) + ((size_t)l * 16 + e) * 1024 * 512, 512, W_UP, (size_t)e * 512 * 1024, 1024, 512, 2, nullptr, 32.f, 1) } t -= 16 * 128;
    if (t < 16 * 64) { const int e = t / 64; t %= 64; WJ_ENT(64, c.in(24) + ((size_t)l * 16 + e) * 256 * 1024, 1024, W_DN, (size_t)e * 1024 * 256, 256, 1024, 0, nullptr, 32.f, 1) } t -= 16 * 64;
#undef WJ_ENT
    j.k0 = t; (void)N;
    return false;
}
DI void w_load(const WJob& j, float (&v)[16], int tid) {
    const int nl = tid & 63, np = j.n0 + nl; int ns = np; bool valid = true;
    if (j.kind == 1) { if (np < 2592) ns = np; else if (np < 2848) ns = np + 12; else if (np < 2860) ns = np - 256; else valid = false; }
    else if (j.kind == 2) { const int jj = np >> 6, cc = np & 63; ns = cc < 32 ? 32 * jj + cc : 256 + 32 * jj + cc - 32; }
    else if (j.kind == 3) { valid = np < 64; }
    const __attribute__((address_space(1))) float* s = j.src + (size_t)(j.k0 + (tid >> 6)) * j.ld + ns;
#pragma unroll
    for (int i = 0; i < 16; ++i) v[i] = valid ? s[(size_t)(4 * i) * j.ld] : 0.f;
    if (j.gain) {
#pragma unroll
        for (int i = 0; i < 16; ++i) v[i] *= j.gain[j.k0 + (tid >> 6) + 4 * i];
    }
}
DI void w_finish(const WJob& j, const float (&v)[16], char* lds, int tid) {
    float* tile = (float*)lds;
    __syncthreads();
#pragma unroll
    for (int i = 0; i < 16; ++i) tile[((tid >> 6) + 4 * i) * 65 + (tid & 63)] = v[i] * j.scale;
    __syncthreads();
    if (j.f8) {
#pragma unroll
        for (int q = 0; q < 4; ++q) { const int kq = tid & 15, nl = (tid >> 4) + 16 * q;
            *(__attribute__((address_space(1))) unsigned*)(j.dst + (size_t)(j.n0 + nl) * j.K + j.k0 + 4 * kq) = pk4_fp8(tile[(4 * kq) * 65 + nl], tile[(4 * kq + 1) * 65 + nl], tile[(4 * kq + 2) * 65 + nl], tile[(4 * kq + 3) * 65 + nl]); }
    } else {
        __attribute__((address_space(1))) bf16_t* d = (__attribute__((address_space(1))) bf16_t*)j.dst;
#pragma unroll
        for (int q = 0; q < 8; ++q) { const int kp = tid & 31, nl = (tid >> 5) + 8 * q;
            *(__attribute__((address_space(1))) unsigned*)(d + (size_t)(j.n0 + nl) * j.K + j.k0 + 2 * kp) = cvtpk(tile[(2 * kp) * 65 + nl], tile[(2 * kp + 1) * 65 + nl]); }
    }
}
DI void w_cpart(const Ctx& c, int t) {
    const int l = c.layer; const int kv = t >> 5, pp = t & 31; const int tid = opaque_tid(), j = tid & 127, hh = tid >> 7;
    const float* w1 = c.in(kv ? 10 : 8) + (size_t)l * 2048 * 128; const float* pe = c.in(7) + (size_t)l * 2048;
    float s = 0.f;
    for (int k = pp * 64 + hh * 32; k < pp * 64 + hh * 32 + 32; ++k) s += pe[k] * w1[(size_t)k * 128 + j];
    float* red = (float*)c.lds;
    __syncthreads();
    if (hh) red[j] = s;
    __syncthreads();
    if (!hh) c.CPART()[(kv * 32 + pp) * 128 + j] = s + red[j];
}
DI void phase_weights(const Ctx& c) {
    constexpr int TOTAL = 16 * 46 + 4 * 6 + 2 * 8 + 2 * 64 + 2 * 4 + 128 + 5 * 64 + 5 * 256 + 256 + 16 * 128 + 16 * 64 + 64;
    const int tid = opaque_tid(); const int G = gridDim.x;
    int item = blockIdx.x;
    WJob cur; cur.src = (const __attribute__((address_space(1))) float*)nullptr; cur.gain = (const __attribute__((address_space(1))) float*)nullptr; cur.dst = (__attribute__((address_space(1))) unsigned char*)nullptr; cur.scale = 1.f; cur.ld = 0; cur.K = 0; cur.k0 = 0; cur.n0 = 0; cur.kind = 0; cur.f8 = 0;
    float v[16]; bool is_tile = false;
#pragma unroll
    for (int i = 0; i < 16; ++i) v[i] = 0.f;
    if (item < TOTAL) { is_tile = w_decode(c, item, cur); if (is_tile) w_load(cur, v, tid); }
    while (item < TOTAL) {
        const int nitem = item + G;
        WJob nxt = cur; float vn[16]; bool ntile = false;
#pragma unroll
        for (int i = 0; i < 16; ++i) vn[i] = 0.f;
        if (nitem < TOTAL) { ntile = w_decode(c, nitem, nxt); if (ntile) w_load(nxt, vn, tid); }
        if (is_tile) w_finish(cur, v, c.lds, tid); else w_cpart(c, cur.k0);
        cur = nxt; is_tile = ntile; item = nitem;
#pragma unroll
        for (int i = 0; i < 16; ++i) v[i] = vn[i];
    }
}

DI void store_bf16_tile(const f32x16 (&acc)[2][2], bf16_t* dst  , size_t ldc) {
    const int tid = opaque_tid(), lane = tid & 63, w = tid >> 6, r = lane & 31, h = lane >> 5, wr = w >> 1, wc = w & 1;
#pragma unroll
    for (int mi = 0; mi < 2; ++mi)
#pragma unroll
        for (int ni = 0; ni < 2; ++ni)
#pragma unroll
            for (int g = 0; g < 4; g += 2) {
                u32x2 wa, wb; wa[0] = cvtpk(acc[mi][ni][4 * g], acc[mi][ni][4 * g + 1]); wa[1] = cvtpk(acc[mi][ni][4 * g + 2], acc[mi][ni][4 * g + 3]);
                wb[0] = cvtpk(acc[mi][ni][4 * g + 4], acc[mi][ni][4 * g + 5]); wb[1] = cvtpk(acc[mi][ni][4 * g + 6], acc[mi][ni][4 * g + 7]);
                store_pair16(dst + (size_t)(64 * wr + 32 * mi + r) * ldc + 64 * wc + 32 * ni + 8 * g, wa, wb, h);
            }
}
DI void phase_proj(const Ctx& c) {
    const int tid = opaque_tid(), srow = tid >> 3, scol = (tid & 7) * 8;
    if (blockIdx.x == 0) {
        const float* cp = c.CPART(); float s = 0.f; const int kv = tid >> 7, j = tid & 127;
        for (int pp = 0; pp < 32; ++pp) s += cp[(kv * 32 + pp) * 128 + j];
        c.CBIAS()[tid] = s;
    }
    constexpr int NTN = PW / 128;
    int mt, nt; bool have = xcd_item(0, T / 128, NTN, mt, nt);
    for (int k = 0; have; ++k) {
        int mt2 = 0, nt2 = 0; const bool have2 = xcd_item(k + 1, T / 128, NTN, mt2, nt2);
        f32x16 acc[2][2]; zero_acc(acc);
        { int rowE, cbE, cbO; dma_lane(tid, rowE, cbE, cbO);
          const char* a8 = (const char*)(c.HB8() + (size_t)(128 * mt + rowE) * 1024);
          const char* b8 = (const char*)(c.W() + W_IN) + (size_t)(128 * nt + rowE) * 1024;
          const NextSt nx = next_reg(c.HB8() + (size_t)(128 * mt2) * 1024, 1024, (const char*)(c.W() + W_IN) + (size_t)(128 * nt2) * 1024, 1024, have2, tid);
          gemm_dma<2, true, NextSt, 122, 127>(acc, a8 + cbE, a8 + 8 * 1024 + cbO, nullptr, nullptr, 16 * 1024, 128, b8 + cbE, b8 + 8 * 1024 + cbO, 16 * 1024, 8, c.lds, k ? 8 : 0, nx); }
        store_bf16_tile(acc, c.P() + (size_t)(128 * mt) * PW + 128 * nt, PW);
        if (nt == 8 || nt == 9) {
            const int lane_ = tid & 63, w_ = tid >> 6, r_ = lane_ & 31, h_ = lane_ >> 5, wr_ = w_ >> 1, wc_ = w_ & 1;
            float* red = (float*)(c.lds + LDS_MISC + 2048);
#pragma unroll
            for (int ni = 0; ni < 2; ++ni)
#pragma unroll
                for (int i = 0; i < 16; ++i) {
                    float v = acc[0][ni][i] + acc[1][ni][i];
#pragma unroll
                    for (int o = 1; o <= 16; o <<= 1) v += __shfl_xor(v, o);
                    if (r_ == 0) red[wr_ * 128 + 64 * wc_ + 32 * ni + 8 * (i >> 2) + 4 * h_ + (i & 3)] = v;
                }
            __syncthreads();
            if (tid < 128) c.KMEAN()[(size_t)mt * 256 + (nt - 8) * 128 + tid] = red[tid] + red[128 + tid];
            __syncthreads();
        }
        mt = mt2; nt = nt2; have = have2;
    }
    {
        const int first = gridDim.x >= 512 ? 256 : 0;
        for (int item = (int)blockIdx.x - first; item >= 0 && item < 32; item += gridDim.x) {
            f32x16 acc[2][2]; zero_acc(acc);
            const int mt = item >> 2, nt = item & 3;
            gemm_reg(acc, c.MEMB() + (size_t)(128 * mt) * 1024, 1024, c.W() + W_MEM + (size_t)(128 * nt) * 1024, 1024, 1024, c.lds);
            store_bf16_tile(acc, c.MEMKV() + (size_t)(128 * mt) * 512 + 128 * nt, 512);
        }
    }
}

DI void sel_item(const Ctx& c, int item) {
    const int tid = opaque_tid(), lane = tid & 63, w = tid >> 6, r = lane & 31, h = lane >> 5;
    float* km = (float*)(c.lds + 24576);
    {
        const int qt = item >> 4, b = (item >> 2) & 3, head = item & 3, bh = b * 4 + head;
        const int q0 = 128 * qt, own = q0 >> 8, qpos = q0 + 32 * w + r; const size_t tok = (size_t)b * S + qpos;
        const bf16_t* qrow = c.P() + tok * PW + C_MBQ + head * 64;
        __syncthreads();
        { const float* kp = c.KMEAN() + (size_t)(b * 64) * 256 + head * 64;
          for (int i = tid; i < own * 64; i += NTHR) { const int n = i >> 6, d = i & 63; km[i] = (kp[(size_t)(2 * n) * 256 + d] + kp[(size_t)(2 * n + 1) * 256 + d]) * (1.f / 256.f); } }
        __syncthreads();
        u32x4 qq[8];
#pragma unroll
        for (int i = 0; i < 8; ++i) qq[i] = *(const u32x4*)(qrow + 8 * i);
        float v1 = -3e38f, v2 = -3e38f, v3 = -3e38f; int i1 = 255, i2 = 255, i3 = 255;
        for (int n = 0; n < own; ++n) {
            float gsc = 0.f; const float* kr = km + n * 64;
#pragma unroll
            for (int i = 0; i < 8; ++i)
#pragma unroll
                for (int e = 0; e < 4; ++e) { gsc += bflo(qq[i][e]) * kr[8 * i + 2 * e]; gsc += bfhi(qq[i][e]) * kr[8 * i + 2 * e + 1]; }
            if (gsc > v1) { v3 = v2; i3 = i2; v2 = v1; i2 = i1; v1 = gsc; i1 = n; }
            else if (gsc > v2) { v3 = v2; i3 = i2; v2 = gsc; i2 = n; }
            else if (gsc > v3) { v3 = gsc; i3 = n; }
        }
        if (h == 0) {
            c.MBSEL()[(size_t)bh * S + qpos] = (unsigned)i1 | ((unsigned)i2 << 8) | ((unsigned)i3 << 16);
            unsigned* cnt = c.CTL() + CW_MB + (512 * c.layer + bh * 32) * 64;
            unsigned short* lst = c.MBLIST() + (size_t)(bh * 32) * 8192;
            if (i1 < 255) { const unsigned pos = __hip_atomic_fetch_add(cnt + 64 * i1, 1u, __ATOMIC_RELAXED, __HIP_MEMORY_SCOPE_AGENT); lst[(size_t)i1 * 8192 + pos] = (unsigned short)(qpos | (0 << 13)); }
            if (i2 < 255) { const unsigned pos = __hip_atomic_fetch_add(cnt + 64 * i2, 1u, __ATOMIC_RELAXED, __HIP_MEMORY_SCOPE_AGENT); lst[(size_t)i2 * 8192 + pos] = (unsigned short)(qpos | (1 << 13)); }
            if (i3 < 255) { const unsigned pos = __hip_atomic_fetch_add(cnt + 64 * i3, 1u, __ATOMIC_RELAXED, __HIP_MEMORY_SCOPE_AGENT); lst[(size_t)i3 * 8192 + pos] = (unsigned short)(qpos | (2 << 13)); }
        }
    }
}
DI void phase_prep1(const Ctx& c) {
    const int tid = opaque_tid(), lane = tid & 63, w = tid >> 6, r = lane & 31, h = lane >> 5, wr = w >> 1, wc = w & 1;
    const int srow = tid >> 3, scol = (tid & 7) * 8;
    float* rstd = (float*)(c.lds + LDS_MISC);
    constexpr int N_C = 32, N_KM = 1024, N_Q = 256 * 3, N_KV = 256 * 4, TOTAL = N_C + N_KM + N_Q + N_KV;
    unsigned* qh = c.CTL() + 512 + 16 * c.layer;
    volatile int* qslot = (volatile int*)(c.lds + LDS_MISC + 3584);
    for (;;) {
        __syncthreads();
        if (threadIdx.x == 0) *qslot = (int)__hip_atomic_fetch_add(qh, 1u, __ATOMIC_RELAXED, __HIP_MEMORY_SCOPE_AGENT);
        __syncthreads();
        const int item = __builtin_amdgcn_readfirstlane(*qslot);
        if (item >= TOTAL) break;
        int t = item;
        if (t < N_C) {
            const int kv = t >> 4, mt = t & 15;
            f32x16 acc[2][2]; zero_acc(acc);
            int rowE, cbE, cbO; dma_lane(tid, rowE, cbE, cbO);
            const char* ap[4];
#pragma unroll
            for (int i = 0; i < 4; ++i) { const int gr = 128 * mt + rowE + 8 * i, b = gr >> 9; int n = gr & 511; n = n > 510 ? 510 : n;
                ap[i] = (const char*)(c.P() + (size_t)(b * S + 16 * n) * PW + C_NKV + 64 * kv) + ((i & 1) ? cbO : cbE); }
            const char* bp = (const char*)(c.W() + W_PHI1 + (size_t)kv * 128 * 2048 + (size_t)rowE * 2048);
            gemm_dma<0, false>(acc, ap[0], ap[1], ap[2], ap[3], 0, (size_t)PW * 2, bp + cbE, bp + 8 * 2048 * 2 + cbO, 16 * 2048 * 2, 32, c.lds);
            const float* cbias = c.CBIAS() + kv * 128; bf16_t* hc = c.HC() + (size_t)kv * 2048 * 128 + (size_t)(128 * mt) * 128;
#pragma unroll
            for (int mi = 0; mi < 2; ++mi)
#pragma unroll
                for (int ni = 0; ni < 2; ++ni)
#pragma unroll
                    for (int g = 0; g < 4; ++g) {
                        const int col = 64 * wc + 32 * ni + 8 * g + 4 * h; const f32x4 bv = *(const f32x4*)(cbias + col);
                        float o4[4];
#pragma unroll
                        for (int e = 0; e < 4; ++e) { const float x = acc[mi][ni][4 * g + e] + bv[e]; const float y = 0.7978845608028654f * (x + 0.044715f * x * x * x);
                            o4[e] = x * rcpf_(1.f + ex2(-2.f * LOG2E * y)); }
                        u32x2 wv; wv[0] = cvtpk(o4[0], o4[1]); wv[1] = cvtpk(o4[2], o4[3]);
                        *(u32x2*)(hc + (size_t)(64 * wr + 32 * mi + r) * 128 + col) = wv;
                    }
            f32x16 acc2[2][2]; zero_acc(acc2);
            gemm_reg(acc2, hc, 128, c.W() + W_PHI2 + (size_t)kv * 128 * 128, 128, 128, c.lds);
            if (wc == 0) {
                bf16_t* dst = c.KC() + (size_t)kv * 2048 * 64 + (size_t)(128 * mt) * 64;
#pragma unroll
                for (int mi = 0; mi < 2; ++mi)
#pragma unroll
                    for (int ni = 0; ni < 2; ++ni)
#pragma unroll
                        for (int g = 0; g < 4; ++g) {
                            u32x2 wv; wv[0] = cvtpk(acc2[mi][ni][4 * g], acc2[mi][ni][4 * g + 1]); wv[1] = cvtpk(acc2[mi][ni][4 * g + 2], acc2[mi][ni][4 * g + 3]);
                            *(u32x2*)(dst + (size_t)(64 * wr + 32 * mi + r) * 64 + 32 * ni + 8 * g + 4 * h) = wv;
                        }
            }
            continue;
        }
        t -= N_C;
        if (t < N_KM) { sel_item(c, t); continue; }
        t -= N_KM;
        if (t < N_Q) {
            const int mt = t / 3, ct = t % 3;
            __syncthreads();
            { const int row = tid >> 1, half = tid & 1; const bf16_t* src = c.P() + (size_t)(128 * mt + row) * PW + C_CQ + half * 128; float ss = 0.f;
#pragma unroll
              for (int i = 0; i < 16; ++i) { const u32x4 v = *(const u32x4*)(src + 8 * i);
#pragma unroll
                  for (int e = 0; e < 4; ++e) { const float a = bflo(v[e]), bq = bfhi(v[e]); ss += a * a + bq * bq; } }
              ss += __shfl_xor(ss, 1);
              if (!half) rstd[row] = __builtin_amdgcn_rsqf(ss * (1.f / 256.f) + 1e-6f); }
            f32x16 acc[2][2]; zero_acc(acc);
            gemm_reg(acc, c.P() + (size_t)(128 * mt) * PW + C_CQ, PW, c.W() + W_UQ + (size_t)(128 * ct) * 256, 256, 256, c.lds);
            bf16_t* dst = c.QM() + (size_t)(128 * mt) * QMW + 128 * ct;
#pragma unroll
            for (int mi = 0; mi < 2; ++mi) { const float sc = rstd[64 * wr + 32 * mi + r];
#pragma unroll
                for (int ni = 0; ni < 2; ++ni)
#pragma unroll
                    for (int g = 0; g < 4; g += 2) {
                        u32x2 wa, wb; wa[0] = cvtpk(acc[mi][ni][4 * g] * sc, acc[mi][ni][4 * g + 1] * sc); wa[1] = cvtpk(acc[mi][ni][4 * g + 2] * sc, acc[mi][ni][4 * g + 3] * sc);
                        wb[0] = cvtpk(acc[mi][ni][4 * g + 4] * sc, acc[mi][ni][4 * g + 5] * sc); wb[1] = cvtpk(acc[mi][ni][4 * g + 6] * sc, acc[mi][ni][4 * g + 7] * sc);
                        store_pair16(dst + (size_t)(64 * wr + 32 * mi + r) * QMW + 64 * wc + 32 * ni + 8 * g, wa, wb, h);
                    } }
            continue;
        }
        t -= N_Q;
        {
            const int mt = t >> 2, ct = t & 3;
            __syncthreads();
            { const int row = tid >> 1, half = tid & 1; const bf16_t* src = c.P() + (size_t)(128 * mt + row) * PW + C_CKV + half * 64; float ss = 0.f;
#pragma unroll
              for (int i = 0; i < 8; ++i) { const u32x4 v = *(const u32x4*)(src + 8 * i);
#pragma unroll
                  for (int e = 0; e < 4; ++e) { const float a = bflo(v[e]), bq = bfhi(v[e]); ss += a * a + bq * bq; } }
              ss += __shfl_xor(ss, 1);
              if (!half) rstd[row] = __builtin_amdgcn_rsqf(ss * (1.f / 128.f) + 1e-6f);
              if (ct == 0) {
                  const int tok = 128 * mt + row; const float pos = (float)(tok & (S - 1));
                  const bf16_t* kr = c.P() + (size_t)tok * PW + C_KR + 8 * half;
                  const u32x4 x1 = *(const u32x4*)kr, x2 = *(const u32x4*)(kr + 16);
                  float o1[8], o2[8];
#pragma unroll
                  for (int j = 0; j < 8; ++j) { const int i = 8 * half + j; const float fr = ex2(-(float)i * (13.287712379549449f / 16.f)) * 0.15915494309189535f;
                      const float tt = pos * fr; const float ph = tt - floorf(tt); const float sn = __builtin_amdgcn_sinf(ph), cs = __builtin_amdgcn_cosf(ph);
                      const float a = (j & 1) ? bfhi(x1[j >> 1]) : bflo(x1[j >> 1]), bq = (j & 1) ? bfhi(x2[j >> 1]) : bflo(x2[j >> 1]);
                      o1[j] = a * cs - bq * sn; o2[j] = a * sn + bq * cs; }
                  u32x4 w1v, w2v;
#pragma unroll
                  for (int j = 0; j < 4; ++j) { w1v[j] = cvtpk(o1[2 * j], o1[2 * j + 1]); w2v[j] = cvtpk(o2[2 * j], o2[2 * j + 1]); }
                  bf16_t* d = c.MK() + (size_t)tok * MKW + 64 + 8 * half;
#pragma unroll
                  for (int hd = 0; hd < 4; ++hd) { *(u32x4*)(d + hd * 160) = w1v; *(u32x4*)(d + hd * 160 + 16) = w2v; }
              } }
            f32x16 acc[2][2]; zero_acc(acc);
            gemm_reg(acc, c.P() + (size_t)(128 * mt) * PW + C_CKV, PW, c.W() + W_UKV + (size_t)(128 * ct) * 128, 128, 128, c.lds);
            bf16_t* dst = c.MK() + (size_t)(128 * mt) * MKW + ct * 160 + (wc ? 96 : 0);
#pragma unroll
            for (int mi = 0; mi < 2; ++mi) { const float sc = rstd[64 * wr + 32 * mi + r];
#pragma unroll
                for (int ni = 0; ni < 2; ++ni)
#pragma unroll
                    for (int g = 0; g < 4; g += 2) {
                        u32x2 wa, wb; wa[0] = cvtpk(acc[mi][ni][4 * g] * sc, acc[mi][ni][4 * g + 1] * sc); wa[1] = cvtpk(acc[mi][ni][4 * g + 2] * sc, acc[mi][ni][4 * g + 3] * sc);
                        wb[0] = cvtpk(acc[mi][ni][4 * g + 4] * sc, acc[mi][ni][4 * g + 5] * sc); wb[1] = cvtpk(acc[mi][ni][4 * g + 6] * sc, acc[mi][ni][4 * g + 7] * sc);
                        store_pair16(dst + (size_t)(64 * wr + 32 * mi + r) * MKW + 32 * ni + 8 * g, wa, wb, h);
                    } }
        }
    }
}

DI void phase_prep2(const Ctx& c) {
    const int tid = opaque_tid(), lane = tid & 63, w = tid >> 6, r = lane & 31, h = lane >> 5, wr = w >> 1, wc = w & 1;
    const int srow = tid >> 3, scol = (tid & 7) * 8;
    for (int item = blockIdx.x; item < 32; item += gridDim.x) {
        const int kv = item >> 4, mt = item & 15;
        f32x16 acc[2][2]; zero_acc(acc);
        gemm_reg(acc, c.HC() + (size_t)kv * 2048 * 128 + (size_t)(128 * mt) * 128, 128, c.W() + W_PHI2 + (size_t)kv * 128 * 128, 128, 128, c.lds);
        if (wc == 0) {
            bf16_t* dst = c.KC() + (size_t)kv * 2048 * 64 + (size_t)(128 * mt) * 64;
#pragma unroll
            for (int mi = 0; mi < 2; ++mi)
#pragma unroll
                for (int ni = 0; ni < 2; ++ni)
#pragma unroll
                    for (int g = 0; g < 4; ++g) {
                        u32x2 wv; wv[0] = cvtpk(acc[mi][ni][4 * g], acc[mi][ni][4 * g + 1]); wv[1] = cvtpk(acc[mi][ni][4 * g + 2], acc[mi][ni][4 * g + 3]);
                        *(u32x2*)(dst + (size_t)(64 * wr + 32 * mi + r) * 64 + 32 * ni + 8 * g + 4 * h) = wv;
                    }
        }
    }
}

DI void sb_item(const Ctx& c, int b, int head, int qt) {
    const int tid = opaque_tid(), lane = tid & 63, w = tid >> 6, r = lane & 31, h = lane >> 5;
    const int q0 = 128 * qt, qpos = q0 + 32 * w + r; const size_t tok = (size_t)b * S + qpos;
    bf16x8 qf[4]; load_q64(qf, c.P() + tok * PW + C_SBQ + head * 64, tid);
    const bf16_t* kbase = c.P() + (size_t)b * S * PW + C_SBK + head * 64; const bf16_t* vbase = c.P() + (size_t)b * S * PW + C_SBV + head * 64;
    volatile int* flags = (volatile int*)(c.lds + 40960);
    f32x16 o[2]; o[0] = zero16(); o[1] = zero16();
    float carry = 0.f;
    const int t_top = 2 * qt + 1;
    KVRegs<64> R; kv_load<64>(R, kbase, PW, vbase, PW, t_top, S - 1, tid);
    for (int t = t_top; t >= 0; --t) {
        __syncthreads();
        if (t != t_top) { const int any = flags[0] | flags[1] | flags[2] | flags[3]; if (!any) break; }
        kv_store<64>(R, c.lds, tid);
        __syncthreads();
        if (t > 0) kv_load<64>(R, kbase, PW, vbase, PW, t - 1, S - 1, tid);
        f32x16 s[2];
        qk_tile<64>(s, qf, c.lds, tid);
        const int lim = qpos - 64 * t - 4 * h;
#pragma unroll
        for (int kh = 1; kh >= 0; --kh) {
            float G[4], Go[4], lkv[16];
#pragma unroll
            for (int g = 0; g < 4; ++g) { G[g] = 0.f;
#pragma unroll
                for (int e = 0; e < 4; ++e) { const int i = 4 * g + e; const int koff = 32 * kh + 8 * g + e;
                    const float z = s[kh][i] * 0.125f; const float az = fabsf(z);
                    const float sp = fmaxf(z, 0.f) + LN2 * lg2(1.f + ex2(-az * LOG2E));
                    const float lk = koff < lim ? -sp : 0.f;
                    lkv[i] = lk; s[kh][i] = z; G[g] += lk; } }
#pragma unroll
            for (int g = 0; g < 4; ++g) Go[g] = __shfl_xor(G[g], 32);
            float tot = 0.f, gs[4];
#pragma unroll
            for (int g = 3; g >= 0; --g) { gs[g] = tot + (h == 0 ? Go[g] : 0.f); tot += G[g] + Go[g]; }
#pragma unroll
            for (int g = 0; g < 4; ++g) { float insuf = 0.f;
#pragma unroll
                for (int e = 3; e >= 0; --e) { const int i = 4 * g + e; const int koff = 32 * kh + 8 * g + e;
                    const bool valid = koff < lim;
                    const float a = valid ? ex2((s[kh][i] + lkv[i] + carry + gs[g] + insuf) * LOG2E) : 0.f;
                    insuf += lkv[i]; s[kh][i] = a; } }
            carry += tot;
        }
        pv_tile<64>(o, s, c.lds, tid);
        const int act = __any(carry >= -104.f);
        if (lane == 0) flags[w] = act;
    }
    write_o(c.OB() + tok * OBW + 0 + head * 64, o, tid);
}

DI void moba_sel_item(const Ctx& c, int bhblk, int chunk) {
    const int tid = opaque_tid(), lane = tid & 63, w = tid >> 6, r = lane & 31, h = lane >> 5;
    const int bh = bhblk >> 5, blk = bhblk & 31, b = bh >> 2, head = bh & 3;
    const int cnt = (int)c.CTL()[CW_MB + (512 * c.layer + bhblk) * 64];
    int e = chunk * 128 + 32 * w + r; const bool live = e < cnt; e = live ? e : cnt - 1;
    const unsigned ent = c.MBLIST()[(size_t)bhblk * 8192 + e];
    const int qpos = ent & 0x1FFF, slot = ent >> 13;
    const bf16_t* qrow = c.P() + ((size_t)b * S + qpos) * PW + C_MBQ + head * 64;
    bf16x8 qf[4]; load_q64(qf, qrow, tid);
    PolRoute pol; pol.qpos = qpos; pol.sc2 = 0.125f * LOG2E; pol.sl2 = exp2f(-2.f * (float)(head + 1)) * LOG2E; pol.h4 = 4 * h; pol.base = 0.f;
    float m = -1e30f, l = 0.f; f32x16 o[2]; o[0] = zero16(); o[1] = zero16();
    const bf16_t* kbase = c.P() + (size_t)b * S * PW + C_MBK + head * 64; const bf16_t* vbase = c.P() + (size_t)b * S * PW + C_MBV + head * 64;
    flash_pass<64, true, false>(qf, kbase, PW, vbase, PW, S - 1, 4 * blk, 4 * blk + 4, NeedAll(), 1 << 30, pol, m, l, o, c.lds, tid);
    l += __shfl_xor(l, 32);
    const float inv = 1.f / l;
#pragma unroll
    for (int i = 0; i < 16; ++i) { o[0][i] *= inv; o[1][i] *= inv; }
    if (live) {
        unsigned char* rec = c.MBPART() + ((size_t)(bh * S + qpos) * 3 + slot) * 144;
        if (h == 0) { f32x2 ml = {m, l}; *(f32x2*)rec = ml; }
        write_o_bf16((bf16_t*)(rec + 16), o, tid);
    }
}
DI void moba_own_item(const Ctx& c, int b, int head, int qt) {
    const int tid = opaque_tid(), lane = tid & 63, w = tid >> 6, r = lane & 31, h = lane >> 5;
    const int q0 = 128 * qt, own = q0 >> 8, qpos = q0 + 32 * w + r, bh = b * 4 + head; const size_t tok = (size_t)b * S + qpos;
    const bf16_t* qrow = c.P() + tok * PW + C_MBQ + head * 64;
    bf16x8 qf[4]; load_q64(qf, qrow, tid);
    PolMoba pol; pol.qpos = qpos; pol.sc2 = 0.125f * LOG2E; pol.sl2 = exp2f(-2.f * (float)(head + 1)) * LOG2E; pol.mask = 1u << own; pol.lim = -1; pol.h4 = 4 * h; pol.base = 0.f;
    float m = -1e30f, l = 0.f; f32x16 o[2]; o[0] = zero16(); o[1] = zero16();
    const bf16_t* kbase = c.P() + (size_t)b * S * PW + C_MBK + head * 64; const bf16_t* vbase = c.P() + (size_t)b * S * PW + C_MBV + head * 64;
    flash_pass<64, true, false>(qf, kbase, PW, vbase, PW, S - 1, 4 * own, 2 * qt + 2, NeedAll(), (q0 + 32 * w + 31) >> 6, pol, m, l, o, c.lds, tid);
    l += __shfl_xor(l, 32);
    const unsigned sel = c.MBSEL()[(size_t)bh * S + qpos];
    const unsigned char* rec0 = c.MBPART() + (size_t)(bh * S + qpos) * 3 * 144;
    float mk[3], lk[3]; float M = m;
#pragma unroll
    for (int k = 0; k < 3; ++k) { const bool on = ((sel >> (8 * k)) & 255u) != 255u; const f32x2 ml = on ? *(const f32x2*)(rec0 + k * 144) : (f32x2){-1e30f, 0.f}; mk[k] = ml[0]; lk[k] = ml[1]; M = fmaxf(M, mk[k]); }
    const float wown = ex2(m - M); float den = l * wown;
#pragma unroll
    for (int i = 0; i < 16; ++i) { o[0][i] *= wown; o[1][i] *= wown; }
#pragma unroll
    for (int k = 0; k < 3; ++k) {
        const float wk = lk[k] * ex2(mk[k] - M); den += wk;
        if (((sel >> (8 * k)) & 255u) != 255u) {
            const bf16_t* ok = (const bf16_t*)(rec0 + k * 144 + 16);
#pragma unroll
            for (int db = 0; db < 2; ++db)
#pragma unroll
                for (int g = 0; g < 4; ++g) { const u32x2 v = *(const u32x2*)(ok + 32 * db + 8 * g + 4 * h);
                    o[db][4 * g] += wk * bflo(v[0]); o[db][4 * g + 1] += wk * bfhi(v[0]); o[db][4 * g + 2] += wk * bflo(v[1]); o[db][4 * g + 3] += wk * bfhi(v[1]); }
        }
    }
    const float inv = 1.f / den;
#pragma unroll
    for (int i = 0; i < 16; ++i) { o[0][i] *= inv; o[1][i] *= inv; }
    write_o(c.OB() + tok * OBW + 256 + head * 64, o, tid);
}
DI void phase_attn_b(const Ctx& c) {
    for (int item = blockIdx.x; item < 1024; item += gridDim.x) { __syncthreads(); moba_own_item(c, (item >> 2) & 3, item & 3, item >> 4); }
}

DI void mla_item(const Ctx& c, int b, int head, int qt) {
    const int tid = opaque_tid(), lane = tid & 63, w = tid >> 6, r = lane & 31, h = lane >> 5;
    const int q0 = 128 * qt, qpos = q0 + 32 * w + r; const size_t tok = (size_t)b * S + qpos;
    const bf16_t* qrow = c.QM() + tok * QMW + head * 96;
    bf16x8 qf[6];
#pragma unroll
    for (int ks = 0; ks < 6; ++ks) qf[ks] = *(const bf16x8*)(qrow + 16 * ks + 8 * h);
    {
        float o1[8], o2[8];
#pragma unroll
        for (int j = 0; j < 8; ++j) { const int i = 8 * h + j; const float fr = ex2(-(float)i * (13.287712379549449f / 16.f)) * 0.15915494309189535f;
            const float tt = (float)qpos * fr; const float ph = tt - floorf(tt); const float sn = __builtin_amdgcn_sinf(ph), cs = __builtin_amdgcn_cosf(ph);
            const float a = bf2f((unsigned short)qf[4][j]), bq = bf2f((unsigned short)qf[5][j]);
            o1[j] = a * cs - bq * sn; o2[j] = a * sn + bq * cs; }
        u32x4 w1v, w2v;
#pragma unroll
        for (int j = 0; j < 4; ++j) { w1v[j] = cvtpk(o1[2 * j], o1[2 * j + 1]); w2v[j] = cvtpk(o2[2 * j], o2[2 * j + 1]); }
        qf[4] = __builtin_bit_cast(bf16x8, w1v); qf[5] = __builtin_bit_cast(bf16x8, w2v);
    }
    PolCausal pol; pol.qpos = qpos; pol.lim = -1; pol.h4 = 4 * h; pol.sc2 = 0.10206207261596577f * LOG2E;
    float m = -1e30f, l = 0.f; f32x16 o[2]; o[0] = zero16(); o[1] = zero16();
    const bf16_t* kbase = c.MK() + (size_t)b * S * MKW + head * 160; const bf16_t* vbase = kbase + 96;
    flash_pass<96, true, MLA_PRE>(qf, kbase, MKW, vbase, MKW, S - 1, 0, 2 * qt + 2, NeedAll(), (q0 + 32 * w + 31) >> 6, pol, m, l, o, c.lds, tid);
    l += __shfl_xor(l, 32);
    const float inv = 1.f / l;
#pragma unroll
    for (int i = 0; i < 16; ++i) { o[0][i] *= inv; o[1][i] *= inv; }
    write_o(c.OB() + tok * OBW + 512 + head * 64, o, tid);
}

DI void mem_item(const Ctx& c, int b, int head, int qt) {
    const int tid = opaque_tid(), lane = tid & 63, w = tid >> 6, r = lane & 31;
    const int q0 = 128 * qt, qpos = q0 + 32 * w + r; const size_t tok = (size_t)b * S + qpos;
    bf16x8 qf[4]; load_q64(qf, c.P() + tok * PW + C_QM + head * 64, tid);
    PolMem pol; pol.sc2 = 0.125f * LOG2E;
    float m = -1e30f, l = 0.f; f32x16 o[2]; o[0] = zero16(); o[1] = zero16();
    const bf16_t* kbase = c.MEMKV() + (size_t)b * 256 * 512 + head * 64; const bf16_t* vbase = kbase + 256;
    flash_pass<64, true, true>(qf, kbase, 512, vbase, 512, 255, 0, 4, NeedAll(), 1 << 30, pol, m, l, o, c.lds, tid);
    l += __shfl_xor(l, 32);
    const float inv = 1.f / l;
#pragma unroll
    for (int i = 0; i < 16; ++i) { o[0][i] *= inv; o[1][i] *= inv; }
    write_o(c.OB() + tok * OBW + 1024 + head * 64, o, tid);
}

DI void nsa_item(const Ctx& c, int b, int qg) {
    const int tid = opaque_tid(), lane = tid & 63, w = tid >> 6, r = lane & 31, h = lane >> 5;
    const int head = w, q0 = 32 * qg, qpos = q0 + r; const size_t tok = (size_t)b * S + qpos;
    constexpr int IP = 130;
    unsigned* imp = (unsigned*)(c.lds + 24576);
    unsigned* selm = (unsigned*)(c.lds + 41216);
    unsigned* uni = (unsigned*)(c.lds + 41728);
    __syncthreads();
    for (int i = tid; i < 32 * IP; i += NTHR) imp[i] = 0u;
    if (tid < 128) selm[tid] = 0u;
    if (tid < 4) uni[tid] = 0u;
    bf16x8 qf[4]; load_q64(qf, c.P() + tok * PW + C_NQ + head * 64, tid);
    const float sc2 = 0.125f * LOG2E, sl2 = exp2f(-2.f * (float)(head + 1)) * LOG2E;
    const bf16_t* grow = c.P() + tok * PW + C_GN + head * 3;
    const float g0 = 1.f / (1.f + ex2(-bf2f(grow[0]) * LOG2E)), g1 = 1.f / (1.f + ex2(-bf2f(grow[1]) * LOG2E)), g2 = 1.f / (1.f + ex2(-bf2f(grow[2]) * LOG2E));
    float* stash0 = (float*)(c.ws() + WS_STASH) + (size_t)blockIdx.x * 8192 + tid * 32;
    const bf16_t* Pb = c.P() + (size_t)b * S * PW;
    const int nct = ((2 * qg) >> 6) + 1;
    const bf16_t* kc = c.KC() + (size_t)b * 512 * 64; const bf16_t* vc = c.KC() + (size_t)2048 * 64 + (size_t)b * 512 * 64;
    float m_c, inv_c;
    {
        PolCmp pol; pol.qpos = qpos; pol.sc2 = sc2; pol.sl2 = sl2; pol.lim = -1; pol.h4 = 4 * h; pol.base = 0.f;
        float m = -1e30f, l = 0.f; f32x16 o[2]; o[0] = zero16(); o[1] = zero16();
        flash_pass<64, false, NSA_PRE>(qf, kc, 64, vc, 64, 510, 0, nct, NeedAll(), 1 << 30, pol, m, l, o, c.lds, tid);
        l += __shfl_xor(l, 32);
        const bool has = m > -0.5e30f;
        inv_c = has ? 1.f / l : 0.f; m_c = m;
        const float f = inv_c * g0;
        __attribute__((address_space(1))) float* stash = (__attribute__((address_space(1))) float*)stash0; asm volatile("" : "+v"(stash));
#pragma unroll
        for (int i = 0; i < 16; ++i) { stash[i] = o[0][i] * f; stash[16 + i] = o[1][i] * f; }
        KVRegs<64> R; kv_load<64>(R, kc, 64, vc, 64, 0, 510, tid);
        for (int t = 0; t < nct; ++t) {
            __syncthreads();
            kv_store<64>(R, c.lds, tid);
            __syncthreads();
            if (t + 1 < nct) kv_load<64>(R, kc, 64, vc, 64, t + 1, 510, tid);
            f32x16 s[2]; qk_tile<64>(s, qf, c.lds, tid); pol.prep(t);
#pragma unroll
            for (int kh = 0; kh < 2; ++kh)
#pragma unroll
                for (int g = 0; g < 4; ++g) {
                    float p4[4];
#pragma unroll
                    for (int e = 0; e < 4; ++e) p4[e] = ex2(pol.score(s[kh][4 * g + e], 32 * kh + 8 * g + e) - m_c) * inv_c;
                    const int sb = 16 * t + 8 * kh + 2 * g + h;
                    const float sum4 = (p4[0] + p4[1]) + (p4[2] + p4[3]);
                    atomicAdd(&imp[r * IP + sb], (unsigned)(sum4 * 268435456.f + 0.5f));
                    if (sb + 1 < 128) atomicAdd(&imp[r * IP + sb + 1], (unsigned)(p4[3] * 268435456.f + 0.5f));
                }
        }
    }
    __syncthreads();
    {
        const int qi = tid >> 3, sub = tid & 7; const int cur = (q0 + qi) >> 6;
        for (int half = 0; half < 2; ++half) {
            unsigned cs[8]; int rank[8];
#pragma unroll
            for (int k = 0; k < 8; ++k) { const int sidx = sub + 8 * (8 * half + k); cs[k] = (sidx == 0 || sidx == cur) ? 0xffffffffu : imp[qi * IP + (sidx & 127)]; rank[k] = 0; }
            if (sub + 64 * half > cur) break;
            for (int sp = 0; sp <= cur; ++sp) {
                const unsigned v = (sp == 0 || sp == cur) ? 0xffffffffu : imp[qi * IP + sp];
#pragma unroll
                for (int k = 0; k < 8; ++k) { const int sidx = sub + 8 * (8 * half + k); rank[k] += (v > cs[k] || (v == cs[k] && sp < sidx)) ? 1 : 0; }
            }
#pragma unroll
            for (int k = 0; k < 8; ++k) { const int sidx = sub + 8 * (8 * half + k);
                if (sidx <= cur && rank[k] < 16) { atomicOr(&selm[qi * 4 + (sidx >> 5)], 1u << (sidx & 31)); atomicOr(&uni[sidx >> 5], 1u << (sidx & 31)); } }
        }
    }
    __syncthreads();
    {
        PolSel pol; pol.qpos = qpos; pol.sc2 = sc2; pol.sl2 = sl2; pol.mlo = (unsigned long long)selm[r * 4] | ((unsigned long long)selm[r * 4 + 1] << 32); pol.mhi = (unsigned long long)selm[r * 4 + 2] | ((unsigned long long)selm[r * 4 + 3] << 32); pol.lim = -1; pol.h4 = 4 * h; pol.base = 0.f;
        NeedBits128 need; need.lo = (unsigned long long)uni[0] | ((unsigned long long)uni[1] << 32); need.hi = (unsigned long long)uni[2] | ((unsigned long long)uni[3] << 32);
        float m = -1e30f, l = 0.f; f32x16 o[2]; o[0] = zero16(); o[1] = zero16();
        flash_pass<64, true, NSA_PRE>(qf, Pb + C_NKV + 128, PW, Pb + C_NKV + 192, PW, S - 1, 0, (q0 >> 6) + 1, need, 1 << 30, pol, m, l, o, c.lds, tid);
        l += __shfl_xor(l, 32);
        const float f = g1 / l;
        __attribute__((address_space(1))) float* stash = (__attribute__((address_space(1))) float*)stash0; asm volatile("" : "+v"(stash));
#pragma unroll
        for (int i = 0; i < 16; ++i) { stash[i] += o[0][i] * f; stash[16 + i] += o[1][i] * f; }
    }
    {
        PolWin pol; pol.qpos = qpos; pol.sc2 = sc2; pol.sl2 = sl2; pol.lim = -1; pol.h4 = 4 * h; pol.base = 0.f;
        const int lo = q0 - 511; const int t_lo = lo > 0 ? (lo >> 6) : 0;
        float m = -1e30f, l = 0.f; f32x16 o[2]; o[0] = zero16(); o[1] = zero16();
        flash_pass<64, true, NSA_PRE>(qf, Pb + C_NKV + 256, PW, Pb + C_NKV + 320, PW, S - 1, t_lo, (q0 >> 6) + 1, NeedAll(), 1 << 30, pol, m, l, o, c.lds, tid);
        l += __shfl_xor(l, 32);
        const float f = g2 / l;
        __attribute__((address_space(1))) float* stash = (__attribute__((address_space(1))) float*)stash0; asm volatile("" : "+v"(stash));
#pragma unroll
        for (int i = 0; i < 16; ++i) { o[0][i] = stash[i] + o[0][i] * f; o[1][i] = stash[16 + i] + o[1][i] * f; }
        write_o(c.OB() + tok * OBW + 768 + head * 64, o, tid);
    }
}

DI void phase_attn(const Ctx& c) {
    unsigned* qhead = c.CTL() + CW_Q + 16 * c.layer + c.qslot;
    volatile int* slot = (volatile int*)(c.lds + 41984);
    int* pre = (int*)(c.lds + LDS_MISC);
    {
        const int tid = opaque_tid();
        __syncthreads();
        if (tid < 64) {
            const unsigned* cnt = c.CTL() + CW_MB + (512 * c.layer + 8 * tid) * 64;
            int loc[8], s = 0;
#pragma unroll
            for (int i = 0; i < 8; ++i) { loc[i] = s; s += ((int)cnt[64 * i] + 127) >> 7; }
            int incl = s;
#pragma unroll
            for (int o = 1; o < 64; o <<= 1) { const int v = __shfl_up(incl, o); if (tid >= o) incl += v; }
            const int excl = incl - s;
#pragma unroll
            for (int i = 0; i < 8; ++i) pre[8 * tid + i] = excl + loc[i];
            if (tid == 63) pre[512] = incl;
        }
        __syncthreads();
    }
    const int nsel = pre[512];
    for (;;) {
        __syncthreads();
        if (threadIdx.x == 0) *slot = (int)__hip_atomic_fetch_add(qhead, 1u, __ATOMIC_RELAXED, __HIP_MEMORY_SCOPE_AGENT);
        __syncthreads();
        const int item = __builtin_amdgcn_readfirstlane(*slot);
        if (item >= 4096 + nsel) break;
        if (item < 1024) { nsa_item(c, item & 3, 255 - (item >> 2)); }
        else if (item < 2048) { const int j = item - 1024; mla_item(c, (j >> 2) & 3, j & 3, 63 - (j >> 4)); }
        else if (item < 2048 + nsel) {
            const int idx = item - 2048; int lo = 0, hi = 511;
            while (lo < hi) { const int mid = (lo + hi + 1) >> 1; if (pre[mid] <= idx) lo = mid; else hi = mid - 1; }
            moba_sel_item(c, lo, idx - pre[lo]);
        }
        else if (item < 3072 + nsel) { const int j = item - 2048 - nsel; mem_item(c, (j >> 2) & 3, j & 3, j >> 4); }
        else { const int j = item - 3072 - nsel; sb_item(c, (j >> 2) & 3, j & 3, j >> 4); }
    }
}

DI void phase_gate(const Ctx& c) {
    const int tid = opaque_tid(), lane = tid & 63, w = tid >> 6, r = lane & 31, h = lane >> 5, wr = w >> 1, wc = w & 1;
    const int srow = tid >> 3, scol = (tid & 7) * 8; const int l = c.layer;
    for (int k = 0;; ++k) {
        int mt, nt; if (!xcd_item(k, 256, 8, mt, nt)) break;
        unsigned mgp[2][2][8];
#pragma unroll
        for (int mi = 0; mi < 2; ++mi)
#pragma unroll
            for (int ni = 0; ni < 2; ++ni)
#pragma unroll
                for (int k = 0; k < 8; ++k) mgp[mi][ni][k] = 0u;
        for (int i = 0; i < 5; ++i) {
            unsigned brp[2][2][8];
            {
                f32x16 br[2][2]; zero_acc(br);
                { int rowE, cbE, cbO; dma_lane(tid, rowE, cbE, cbO);
                  const char* a8 = (const char*)c.OB() + (size_t)(128 * mt + rowE) * OBW + 256 * i;
                  const char* b8 = (const char*)(c.W() + W_BR) + (size_t)i * 1024 * 256 + (size_t)(128 * nt + rowE) * 256;
                  gemm_dma<2, true, NoNext, 122, 123>(br, a8 + cbE, a8 + 8 * OBW + cbO, nullptr, nullptr, 16 * OBW, 128, b8 + cbE, b8 + 8 * 256 + cbO, 16 * 256, 2, c.lds); }
#pragma unroll
                for (int mi = 0; mi < 2; ++mi)
#pragma unroll
                    for (int ni = 0; ni < 2; ++ni)
#pragma unroll
                        for (int k = 0; k < 8; ++k) brp[mi][ni][k] = cvtpk(br[mi][ni][2 * k], br[mi][ni][2 * k + 1]);
            }
            f32x16 ga[2][2]; zero_acc(ga);
            { int rowE, cbE, cbO; dma_lane(tid, rowE, cbE, cbO);
              const char* a8 = (const char*)(c.HB8() + (size_t)(128 * mt + rowE) * 1024);
              const char* b8 = (const char*)(c.W() + W_G) + (size_t)i * 1024 * 1024 + (size_t)(128 * nt + rowE) * 1024;
              gemm_dma<2, true, NoNext, 122, 127>(ga, a8 + cbE, a8 + 8 * 1024 + cbO, nullptr, nullptr, 16 * 1024, 128, b8 + cbE, b8 + 8 * 1024 + cbO, 16 * 1024, 8, c.lds); }
            const float* bg = c.in(15) + ((size_t)l * 5 + i) * 1024 + 128 * nt + 64 * wc + 4 * h;
#pragma unroll
            for (int ni = 0; ni < 2; ++ni)
#pragma unroll
                for (int g = 0; g < 4; ++g) {
                    f32x4 bv = *(const f32x4*)(bg + 32 * ni + 8 * g);
#pragma unroll
                    for (int e = 0; e < 4; ++e) bv[e] *= -LOG2E;
#pragma unroll
                    for (int mi = 0; mi < 2; ++mi)
#pragma unroll
                        for (int e2 = 0; e2 < 2; ++e2) {
                            const float g0 = rcpf_(1.f + ex2(fmaf(ga[mi][ni][4 * g + 2 * e2], -LOG2E, bv[2 * e2])));
                            const float g1 = rcpf_(1.f + ex2(fmaf(ga[mi][ni][4 * g + 2 * e2 + 1], -LOG2E, bv[2 * e2 + 1])));
                            const unsigned pb = brp[mi][ni][2 * g + e2], pm = mgp[mi][ni][2 * g + e2];
                            mgp[mi][ni][2 * g + e2] = cvtpk(bflo(pm) + g0 * bflo(pb), bfhi(pm) + g1 * bfhi(pb));
                        }
                }
        }
        unsigned char* dst = (unsigned char*)c.MG() + (size_t)(128 * mt) * 1024 + 128 * nt;
#pragma unroll
        for (int mi = 0; mi < 2; ++mi)
#pragma unroll
            for (int ni = 0; ni < 2; ++ni)
#pragma unroll
                for (int g = 0; g < 4; g += 2) {
                    const unsigned p0 = mgp[mi][ni][2 * g], p1 = mgp[mi][ni][2 * g + 1], p2 = mgp[mi][ni][2 * g + 2], p3 = mgp[mi][ni][2 * g + 3];
                    store_pair8(dst + (size_t)(64 * wr + 32 * mi + r) * 1024 + 64 * wc + 32 * ni + 8 * g, pk4_fp8(8.f * bflo(p0), 8.f * bfhi(p0), 8.f * bflo(p1), 8.f * bfhi(p1)),
                                pk4_fp8(8.f * bflo(p2), 8.f * bfhi(p2), 8.f * bflo(p3), 8.f * bfhi(p3)), h);
                }
    }
}

DI void phase_out(const Ctx& c) {
    const int tid = opaque_tid(), lane = tid & 63, w = tid >> 6, r = lane & 31, h = lane >> 5, wr = w >> 1, wc = w & 1;
    const int srow = tid >> 3, scol = (tid & 7) * 8;
    bf16_t* yb = c.YB();
    int mt, nt; bool have = xcd_item(0, 256, 8, mt, nt);
    for (int k = 0; have; ++k) {
        int mt2 = 0, nt2 = 0; const bool have2 = xcd_item(k + 1, 256, 8, mt2, nt2);
        f32x16 acc[2][2]; zero_acc(acc);
        { int rowE, cbE, cbO; dma_lane(tid, rowE, cbE, cbO);
          const char* a8 = (const char*)c.MG() + (size_t)(128 * mt + rowE) * 1024;
          const char* b8 = (const char*)(c.W() + W_OUT) + (size_t)(128 * nt + rowE) * 1024;
          const NextSt nx = next_reg((const char*)c.MG() + (size_t)(128 * mt2) * 1024, 1024, (const char*)(c.W() + W_OUT) + (size_t)(128 * nt2) * 1024, 1024, have2, tid);
          gemm_dma<2, true, NextSt, 121, 124>(acc, a8 + cbE, a8 + 8 * 1024 + cbO, nullptr, nullptr, 16 * 1024, 128, b8 + cbE, b8 + 8 * 1024 + cbO, 16 * 1024, 8, c.lds, k ? 8 : 0, nx); }
#pragma unroll
        for (int mi = 0; mi < 2; ++mi)
#pragma unroll
            for (int ni = 0; ni < 2; ++ni)
#pragma unroll
                for (int g = 0; g < 4; g += 2) {
                    const size_t off = (size_t)(128 * mt + 64 * wr + 32 * mi + r) * 1024 + 128 * nt + 64 * wc + 32 * ni + 8 * g;
                    u32x2 oa, ob; oa[0] = cvtpk(acc[mi][ni][4 * g], acc[mi][ni][4 * g + 1]); oa[1] = cvtpk(acc[mi][ni][4 * g + 2], acc[mi][ni][4 * g + 3]);
                    ob[0] = cvtpk(acc[mi][ni][4 * g + 4], acc[mi][ni][4 * g + 5]); ob[1] = cvtpk(acc[mi][ni][4 * g + 6], acc[mi][ni][4 * g + 7]);
                    store_pair16(yb + off, oa, ob, h);
                }
        mt = mt2; nt = nt2; have = have2;
    }
}

template <bool ROUTE> DI void phase_ln(const Ctx& c) {
    const int tid = opaque_tid(), lane = tid & 63, w = tid >> 6; const int l = c.layer;
    float* out = c.outp(); const bf16_t* yb = c.YB();
    const float* hs = (ROUTE && l == 0) ? c.in(0) : out;
    const float* gam = c.in(ROUTE ? 17 : 25) + l * 1024; const float* bet = c.in(ROUTE ? 18 : 26) + l * 1024;
#define LNCOL(j) (4 * lane + 256 * (j))
    f32x4 gv[4], bv[4];
#pragma unroll
    for (int j = 0; j < 4; ++j) { gv[j] = *(const f32x4*)(gam + LNCOL(j)); bv[j] = *(const f32x4*)(bet + LNCOL(j)); }
    constexpr int RB = 4;
    const int gw = blockIdx.x * 4 + w, nw = gridDim.x * 4;
    for (int row0 = gw * RB; row0 < T; row0 += nw * RB) {
        f32x4 x[RB][4];
#pragma unroll
        for (int q = 0; q < RB; ++q)
#pragma unroll
            for (int j = 0; j < 4; ++j) { const size_t o_ = (size_t)(row0 + q) * 1024 + LNCOL(j);
                const u32x2 raw = *(const u32x2*)(yb + o_); const f32x4 h0 = *(const f32x4*)(hs + o_);
                x[q][j][0] = ALPHA * h0[0] + bf_lo(raw[0]); x[q][j][1] = ALPHA * h0[1] + bf_hi(raw[0]); x[q][j][2] = ALPHA * h0[2] + bf_lo(raw[1]); x[q][j][3] = ALPHA * h0[3] + bf_hi(raw[1]); }
        float mean[RB], rs[RB];
#pragma unroll
        for (int q = 0; q < RB; ++q) { float s = 0.f;
#pragma unroll
            for (int j = 0; j < 4; ++j) s += (x[q][j][0] + x[q][j][1]) + (x[q][j][2] + x[q][j][3]);
            mean[q] = s; }
#pragma unroll
        for (int o = 32; o >= 1; o >>= 1)
#pragma unroll
            for (int q = 0; q < RB; ++q) mean[q] += __shfl_xor(mean[q], o);
#pragma unroll
        for (int q = 0; q < RB; ++q) { mean[q] *= (1.f / 1024.f); float v = 0.f;
#pragma unroll
            for (int j = 0; j < 4; ++j)
#pragma unroll
                for (int e = 0; e < 4; ++e) { const float d = x[q][j][e] - mean[q]; v += d * d; }
            rs[q] = v; }
#pragma unroll
        for (int o = 32; o >= 1; o >>= 1)
#pragma unroll
            for (int q = 0; q < RB; ++q) rs[q] += __shfl_xor(rs[q], o);
#pragma unroll
        for (int q = 0; q < RB; ++q) {
            const float r = __builtin_amdgcn_rsqf(rs[q] * (1.f / 1024.f) + 1e-5f); const size_t ro = (size_t)(row0 + q) * 1024;
#pragma unroll
            for (int j = 0; j < 4; ++j) {
#pragma unroll
                for (int e = 0; e < 4; ++e) x[q][j][e] = (x[q][j][e] - mean[q]) * r * gv[j][e] + bv[j][e];
                *(f32x4*)(out + ro + LNCOL(j)) = x[q][j];
                *(unsigned*)(c.HB8() + ro + LNCOL(j)) = pk4_fp8(x[q][j][0], x[q][j][1], x[q][j][2], x[q][j][3]);
            }
        }
        if (ROUTE) {
            const float* wrg = c.in(19) + (size_t)l * 1024 * 4;
            float gl[RB][4];
#pragma unroll
            for (int q = 0; q < RB; ++q)
#pragma unroll
                for (int g = 0; g < 4; ++g) gl[q][g] = 0.f;
#pragma unroll
            for (int j = 0; j < 4; ++j)
#pragma unroll
                for (int e = 0; e < 4; ++e) { const f32x4 wv = *(const f32x4*)(wrg + (size_t)(LNCOL(j) + e) * 4);
#pragma unroll
                    for (int q = 0; q < RB; ++q)
#pragma unroll
                        for (int g = 0; g < 4; ++g) gl[q][g] += x[q][j][e] * wv[g]; }
#pragma unroll
            for (int o = 32; o >= 1; o >>= 1)
#pragma unroll
                for (int q = 0; q < RB; ++q)
#pragma unroll
                    for (int g = 0; g < 4; ++g) gl[q][g] += __shfl_xor(gl[q][g], o);
            int gsel[RB]; float pg_sel[RB];
            const f32x4 brg = *(const f32x4*)(c.in(20) + l * 4);
#pragma unroll
            for (int q = 0; q < RB; ++q) {
#pragma unroll
                for (int g = 0; g < 4; ++g) gl[q][g] += brg[g];
                int gs = 0; float gmax = gl[q][0];
#pragma unroll
                for (int g = 1; g < 4; ++g) if (gl[q][g] > gmax) { gmax = gl[q][g]; gs = g; }
                float gsum = 0.f;
#pragma unroll
                for (int g = 0; g < 4; ++g) gsum += ex2((gl[q][g] - gmax) * LOG2E);
                gsel[q] = gs; pg_sel[q] = rcpf_(gsum);
            }
            float el[RB][4];
#pragma unroll
            for (int q = 0; q < RB; ++q) {
                const float* wre = c.in(21) + ((size_t)l * 4 + gsel[q]) * 1024 * 4;
#pragma unroll
                for (int g = 0; g < 4; ++g) el[q][g] = 0.f;
#pragma unroll
                for (int j = 0; j < 4; ++j)
#pragma unroll
                    for (int e = 0; e < 4; ++e) { const f32x4 wv = *(const f32x4*)(wre + (size_t)(LNCOL(j) + e) * 4);
#pragma unroll
                        for (int g = 0; g < 4; ++g) el[q][g] += x[q][j][e] * wv[g]; }
            }
#pragma unroll
            for (int o = 32; o >= 1; o >>= 1)
#pragma unroll
                for (int q = 0; q < RB; ++q)
#pragma unroll
                    for (int g = 0; g < 4; ++g) el[q][g] += __shfl_xor(el[q][g], o);
            int mybucket = 0; float mywlo = 0.f, mywhi = 0.f;
#pragma unroll
            for (int q = 0; q < RB; ++q) {
                const f32x4 bre = *(const f32x4*)(c.in(22) + (l * 4 + gsel[q]) * 4);
#pragma unroll
                for (int g = 0; g < 4; ++g) el[q][g] += bre[g];
                int e1 = 0; float m1 = el[q][0];
#pragma unroll
                for (int g = 1; g < 4; ++g) if (el[q][g] > m1) { m1 = el[q][g]; e1 = g; }
                int e2 = -1; float m2 = -3e38f;
#pragma unroll
                for (int g = 0; g < 4; ++g) if (g != e1 && el[q][g] > m2) { m2 = el[q][g]; e2 = g; }
                const float p2 = ex2((m2 - m1) * LOG2E);
                const float w1 = pg_sel[q] * rcpf_(1.f + p2), w2 = w1 * p2;
                const int lo = e1 < e2 ? e1 : e2, hi = e1 < e2 ? e2 : e1;
                const float wlo = e1 < e2 ? w1 : w2, whi = e1 < e2 ? w2 : w1;
                const int pidx = lo == 0 ? hi - 1 : (lo == 1 ? hi + 1 : 5);
                if (lane == q) { mybucket = gsel[q] * 6 + pidx; mywlo = wlo; mywhi = whi; }
            }
            if (lane < RB) {
                const unsigned pos = __hip_atomic_fetch_add(c.CTL() + CW_CNT + (32 * l + mybucket) * 64, 1u, __ATOMIC_RELAXED, __HIP_MEMORY_SCOPE_AGENT);
                c.LTOK()[(size_t)mybucket * T + pos] = row0 + lane;
                c.LW()[((size_t)mybucket * T + pos) * 2] = mywlo; c.LW()[((size_t)mybucket * T + pos) * 2 + 1] = mywhi;
            }
        }
    }
}

DI int moe_table(const Ctx& c, int* tab) {
    __syncthreads();
    if (threadIdx.x == 0) { int acc = 0;
        for (int bkt = 0; bkt < 24; ++bkt) { const int n = (int)c.CTL()[CW_CNT + (32 * c.layer + bkt) * 64]; tab[32 + bkt] = n; tab[bkt] = acc; acc += (n + 127) >> 7; }
        tab[24] = acc; }
    __syncthreads();
    return tab[24];
}
DI void moe_decode(const int* tab, int rt, int& bkt, int& r0, int& nvalid, int& elo, int& ehi) {
    int bk = 0;
    for (int i = 0; i < 24; ++i) if (tab[i] <= rt && rt < tab[i + 1]) bk = i;
    bkt = bk; r0 = 128 * (rt - tab[bk]); const int n = tab[32 + bk] - r0; nvalid = n < 128 ? n : 128;
    const int g = bk / 6, pidx = bk % 6;
    const int lo = pidx < 3 ? 0 : (pidx < 5 ? 1 : 2), hi = pidx < 3 ? pidx + 1 : (pidx < 5 ? pidx - 1 : 3);
    elo = g * 4 + lo; ehi = g * 4 + hi;
}
DI void phase_moe_up(const Ctx& c) {
    const int tid = opaque_tid(), lane = tid & 63, w = tid >> 6, r = lane & 31, h = lane >> 5, wr = w >> 1, wc = w & 1;
    const int srow = tid >> 3, scol = (tid & 7) * 8;
    int* tab = (int*)(c.lds + LDS_MISC + 1024);
    const int RT = moe_table(c, tab);
    for (int k = 0;; ++k) {
        int rt, ct; if (!xcd_item(k, RT, 8, rt, ct)) break;
        if (rt >= RT) continue;
        const int es = ct >> 2, q4 = ct & 3;
        int bkt, r0, nvalid, elo, ehi; moe_decode(tab, rt, bkt, r0, nvalid, elo, ehi);
        const int* ltok = c.LTOK() + (size_t)bkt * T + r0;
        int rowE, cbE, cbO; dma_lane(tid, rowE, cbE, cbO);
        const char* ap[4];
#pragma unroll
        for (int i = 0; i < 4; ++i) { int lr = rowE + 8 * i; lr = lr < nvalid ? lr : nvalid - 1; ap[i] = (const char*)(c.HB8() + (size_t)ltok[lr] * 1024) + ((i & 1) ? cbO : cbE); }
        const int e = es ? ehi : elo;
        f32x16 acc[2][2]; zero_acc(acc);
        const char* bp = (const char*)(c.W() + W_UP) + (size_t)e * 512 * 1024 + (size_t)(128 * q4 + rowE) * 1024;
        gemm_dma<2, false, NoNext, 122, 127>(acc, ap[0], ap[1], ap[2], ap[3], 0, 128, bp + cbE, bp + 8 * 1024 + cbO, 16 * 1024, 8, c.lds);
        const float* lw = c.LW() + ((size_t)bkt * T + r0) * 2 + es;
#pragma unroll
        for (int mi = 0; mi < 2; ++mi) {
            int lr = 64 * wr + 32 * mi + r; const int lrc = lr < nvalid ? lr : nvalid - 1;
            const float wt = lw[(size_t)lrc * 2];
            unsigned char* dst = (unsigned char*)c.ACT() + (size_t)(128 * rt + lr) * 512 + es * 256 + 32 * (2 * q4 + wc);
#pragma unroll
            for (int g = 0; g < 4; g += 2) { unsigned pk[2];
#pragma unroll
                for (int gg = 0; gg < 2; ++gg) { float o4[4];
#pragma unroll
                    for (int e4 = 0; e4 < 4; ++e4) { const float a = acc[mi][0][4 * (g + gg) + e4], u = acc[mi][1][4 * (g + gg) + e4]; o4[e4] = a * rcpf_(1.f + ex2(a * -LOG2E)) * u * wt; }
                    pk[gg] = pk4_fp8(16.f * o4[0], 16.f * o4[1], 16.f * o4[2], 16.f * o4[3]); }
                store_pair8(dst + 8 * g, pk[0], pk[1], h); }
        }
    }
}
DI void phase_moe_down(const Ctx& c) {
    const int tid = opaque_tid(), lane = tid & 63, w = tid >> 6, r = lane & 31, h = lane >> 5, wr = w >> 1, wc = w & 1;
    const int srow = tid >> 3, scol = (tid & 7) * 8;
    int* tab = (int*)(c.lds + LDS_MISC + 1024);
    const int RT = moe_table(c, tab);
    bf16_t* yb = c.YB();
    for (int k = 0;; ++k) {
        int rt, nt; if (!xcd_item(k, RT, 8, rt, nt)) break;
        if (rt >= RT) continue;
        int bkt, r0, nvalid, elo, ehi; moe_decode(tab, rt, bkt, r0, nvalid, elo, ehi);
        const int* ltok = c.LTOK() + (size_t)bkt * T + r0;
        f32x16 acc[2][2]; zero_acc(acc);
        for (int es = 0; es < 2; ++es) {
          int rowE, cbE, cbO; dma_lane(opaque_tid(), rowE, cbE, cbO);
          const char* a8 = (const char*)c.ACT() + (size_t)(128 * rt + rowE) * 512 + 256 * es;
          const char* b8 = (const char*)(c.W() + W_DN) + (size_t)(es ? ehi : elo) * 1024 * 256 + (size_t)(128 * nt + rowE) * 256;
          gemm_dma<2, true, NoNext, 122, 123>(acc, a8 + cbE, a8 + 8 * 512 + cbO, nullptr, nullptr, 16 * 512, 128, b8 + cbE, b8 + 8 * 256 + cbO, 16 * 256, 2, c.lds); }
#pragma unroll
        for (int mi = 0; mi < 2; ++mi) {
            const int lr = 64 * wr + 32 * mi + r;
            if (lr < nvalid) {
                const size_t tok = (size_t)ltok[lr];
#pragma unroll
                for (int ni = 0; ni < 2; ++ni)
#pragma unroll
                    for (int g = 0; g < 4; g += 2) {
                        const size_t off = tok * 1024 + 128 * nt + 64 * wc + 32 * ni + 8 * g;
                        u32x2 oa, ob; oa[0] = cvtpk(acc[mi][ni][4 * g], acc[mi][ni][4 * g + 1]); oa[1] = cvtpk(acc[mi][ni][4 * g + 2], acc[mi][ni][4 * g + 3]);
                        ob[0] = cvtpk(acc[mi][ni][4 * g + 4], acc[mi][ni][4 * g + 5]); ob[1] = cvtpk(acc[mi][ni][4 * g + 6], acc[mi][ni][4 * g + 7]);
                        store_pair16(yb + off, oa, ob, h);
                    }
            }
        }
    }
}


#define XB_TMO      128
#define XB_XCNT(j)  (256  + 64 * (j))
#define XB_XSUB(j)  (1280 + 64 * (j))
#define XB_XGEN(j)  (2304 + 64 * (j))
#define XB_TOP      3328
#define XB_TOPGEN   3392
#define XCD_BAR_WORDS 3456
#define XB_SPIN_CAP (1u << 18)

__device__ __forceinline__ unsigned xb_ld(unsigned* p)              { return __hip_atomic_load(p, __ATOMIC_RELAXED, __HIP_MEMORY_SCOPE_AGENT); }
__device__ __forceinline__ unsigned xb_add(unsigned* p, unsigned v) { return __hip_atomic_fetch_add(p, v, __ATOMIC_RELAXED, __HIP_MEMORY_SCOPE_AGENT); }
__device__ __forceinline__ unsigned xb_xcc_id() { return (unsigned)__builtin_amdgcn_s_getreg((3 << 11) | 20) & 0xFu; }
#define XB_SPIN(cond, bar) do { unsigned _sp = 0; while (cond) { __builtin_amdgcn_s_sleep(1); \
    if ((++_sp & 255u) == 0u) { if (xb_ld(&(bar)[XB_TMO])) break; if (_sp > XB_SPIN_CAP) { atomicAdd(&(bar)[XB_TMO], 1u); break; } } } } while (0)

struct XcdBarrier {
    unsigned* bar; unsigned x;
    volatile LAS unsigned* st;
};

__device__ __forceinline__ XcdBarrier xcd_barrier_post(unsigned* bar, volatile LAS unsigned* st) {
    XcdBarrier b; b.bar = bar; b.x = xb_xcc_id(); b.st = st;
    if (threadIdx.x == 0) (void)xb_add(&bar[XB_XCNT(b.x)], 1u);
    return b;
}
__device__ __forceinline__ void xcd_barrier_complete(unsigned* bar, unsigned x, unsigned& nloc, unsigned& nx) {
    const unsigned G = gridDim.x * gridDim.y * gridDim.z;
    unsigned sum, cnt, mine, sp = 0u;
    for (;;) {
        sum = 0u; cnt = 0u; mine = 0u;
#pragma unroll
        for (unsigned j = 0; j < 16; ++j) { const unsigned c = xb_ld(&bar[XB_XCNT(j)]); sum += c; cnt += (c > 0u) ? 1u : 0u; mine = (j == x) ? c : mine; }
        if (sum == G) break;
        __builtin_amdgcn_s_sleep(1);
        if ((++sp & 255u) == 0u) { if (xb_ld(&bar[XB_TMO])) break; if (sp > XB_SPIN_CAP) { atomicAdd(&bar[XB_TMO], 1u); break; } }
    }
    nloc = mine > 0u ? mine : 1u; nx = cnt > 0u ? cnt : 1u;
}

__device__ __forceinline__ void xcd_barrier(const XcdBarrier& b) {
    asm volatile("s_waitcnt vmcnt(0)" ::: "memory");
    __syncthreads();
    if (threadIdx.x == 0) {
        unsigned* bar = b.bar; asm volatile("" : "+s"(bar)); unsigned bx = b.x; asm volatile("" : "+s"(bx));
        __builtin_amdgcn_s_waitcnt(0);
        unsigned nloc = b.st[0], nx = b.st[1];
        if (nloc == 0u) { xcd_barrier_complete(bar, bx, nloc, nx); b.st[0] = nloc; b.st[1] = nx; }
        const unsigned old = xb_add(&bar[XB_XSUB(bx)], 1u);
        const unsigned gen = old / nloc;
        if (old + 1u == (gen + 1u) * nloc) {
            __builtin_amdgcn_fence(__ATOMIC_RELEASE, "agent");
            asm volatile("s_waitcnt vmcnt(0)" ::: "memory");
            const unsigned og = xb_add(&bar[XB_TOP], 1u);
            const unsigned tg = og / nx;
            if (og + 1u == (tg + 1u) * nx) xb_add(&bar[XB_TOPGEN], 1u);
            else XB_SPIN(xb_ld(&bar[XB_TOPGEN]) == tg, bar);
            __builtin_amdgcn_fence(__ATOMIC_ACQUIRE, "agent");
            xb_add(&bar[XB_XGEN(bx)], 1u);
            asm volatile("s_waitcnt vmcnt(0)" ::: "memory");
        } else {
            XB_SPIN(xb_ld(&bar[XB_XGEN(bx)]) == gen, bar);
            __builtin_amdgcn_fence(__ATOMIC_ACQUIRE, "agent");
            asm volatile("s_waitcnt vmcnt(0)" ::: "memory");
        }
    }
    __syncthreads();
}

enum { PH_PRO = 0, PH_W, PH_PROJ, PH_PREP1, PH_PREP2, PH_ATTN, PH_GATE, PH_OUT, PH_LN1, PH_MUP, PH_MDN, PH_LN2, PH_SEL, PH_ATTNB };
template <int PH> DI void run_phase(const Ctx& c0) {
    Ctx c = c0; { const __attribute__((address_space(4))) char* k = (const __attribute__((address_space(4))) char*)__builtin_amdgcn_kernarg_segment_ptr(); asm volatile("" : "+s"(k)); c.ka = k;
                  __attribute__((address_space(1))) unsigned char* w = *(__attribute__((address_space(1))) unsigned char* const __attribute__((address_space(4)))*)(k + 224); asm volatile("" : "+s"(w)); c.wsp = (unsigned char*)w; }
    if (PH == PH_PRO) phase_prologue(c);
    else if (PH == PH_W) phase_weights(c);
    else if (PH == PH_PROJ) phase_proj(c);
    else if (PH == PH_PREP1) phase_prep1(c);
    else if (PH == PH_PREP2) phase_prep2(c);
    else if (PH == PH_ATTN) phase_attn(c);
    else if (PH == PH_GATE) phase_gate(c);
    else if (PH == PH_OUT) phase_out(c);
    else if (PH == PH_LN1) phase_ln<true>(c);
    else if (PH == PH_MUP) phase_moe_up(c);
    else if (PH == PH_MDN) phase_moe_down(c);
    else if (PH == PH_LN2) phase_ln<false>(c);
    else if (PH == PH_ATTNB) phase_attn_b(c);
}
extern __shared__ __attribute__((aligned(16))) char dyn_lds[];
template <int PH> __global__ void __launch_bounds__(NTHR, 2) k_phase(Params p, int layer) {
    Ctx c; c.p = &p; c.layer = layer & 255; c.qslot = layer >> 8; c.lds = dyn_lds; c.wsp = p.ws; c.ka = (const __attribute__((address_space(4))) char*)__builtin_amdgcn_kernarg_segment_ptr();
    run_phase<PH>(c);
}

__global__ void __launch_bounds__(NTHR, 2) k_mega(Params p) {
    Ctx c; c.p = &p; c.layer = 0; c.qslot = 0; c.lds = dyn_lds; c.wsp = p.ws; c.ka = (const __attribute__((address_space(4))) char*)__builtin_amdgcn_kernarg_segment_ptr();
    volatile LAS unsigned* st = (volatile LAS unsigned*)(LAS char*)(dyn_lds + LDS_BYTES - 16);
    if (threadIdx.x == 0) { st[0] = 0u; st[1] = 0u; st[2] = 0u; st[3] = 0u; }
    __syncthreads();
    const XcdBarrier bar = xcd_barrier_post(c.CTL() + CW_BAR, st);
    run_phase<PH_PRO>(c);
    run_phase<PH_W>(c);
    xcd_barrier(bar);
    for (int l = 0; l < NL; ++l) {
        c.layer = l;
        run_phase<PH_PROJ>(c); xcd_barrier(bar);
        run_phase<PH_PREP1>(c); xcd_barrier(bar);
        run_phase<PH_ATTN>(c); xcd_barrier(bar);
        run_phase<PH_ATTNB>(c); xcd_barrier(bar);
        run_phase<PH_GATE>(c); xcd_barrier(bar);
        run_phase<PH_OUT>(c); xcd_barrier(bar);
        run_phase<PH_LN1>(c); xcd_barrier(bar);
        run_phase<PH_MUP>(c); xcd_barrier(bar);
        run_phase<PH_MDN>(c); xcd_barrier(bar);
        run_phase<PH_LN2>(c);
        if (l + 1 < NL) { c.layer = l + 1; run_phase<PH_W>(c); }
        xcd_barrier(bar);
    }
}

extern "C" void kernel_launch(void* const* d_in, const int* in_sizes, int n_in, void* d_out, int out_size, void* d_ws, size_t ws_size, hipStream_t stream) {
    Params p{};
    for (int i = 0; i < 27; ++i) p.in[i] = (const float*)d_in[i];
    p.out = (float*)d_out; p.ws = (unsigned char*)d_ws;
    (void)hipMemsetAsync(d_ws, 0, 786432, stream);
#if N_LAUNCH_MODE == 1
    static int grid = 0;
    if (!grid) {
        int dev = 0, cus = 0, per_cu = 0;
        (void)hipGetDevice(&dev);
        (void)hipDeviceGetAttribute(&cus, hipDeviceAttributeMultiprocessorCount, dev);
        (void)hipFuncSetAttribute((const void*)k_mega, hipFuncAttributeMaxDynamicSharedMemorySize, LDS_BYTES);
        (void)hipOccupancyMaxActiveBlocksPerMultiprocessor(&per_cu, k_mega, NTHR, LDS_BYTES);
        if (per_cu > 2) per_cu = 2;
        if (per_cu < 1) per_cu = 1;
        grid = cus * per_cu;
        if (grid > 512) grid = 512;
    }
    hipLaunchKernelGGL(k_mega, dim3(grid), dim3(NTHR), LDS_BYTES, stream, p);
#else
    const int grid = 512;
#define LAUNCH(PH, L) hipLaunchKernelGGL((k_phase<PH>), dim3(grid), dim3(NTHR), LDS_BYTES, stream, p, (L))
    LAUNCH(PH_PRO, 0);
    for (int l = 0; l < NL; ++l) {
#ifndef PROBE_DUP
#define PROBE_DUP -1
#endif
#define LAUNCH2(PH, L) do { LAUNCH(PH, L); if (PROBE_DUP == PH) LAUNCH(PH, (L) | 256); } while (0)
        LAUNCH2(PH_W, l); LAUNCH2(PH_PROJ, l); LAUNCH2(PH_PREP1, l); LAUNCH2(PH_ATTN, l); LAUNCH(PH_ATTNB, l); LAUNCH2(PH_GATE, l);
        LAUNCH(PH_OUT, l); LAUNCH(PH_LN1, l); LAUNCH2(PH_MUP, l); LAUNCH(PH_MDN, l); LAUNCH(PH_LN2, l);
    }
#endif
}
```
